# Optimizing an MI355X kernel written in HIP

```python
import jax, jax.numpy as jnp
from jax import lax
import numpy as np

D_MODEL = 2048
BATCH = 2
SEQ = 8192
DEPTH = 1

GRID_W = 64
CTX_LEN = 256
CHUNK = 64
EPS = 1e-6
A_HEADS = 16
A_DK = 128
A_DV = 128
A_KW = A_HEADS * A_DK
A_VW = A_HEADS * A_DV
B_HEADS = 4
B_DK = 256
B_DV = 512
B_KW = B_HEADS * B_DK
B_VW = B_HEADS * B_DV
B_RANK = 16
GATE_NORMALIZER = 16.0
IN_COLS = (A_KW, A_VW, A_KW, A_KW, A_VW, B_KW, B_KW, B_VW, B_RANK, B_RANK, B_VW, D_MODEL, D_MODEL)
N_IN = sum(IN_COLS)

kernel_name = 'hgrn2_gla_parallel_prefix_dit_block'


def rms_norm(x, g):
    xf = x.astype(jnp.float32)
    y = xf * lax.rsqrt(jnp.mean(xf * xf, axis=-1, keepdims=True) + EPS)
    return (y * g.astype(jnp.float32)).astype(x.dtype)


def heads(t, n_heads):
    b, l, w = t.shape
    return t.reshape(b, l, n_heads, w // n_heads).transpose(0, 2, 1, 3)


def unheads(t):
    b, h, l, d = t.shape
    return t.transpose(0, 2, 1, 3).reshape(b, l, h * d)


def to_colmajor(t):
    b, l, w = t.shape
    rows = l // GRID_W
    return t.reshape(b, rows, GRID_W, w).transpose(0, 2, 1, 3).reshape(b, l, w)


def from_colmajor(t):
    b, l, w = t.shape
    rows = l // GRID_W
    return t.reshape(b, GRID_W, rows, w).transpose(0, 2, 1, 3).reshape(b, l, w)


def identity(t):
    return t


def chunked_gated_scan(q, k, v, log_f, s0):
    out_dtype = v.dtype
    b, h, l, dk = q.shape
    dv = v.shape[-1]
    n = l // CHUNK

    def chunks(t):
        return jnp.moveaxis(t.astype(jnp.float32).reshape(b, h, n, CHUNK, t.shape[-1]), 2, 0)

    incl = jnp.tril(jnp.ones((CHUNK, CHUNK), dtype=bool))[:, :, None]

    def step(state, inp):
        qc, kc, vc, lfc = inp
        cum = jnp.cumsum(lfc, axis=-2)
        o_inter = jnp.einsum('bhcd,bhde->bhce', qc * jnp.exp(cum), state)
        rel = cum[:, :, :, None, :] - cum[:, :, None, :, :]
        decay = jnp.exp(jnp.where(incl, rel, -jnp.inf))
        scores = jnp.einsum('bhid,bhjd,bhijd->bhij', qc, kc, decay)
        o_intra = jnp.einsum('bhij,bhje->bhie', scores, vc)
        last = cum[:, :, -1:, :]
        k_to_end = kc * jnp.exp(last - cum)
        new_state = jnp.exp(last[:, :, 0, :])[..., None] * state + jnp.einsum('bhcd,bhce->bhde', k_to_end, vc)
        return new_state, o_inter + o_intra

    s_final, o = lax.scan(step, s0.astype(jnp.float32), (chunks(q), chunks(k), chunks(v), chunks(log_f)))
    o = jnp.moveaxis(o, 0, 2).reshape(b, h, l, dv)
    return o.astype(out_dtype), s_final


def bidirectional_scan(q, k_fwd, k_bwd, v, lf_fwd, lf_bwd, s0_fwd, s0_bwd):
    o_f, s_f = chunked_gated_scan(q, k_fwd, v, lf_fwd, s0_fwd)
    o_b, s_b = chunked_gated_scan(jnp.flip(q, 2), jnp.flip(k_bwd, 2), jnp.flip(v, 2), jnp.flip(lf_bwd, 2), s0_bwd)
    return o_f + jnp.flip(o_b, 2), s_f, s_b


def group_rms_gate(o, n_heads, g, gate):
    b, l, w = o.shape
    of = o.astype(jnp.float32).reshape(b, l, n_heads, w // n_heads)
    of = of * lax.rsqrt(jnp.mean(of * of, axis=-1, keepdims=True) + EPS)
    return (of.reshape(b, l, w) * g.astype(jnp.float32)).astype(gate.dtype) * jax.nn.silu(gate)


def hybrid_mixer(h, w_in, lb, gk_w, gk_b, a_norm_g, b_norm_g, w_pa, w_pb, w_out, states, latent, with_output):
    split_at = [int(s) for s in np.cumsum(IN_COLS)[:-1]]
    (a_q, a_i, a_ff, a_fb, a_g, b_q, b_k, b_v, b_rf, b_rb, b_g, m_a, m_b) = jnp.split(
        jnp.einsum('bld,dn->bln', h, w_in), split_at, axis=-1)
    s_af0, s_ab0, s_bf0, s_bb0 = states

    lb = lb.astype(jnp.float32)
    f_f = lb[:A_KW] + (1.0 - lb[:A_KW]) * jax.nn.sigmoid(a_ff.astype(jnp.float32))
    f_b = lb[A_KW:] + (1.0 - lb[A_KW:]) * jax.nn.sigmoid(a_fb.astype(jnp.float32))
    o_a, s_af, s_ab = bidirectional_scan(
        heads(a_q, A_HEADS), heads(1.0 - f_f, A_HEADS), heads(1.0 - f_b, A_HEADS), heads(a_i, A_HEADS),
        heads(jnp.log(f_f), A_HEADS), heads(jnp.log(f_b), A_HEADS), s_af0, s_ab0)

    order, unorder = (to_colmajor, from_colmajor) if latent else (identity, identity)
    lf_bf = jax.nn.log_sigmoid(jnp.einsum('blr,rk->blk', b_rf, gk_w[0]).astype(jnp.float32)
                               + gk_b[0].astype(jnp.float32)) / GATE_NORMALIZER
    lf_bb = jax.nn.log_sigmoid(jnp.einsum('blr,rk->blk', b_rb, gk_w[1]).astype(jnp.float32)
                               + gk_b[1].astype(jnp.float32)) / GATE_NORMALIZER
    kb = heads(order(b_k), B_HEADS)
    o_b, s_bf, s_bb = bidirectional_scan(
        heads(order(b_q), B_HEADS) * (B_DK ** -0.5), kb, kb, heads(order(b_v), B_HEADS),
        heads(order(lf_bf), B_HEADS), heads(order(lf_bb), B_HEADS), s_bf0, s_bb0)
    new_states = (s_af, s_ab, s_bf, s_bb)
    if not with_output:
        return None, new_states

    o_a = group_rms_gate(unheads(o_a), A_HEADS, a_norm_g, a_g)
    o_b = group_rms_gate(unorder(unheads(o_b)), B_HEADS, b_norm_g, b_g)
    y = (jax.nn.sigmoid(m_a) * jnp.einsum('blv,vd->bld', o_a, w_pa)
         + jax.nn.sigmoid(m_b) * jnp.einsum('blv,vd->bld', o_b, w_pb))
    return jnp.einsum('bld,de->ble', y, w_out), new_states


def setup_inputs(seed: int = 0) -> dict:
    key = jax.random.key(seed)
    ks = jax.random.split(key, 20)
    f32 = jnp.float32
    nrm = lambda k, shape, s: jax.random.normal(k, shape, f32) * s
    return {
        'x': nrm(ks[0], (BATCH, SEQ, D_MODEL), 1.0),
        'c': nrm(ks[1], (BATCH, D_MODEL), 1.0),
        'ctx': nrm(ks[2], (BATCH, CTX_LEN, D_MODEL), 1.0),
        'c_ctx': nrm(ks[3], (D_MODEL,), 1.0),
        'w_ada': nrm(ks[4], (DEPTH, D_MODEL, 3 * D_MODEL), 0.5 * D_MODEL ** -0.5),
        'b_ada': nrm(ks[5], (DEPTH, 3 * D_MODEL), 0.01),
        'norm_g': 1.0 + nrm(ks[6], (DEPTH, D_MODEL), 0.1),
        'w_in': nrm(ks[7], (DEPTH, D_MODEL, N_IN), D_MODEL ** -0.5),
        'hgrn_lb_logits': nrm(ks[8], (DEPTH + 1, 2 * A_KW), 0.5),
        'gla_w_gk': nrm(ks[9], (DEPTH, 2, B_RANK, B_KW), B_RANK ** -0.5),
        'gla_b_gk': nrm(ks[10], (DEPTH, 2, B_KW), 0.1),
        'hgrn_onorm_g': 1.0 + nrm(ks[11], (DEPTH, A_VW), 0.1),
        'gla_onorm_g': 1.0 + nrm(ks[12], (DEPTH, B_VW), 0.1),
        'w_pa': nrm(ks[13], (DEPTH, A_VW, D_MODEL), A_VW ** -0.5),
        'w_pb': nrm(ks[14], (DEPTH, B_VW, D_MODEL), B_VW ** -0.5),
        'w_out': nrm(ks[15], (DEPTH, D_MODEL, D_MODEL), D_MODEL ** -0.5),
        'final_norm_g': 1.0 + nrm(ks[16], (D_MODEL,), 0.1),
    }


def reference(x, c, ctx, c_ctx, w_ada, b_ada, norm_g, w_in, hgrn_lb_logits, gla_w_gk, gla_b_gk,
              hgrn_onorm_g, gla_onorm_g, w_pa, w_pb, w_out, final_norm_g):
    b = x.shape[0]
    lower_bounds = jnp.cumsum(jax.nn.softmax(hgrn_lb_logits.astype(jnp.float32), axis=0), axis=0)
    for l in range(DEPTH):
        shift, scale, gate = jnp.split(jnp.einsum('bd,de->be', jax.nn.silu(c), w_ada[l]) + b_ada[l], 3, axis=-1)
        shift_c, scale_c, gate_c = jnp.split(jnp.einsum('d,de->e', jax.nn.silu(c_ctx), w_ada[l]) + b_ada[l], 3, axis=-1)
        params = (w_in[l], lower_bounds[l], gla_w_gk[l], gla_b_gk[l], hgrn_onorm_g[l], gla_onorm_g[l],
                  w_pa[l], w_pb[l], w_out[l])
        zero_states = (jnp.zeros((b, A_HEADS, A_DK, A_DV), jnp.float32), jnp.zeros((b, A_HEADS, A_DK, A_DV), jnp.float32),
                       jnp.zeros((b, B_HEADS, B_DK, B_DV), jnp.float32), jnp.zeros((b, B_HEADS, B_DK, B_DV), jnp.float32))
        last = l == DEPTH - 1
        h_ctx = rms_norm(ctx, norm_g[l]) * (1.0 + scale_c) + shift_c
        y_ctx, ctx_states = hybrid_mixer(h_ctx, *params, zero_states, latent=False, with_output=not last)
        h_x = rms_norm(x, norm_g[l]) * (1.0 + scale[:, None, :]) + shift[:, None, :]
        y_x, _ = hybrid_mixer(h_x, *params, ctx_states, latent=True, with_output=True)
        x = x + gate[:, None, :] * y_x
        if not last:
            ctx = ctx + gate_c * y_ctx
    return rms_norm(x, final_norm_g)
```

```cpp
#include <hip/hip_runtime.h>
#include <hip/hip_cooperative_groups.h>
#include <cstdio>
#include <cstdint>
namespace cg = cooperative_groups;

#define LAS __attribute__((address_space(3)))
typedef unsigned short u16;
typedef short bf16x8 __attribute__((ext_vector_type(8)));
typedef float f32x2 __attribute__((ext_vector_type(2)));
typedef float f32x4 __attribute__((ext_vector_type(4)));
typedef float f32x16 __attribute__((ext_vector_type(16)));
typedef unsigned u32x2 __attribute__((ext_vector_type(2)));
typedef unsigned u32x4 __attribute__((ext_vector_type(4)));
typedef __bf16 bf16x2_t __attribute__((ext_vector_type(2)));
typedef _Float16 f16x2_t __attribute__((ext_vector_type(2)));

constexpr int D = 2048, NB = 2, SEQ = 8192, LCTX = 256;
constexpr int M_LAT = NB * SEQ;
constexpr int M_ALL = M_LAT + NB * LCTX;
constexpr int N_IN = 20512;
constexpr int NCHUNK = M_ALL / 32;
constexpr float EPS = 1e-6f;
constexpr int NSCAN_ROWS = 12544;
constexpr int NGATE_ROWS = 8192;

constexpr size_t WS_MOD = 4096;
constexpr size_t WS_SSO = WS_MOD + 3 * 6144 * 4;
constexpr size_t WS_SSA = WS_SSO + (size_t)M_LAT * 32 * 4;
constexpr size_t WS_SSB = WS_SSA + (size_t)M_LAT * 64 * 4;
constexpr size_t WS_WTG = WS_SSB + (size_t)M_LAT * 64 * 4;
constexpr size_t WS_WTP = WS_WTG + (size_t)NGATE_ROWS * D * 2;
constexpr size_t WS_H   = WS_WTP + (size_t)3 * D * D * 2;
constexpr size_t WS_WTS = WS_H + (size_t)M_ALL * D * 2;
constexpr size_t WS_LFB = WS_WTS;
constexpr size_t WS_R   = WS_LFB + (size_t)2 * NCHUNK * 1024 * 32 * 2;
constexpr size_t WS_AQ  = WS_R + (size_t)NCHUNK * 32 * 32 * 4;
constexpr size_t WS_AV  = WS_AQ + (size_t)NCHUNK * 2048 * 32 * 2;
constexpr size_t WS_ALF = WS_AV + (size_t)NCHUNK * 2048 * 32 * 2;
constexpr size_t WS_BQ  = WS_ALF + (size_t)2 * NCHUNK * 2048 * 32 * 2;
constexpr size_t WS_BK  = WS_BQ + (size_t)NCHUNK * 1024 * 32 * 2;
constexpr size_t WS_BV  = WS_BK + (size_t)NCHUNK * 1024 * 32 * 2;
constexpr size_t WS_END = WS_BV + (size_t)NCHUNK * 2048 * 32 * 2;
constexpr size_t WS_MG  = WS_AQ;
constexpr size_t WS_Y   = WS_ALF;
static_assert(WS_WTS + (size_t)NSCAN_ROWS * D * 2 <= WS_R, "LFB overlay");
static_assert(WS_MG + (size_t)M_LAT * 4096 * 2 <= WS_ALF, "MG overlay");

constexpr int LDS_BYTES = 139264;

struct Params {
    const float *x, *c, *ctx, *c_ctx, *w_ada, *b_ada, *norm_g, *w_in, *lb_logits, *gk_w, *gk_b, *onorm_a, *onorm_b, *w_pa, *w_pb, *w_out, *final_g;
    float* out; unsigned char* ws;
    int ph_lo, ph_hi;
};

__device__ __forceinline__ unsigned pk_bf16(float lo, float hi) { f32x2 v = {lo, hi}; return __builtin_bit_cast(unsigned, __builtin_convertvector(v, bf16x2_t)); }
__device__ __forceinline__ unsigned pk_f16(float lo, float hi) { f32x2 v = {lo, hi}; return __builtin_bit_cast(unsigned, __builtin_convertvector(v, f16x2_t)); }
__device__ __forceinline__ float bf_lo(unsigned w) { return __uint_as_float(w << 16); }
__device__ __forceinline__ float bf_hi(unsigned w) { return __uint_as_float(w & 0xffff0000u); }
__device__ __forceinline__ float bf_sel(unsigned w, int hi) { return hi ? bf_hi(w) : bf_lo(w); }
__device__ __forceinline__ float h_sel(unsigned w, int hi) { return (float)__builtin_bit_cast(_Float16, (u16)(hi ? (w >> 16) : (w & 0xffffu))); }
__device__ __forceinline__ float sigmoidf_(float v) { return 1.0f / (1.0f + __expf(-v)); }
__device__ __forceinline__ float wave_sum(float v) {
#pragma unroll
    for (int o = 1; o < 64; o <<= 1) v += __shfl_xor(v, o);
    return v;
}
#define LDS_WAIT() asm volatile("s_waitcnt lgkmcnt(0)" ::: "memory")
#define VM_WAIT() asm volatile("s_waitcnt vmcnt(0)" ::: "memory")

namespace pg8 {
constexpr int BM = 256, BK = 64, HALF = 128, HTB = HALF * BK * 2, STAGE_BYTES = 8 * HTB, KD = 2048, NT = KD / BK;
__device__ __forceinline__ int lds_byte(int r, int c) { const int st = (r >> 4) * 2 + (c >> 5), rr = r & 15, cc = c & 31, ob = rr * 64 + cc * 2; return st * 1024 + (ob ^ (((ob >> 9) & 1) << 5)); }
__device__ __forceinline__ void stage_rc(int b, int& R, int& C) { const int st = b / 1024, sb = b % 1024, swz = sb ^ (((sb >> 9) & 1) << 5); R = (st >> 1) * 16 + swz / 64; C = (st & 1) * 32 + (swz % 64) / 2; }
__device__ __forceinline__ int perm32(int rho) { const int n = rho >> 4, i = rho & 15; return 8 * (i >> 2) + 4 * n + (i & 3); }

struct Unit { const char* A; const char* B; unsigned rowmul; unsigned hstepA; int pm, pn; };

template <class Epi, class Sched, bool TRANS, bool PERM_A, bool PERM_B>
__device__ __forceinline__ void gemm_phase(LAS unsigned char* lds, const Sched& S, const Epi& E) {
    const int tid = threadIdx.x, wid = __builtin_amdgcn_readfirstlane(tid >> 6), lane = tid & 63, wr = wid >> 2, wc = wid & 3, fr = lane & 15, fq = lane >> 4;
    unsigned rkA[2], c2[2], voffB[2];
#pragma unroll
    for (int i = 0; i < 2; ++i) { int R, C; stage_rc(tid * 16 + i * 8192, R, C);
        const int Ra = PERM_A ? ((R & ~31) + perm32(R & 31)) : R; const int Rb = PERM_B ? ((R & ~31) + perm32(R & 31)) : R;
        rkA[i] = (unsigned)Ra * (unsigned)(KD * 2); c2[i] = (unsigned)C * 2u; voffB[i] = (unsigned)(Rb * KD + C) * 2u; }
    constexpr size_t kstep = (size_t)(BK * 2);
    constexpr size_t hstepB = (size_t)HALF * KD * 2;
    const unsigned ldsw = (unsigned)wid * 1024u;
    const int aoff = lds_byte(wr * 64 + fr, fq * 8), boff = lds_byte(wc * 32 + fr, fq * 8);
#define PG8_SA(b, h) (((b) * 2 + (h)) * HTB)
#define PG8_SB(b, h) ((4 + (b) * 2 + (h)) * HTB)
#define PG8_STAGE(bufoff, gbase, voff) do { _Pragma("unroll") for (int _i = 0; _i < 2; ++_i) \
        __builtin_amdgcn_global_load_lds((const unsigned*)((const char*)(gbase) + (voff)[_i]), (LAS unsigned*)(lds + (bufoff) + ldsw + _i * 8192), 16, 0, 0); } while (0)
#define PG8_LDA(dst, b, h) do { _Pragma("unroll") for (int m = 0; m < 4; ++m) _Pragma("unroll") for (int k = 0; k < 2; ++k) dst[m][k] = *(const LAS bf16x8*)(lds + PG8_SA(b, h) + aoff + m * 2048 + k * 1024); } while (0)
#define PG8_LDB(dst, b, h) do { _Pragma("unroll") for (int n = 0; n < 2; ++n) _Pragma("unroll") for (int k = 0; k < 2; ++k) dst[n][k] = *(const LAS bf16x8*)(lds + PG8_SB(b, h) + boff + n * 2048 + k * 1024); } while (0)
#define PG8_MMA(ai, bj, At, Bt) do { __builtin_amdgcn_s_setprio(1); _Pragma("unroll") for (int m = 0; m < 4; ++m) _Pragma("unroll") for (int n = 0; n < 2; ++n) _Pragma("unroll") for (int k = 0; k < 2; ++k) \
        acc[ai][bj][m][n] = TRANS ? __builtin_amdgcn_mfma_f32_16x16x32_bf16(Bt[n][k], At[m][k], acc[ai][bj][m][n], 0, 0, 0) \
                                  : __builtin_amdgcn_mfma_f32_16x16x32_bf16(At[m][k], Bt[n][k], acc[ai][bj][m][n], 0, 0, 0); __builtin_amdgcn_s_setprio(0); } while (0)
#define PG8_WAIT_V(n) asm volatile("s_waitcnt vmcnt(" #n ")" ::: "memory")
#define PG8_WAIT_L(n) asm volatile("s_waitcnt lgkmcnt(" #n ")" ::: "memory")
#define PG8_BAR __builtin_amdgcn_s_barrier()
#define PG8_SCHED __builtin_amdgcn_sched_barrier(0)
    Unit cur, nxt; int ui = 0;
    if (!S.next(0, cur)) return;
    f32x4 acc[2][2][4][2];
#pragma unroll
    for (int a = 0; a < 2; ++a)
#pragma unroll
        for (int b = 0; b < 2; ++b)
#pragma unroll
            for (int m = 0; m < 4; ++m)
#pragma unroll
                for (int n = 0; n < 2; ++n) acc[a][b][m][n] = (f32x4){0.f, 0.f, 0.f, 0.f};
    bf16x8 At[4][2], B0[2][2], B1[2][2];
    const char* cA = cur.A; const char* cB = cur.B;
    unsigned vA[2] = {rkA[0] * cur.rowmul + c2[0], rkA[1] * cur.rowmul + c2[1]};
    size_t hA = cur.hstepA;
    PG8_STAGE(PG8_SB(0, 0), cB, voffB); PG8_STAGE(PG8_SA(0, 0), cA, vA); PG8_STAGE(PG8_SB(0, 1), cB + hstepB, voffB); PG8_STAGE(PG8_SA(0, 1), cA + hA, vA);
    if (wr == 1) PG8_BAR;
    PG8_WAIT_V(4); PG8_BAR;
    PG8_STAGE(PG8_SB(1, 0), cB + kstep, voffB); PG8_STAGE(PG8_SA(1, 0), cA + kstep, vA); PG8_STAGE(PG8_SB(1, 1), cB + hstepB + kstep, voffB);
    PG8_WAIT_V(6); PG8_BAR;
    for (;;) {
        const bool has_next = S.next(ui + 1, nxt);
        const char* nA = has_next ? nxt.A : cA; const char* nB = has_next ? nxt.B : cB;
        unsigned vN[2]; size_t hN;
        if (has_next) { vN[0] = rkA[0] * nxt.rowmul + c2[0]; vN[1] = rkA[1] * nxt.rowmul + c2[1]; hN = nxt.hstepA; } else { vN[0] = vA[0]; vN[1] = vA[1]; hN = hA; }
        for (int t = 0; t < NT; t += 2) {
            const bool last = (t == NT - 2);
            const char* a1 = cA + (size_t)(t + 1) * kstep;
            const char* a2 = last ? nA : cA + (size_t)(t + 2) * kstep; const char* b2 = last ? nB : cB + (size_t)(t + 2) * kstep;
            const char* a3 = a2 + kstep; const char* b3 = b2 + kstep;
            unsigned v2[2] = {last ? vN[0] : vA[0], last ? vN[1] : vA[1]}; const size_t h2 = last ? hN : hA;
            PG8_LDB(B0, 0, 0); PG8_SCHED; PG8_LDA(At, 0, 0); PG8_STAGE(PG8_SA(1, 1), a1 + hA, vA);
            PG8_WAIT_L(8); PG8_BAR; PG8_WAIT_L(0); PG8_MMA(0, 0, At, B0); PG8_BAR; PG8_SCHED;
            PG8_LDB(B1, 0, 1); PG8_STAGE(PG8_SB(0, 0), b2, voffB);
            PG8_BAR; PG8_WAIT_L(0); PG8_MMA(0, 1, At, B1); PG8_BAR;
            PG8_LDA(At, 0, 1); PG8_STAGE(PG8_SA(0, 0), a2, v2);
            PG8_BAR; PG8_WAIT_L(0); PG8_MMA(1, 0, At, B0); PG8_BAR; PG8_SCHED;
            PG8_STAGE(PG8_SB(0, 1), b2 + hstepB, voffB);
            PG8_WAIT_V(6); PG8_BAR; PG8_MMA(1, 1, At, B1); PG8_BAR;
            PG8_LDB(B0, 1, 0); PG8_SCHED; PG8_LDA(At, 1, 0); PG8_STAGE(PG8_SA(0, 1), a2 + h2, v2);
            PG8_WAIT_L(8); PG8_BAR; PG8_WAIT_L(0); PG8_MMA(0, 0, At, B0); PG8_BAR; PG8_SCHED;
            PG8_LDB(B1, 1, 1); PG8_STAGE(PG8_SB(1, 0), b3, voffB);
            PG8_BAR; PG8_WAIT_L(0); PG8_MMA(0, 1, At, B1); PG8_BAR;
            PG8_LDA(At, 1, 1); PG8_STAGE(PG8_SA(1, 0), a3, v2);
            PG8_BAR; PG8_WAIT_L(0); PG8_MMA(1, 0, At, B0); PG8_BAR; PG8_SCHED;
            PG8_STAGE(PG8_SB(1, 1), b3 + hstepB, voffB);
            PG8_WAIT_V(6); PG8_BAR; PG8_MMA(1, 1, At, B1); PG8_BAR;
        }
        E(acc, cur, wr, wc, fr, fq);
        if (!has_next) break;
#pragma unroll
        for (int a = 0; a < 2; ++a)
#pragma unroll
            for (int b = 0; b < 2; ++b)
#pragma unroll
                for (int m = 0; m < 4; ++m)
#pragma unroll
                    for (int n = 0; n < 2; ++n) acc[a][b][m][n] = (f32x4){0.f, 0.f, 0.f, 0.f};
        cur = nxt; cA = nA; cB = nB; vA[0] = vN[0]; vA[1] = vN[1]; hA = hN; ++ui;
    }
    PG8_WAIT_V(0);
    if (wr == 0) PG8_BAR;
    PG8_BAR;
#undef PG8_SA
#undef PG8_SB
#undef PG8_STAGE
#undef PG8_LDA
#undef PG8_LDB
#undef PG8_MMA
#undef PG8_WAIT_V
#undef PG8_WAIT_L
#undef PG8_BAR
#undef PG8_SCHED
}
}

typedef f32x4 AccT[2][2][4][2];

struct SchedScan {
    int G, c; const char* h; const char* wts;
    __device__ __forceinline__ bool next(int i, pg8::Unit& u) const {
        const int L = i * G + c;
        if (L >= 64 * 49 + 2 * 37) return false;
        int pm, pn;
        if (L < 64 * 49) { pm = L & 63; pn = L >> 6; }
        else { const int r = L - 64 * 49; pm = 64 + (r & 1); int q = r >> 1; pn = (q < 24) ? 8 + q : 36 + (q - 24); }
        u.pm = pm; u.pn = pn; u.B = wts + (size_t)pn * 256 * 4096;
        if (pn >= 32 && pm < 64) {
            const int b = pm >> 5, pp = pm & 31;
            u.A = h + (size_t)(b * 8192 + 2 * pp) * 4096; u.rowmul = 64u; u.hstepA = 4096u;
        } else { u.A = h + (size_t)pm * 256 * 4096; u.rowmul = 1u; u.hstepA = 128u * 4096u; }
        return true;
    }
};
struct SchedStd {
    int G, c, nN; const char* A; const char* B;
    __device__ __forceinline__ bool next(int i, pg8::Unit& u) const {
        const int L = i * G + c;
        if (L >= 64 * nN) return false;
        u.pm = L & 63; u.pn = L >> 6; u.A = A + (size_t)u.pm * 256 * 4096; u.B = B + (size_t)u.pn * 256 * 4096; u.rowmul = 1u; u.hstepA = 128u * 4096u;
        return true;
    }
};

struct EpiScan {
    unsigned char* ws; const float* lbl;
    __device__ __forceinline__ void operator()(const AccT& acc, const pg8::Unit& u, int wr, int wc, int fr, int fq) const {
        const int pn = u.pn;
        int kind, pl, W; size_t base;
        if (pn < 8) { kind = 0; pl = pn; W = 2048; base = WS_AQ; }
        else if (pn < 16) { kind = 0; pl = pn - 8; W = 2048; base = WS_AV; }
        else if (pn < 24) { kind = 1; pl = pn - 16; W = 2048; base = WS_ALF; }
        else if (pn < 32) { kind = 2; pl = pn - 24; W = 2048; base = WS_ALF + (size_t)NCHUNK * 2048 * 32 * 2; }
        else if (pn < 36) { kind = 3; pl = pn - 32; W = 1024; base = WS_BQ; }
        else if (pn < 40) { kind = 0; pl = pn - 36; W = 1024; base = WS_BK; }
        else if (pn < 48) { kind = 0; pl = pn - 40; W = 2048; base = WS_BV; }
        else { kind = 4; pl = 0; W = 32; base = WS_R; }
#pragma unroll
        for (int bj = 0; bj < 2; ++bj)
#pragma unroll
            for (int n = 0; n < 2; ++n) {
                const int ch = pl * 256 + bj * 128 + wc * 32 + n * 16 + fr;
                float lb = 0.f;
                if (kind == 1 || kind == 2) { const int li = (kind == 2 ? 2048 : 0) + ch; lb = sigmoidf_(lbl[li] - lbl[4096 + li]); }
#pragma unroll
                for (int ai = 0; ai < 2; ++ai)
#pragma unroll
                    for (int q = 0; q < 2; ++q) {
                        const int chunk = u.pm * 8 + ai * 4 + wr * 2 + q;
                        f32x4 v0 = acc[ai][bj][2 * q][n], v1 = acc[ai][bj][2 * q + 1][n];
                        if (kind == 4) {
                            if (wc == 0 && bj == 0) { float* dst = (float*)(ws + base) + ((size_t)chunk * 32 + (n * 16 + fr)) * 32 + 8 * fq; *(f32x4*)dst = v0; *(f32x4*)(dst + 4) = v1; }
                        } else {
                            u32x4 w;
                            if (kind == 1 || kind == 2) {
                                float t[8] = {v0[0], v0[1], v0[2], v0[3], v1[0], v1[1], v1[2], v1[3]};
#pragma unroll
                                for (int e = 0; e < 8; ++e) t[e] = __logf(lb + (1.0f - lb) * sigmoidf_(t[e]));
                                w.x = pk_f16(t[0], t[1]); w.y = pk_f16(t[2], t[3]); w.z = pk_f16(t[4], t[5]); w.w = pk_f16(t[6], t[7]);
                            } else {
                                if (kind == 3) { v0 = v0 * 0.0625f; v1 = v1 * 0.0625f; }
                                w.x = pk_bf16(v0[0], v0[1]); w.y = pk_bf16(v0[2], v0[3]); w.z = pk_bf16(v1[0], v1[1]); w.w = pk_bf16(v1[2], v1[3]);
                            }
                            u16* dst = (u16*)(ws + base) + ((size_t)chunk * W + ch) * 32 + 8 * fq;
                            *(u32x4*)dst = w;
                        }
                    }
            }
    }
};

struct EpiGate {
    unsigned char* ws; u16* OA; u16* OB; const float* gain_a; const float* gain_b;
    __device__ __forceinline__ void operator()(const AccT& acc, const pg8::Unit& u, int wr, int wc, int fr, int fq) const {
        const int pn = u.pn;
        const int row0 = u.pm * 256 + wr * 64 + fr;
        if (pn >= 16) {
            u16* MG = (u16*)(ws + WS_MG);
            const int col0 = (pn - 16) * 256 + wc * 32 + 8 * fq;
#pragma unroll
            for (int ai = 0; ai < 2; ++ai)
#pragma unroll
                for (int m = 0; m < 4; ++m) { u16* rowp = MG + (size_t)(row0 + ai * 128 + m * 16) * 4096 + col0;
#pragma unroll
                    for (int bj = 0; bj < 2; ++bj) { const f32x4 v0 = acc[ai][bj][m][0], v1 = acc[ai][bj][m][1]; u32x4 w;
                        w.x = pk_bf16(sigmoidf_(v0[0]), sigmoidf_(v0[1])); w.y = pk_bf16(sigmoidf_(v0[2]), sigmoidf_(v0[3]));
                        w.z = pk_bf16(sigmoidf_(v1[0]), sigmoidf_(v1[1])); w.w = pk_bf16(sigmoidf_(v1[2]), sigmoidf_(v1[3]));
                        *(u32x4*)(rowp + bj * 128) = w; } }
        } else {
            const bool isA = pn < 8; const int pl = isA ? pn : pn - 8;
            u16* O = isA ? OA : OB; const float* gain = isA ? gain_a : gain_b;
            const float* SS = (const float*)(ws + (isA ? WS_SSA : WS_SSB));
            const int col0 = pl * 256 + wc * 32 + 8 * fq;
            f32x4 g[2][2];
#pragma unroll
            for (int bj = 0; bj < 2; ++bj) { g[bj][0] = *(const f32x4*)(gain + col0 + bj * 128); g[bj][1] = *(const f32x4*)(gain + col0 + bj * 128 + 4); }
#pragma unroll
            for (int ai = 0; ai < 2; ++ai)
#pragma unroll
                for (int m = 0; m < 4; ++m) {
                    const int row = row0 + ai * 128 + m * 16;
                    float rstd[2];
                    if (isA) {
#pragma unroll
                        for (int bj = 0; bj < 2; ++bj) { const f32x4 s = *(const f32x4*)(SS + (size_t)row * 64 + (pl * 2 + bj) * 4); rstd[bj] = rsqrtf(((s[0] + s[1]) + (s[2] + s[3])) * (1.0f / 128.0f) + EPS); }
                    } else {
                        const float* sp = SS + (size_t)row * 64 + (pl >> 1) * 16; float t = 0.f;
#pragma unroll
                        for (int k = 0; k < 4; ++k) { const f32x4 s = *(const f32x4*)(sp + 4 * k); t += (s[0] + s[1]) + (s[2] + s[3]); }
                        rstd[0] = rstd[1] = rsqrtf(t * (1.0f / 512.0f) + EPS);
                    }
                    u16* rowp = O + (size_t)row * 2048 + col0;
#pragma unroll
                    for (int bj = 0; bj < 2; ++bj) {
                        const u32x4 ov = *(const u32x4*)(rowp + bj * 128);
                        const f32x4 a0 = acc[ai][bj][m][0], a1 = acc[ai][bj][m][1];
                        float o[8] = {bf_lo(ov.x), bf_hi(ov.x), bf_lo(ov.y), bf_hi(ov.y), bf_lo(ov.z), bf_hi(ov.z), bf_lo(ov.w), bf_hi(ov.w)};
                        float gt[8] = {a0[0], a0[1], a0[2], a0[3], a1[0], a1[1], a1[2], a1[3]};
                        float gg[8] = {g[bj][0][0], g[bj][0][1], g[bj][0][2], g[bj][0][3], g[bj][1][0], g[bj][1][1], g[bj][1][2], g[bj][1][3]};
#pragma unroll
                        for (int e = 0; e < 8; ++e) o[e] = (o[e] * rstd[bj] * gg[e]) * (gt[e] * sigmoidf_(gt[e]));
                        u32x4 w; w.x = pk_bf16(o[0], o[1]); w.y = pk_bf16(o[2], o[3]); w.z = pk_bf16(o[4], o[5]); w.w = pk_bf16(o[6], o[7]);
                        *(u32x4*)(rowp + bj * 128) = w;
                    }
                }
        }
    }
};

template <int SECOND> struct EpiY {
    unsigned char* ws;
    __device__ __forceinline__ void operator()(const AccT& acc, const pg8::Unit& u, int wr, int wc, int fr, int fq) const {
        const u16* MG = (const u16*)(ws + WS_MG) + (SECOND ? 2048 : 0); u16* Y = (u16*)(ws + WS_Y);
        const int row0 = u.pm * 256 + wr * 64 + fr, col0 = u.pn * 256 + wc * 32 + 8 * fq;
#pragma unroll
        for (int ai = 0; ai < 2; ++ai)
#pragma unroll
            for (int m = 0; m < 4; ++m) { const int row = row0 + ai * 128 + m * 16;
#pragma unroll
                for (int bj = 0; bj < 2; ++bj) {
                    const u32x4 mv = *(const u32x4*)(MG + (size_t)row * 4096 + col0 + bj * 128);
                    const f32x4 a0 = acc[ai][bj][m][0], a1 = acc[ai][bj][m][1];
                    float o[8] = {a0[0] * bf_lo(mv.x), a0[1] * bf_hi(mv.x), a0[2] * bf_lo(mv.y), a0[3] * bf_hi(mv.y), a1[0] * bf_lo(mv.z), a1[1] * bf_hi(mv.z), a1[2] * bf_lo(mv.w), a1[3] * bf_hi(mv.w)};
                    u16* yp = Y + (size_t)row * 2048 + col0 + bj * 128;
                    if (SECOND) { const u32x4 yv = *(const u32x4*)yp;
                        o[0] += bf_lo(yv.x); o[1] += bf_hi(yv.x); o[2] += bf_lo(yv.y); o[3] += bf_hi(yv.y); o[4] += bf_lo(yv.z); o[5] += bf_hi(yv.z); o[6] += bf_lo(yv.w); o[7] += bf_hi(yv.w); }
                    u32x4 w; w.x = pk_bf16(o[0], o[1]); w.y = pk_bf16(o[2], o[3]); w.z = pk_bf16(o[4], o[5]); w.w = pk_bf16(o[6], o[7]);
                    *(u32x4*)yp = w;
                } }
    }
};

struct EpiOut {
    const float* x; float* out; const float* mod; float* sso;
    __device__ __forceinline__ void operator()(const AccT& acc, const pg8::Unit& u, int wr, int wc, int fr, int fq) const {
        const int row0 = u.pm * 256 + wr * 64 + fr, col0 = u.pn * 256 + wc * 32 + 4 * fq;
        const float* gate = mod + (size_t)(u.pm >> 5) * 6144 + 4096;
        f32x4 gv[2][2];
#pragma unroll
        for (int bj = 0; bj < 2; ++bj)
#pragma unroll
            for (int n = 0; n < 2; ++n) gv[bj][n] = *(const f32x4*)(gate + col0 + bj * 128 + n * 16);
#pragma unroll
        for (int ai = 0; ai < 2; ++ai)
#pragma unroll
            for (int m = 0; m < 4; ++m) { const int row = row0 + ai * 128 + m * 16; const size_t off = (size_t)row * 2048 + col0; float s = 0.f;
#pragma unroll
                for (int bj = 0; bj < 2; ++bj)
#pragma unroll
                    for (int n = 0; n < 2; ++n) { const f32x4 xv = *(const f32x4*)(x + off + bj * 128 + n * 16); const f32x4 o = xv + gv[bj][n] * acc[ai][bj][m][n];
                        *(f32x4*)(out + off + bj * 128 + n * 16) = o; s += (o[0] * o[0] + o[1] * o[1]) + (o[2] * o[2] + o[3] * o[3]); }
                s += __shfl_xor(s, 16); s += __shfl_xor(s, 32);
                if (fq == 0) sso[(size_t)row * 32 + u.pn * 4 + wc] = s; }
    }
};

__device__ __forceinline__ void transpose_item(const float* W, int N, int n0, int k0, u16* WTrow0, LAS float* scr, int lane) {
#pragma unroll 8
    for (int i = 0; i < 32; ++i) { const int kk = 2 * i + (lane >> 5); scr[kk * 33 + (lane & 31)] = W[(size_t)(k0 + kk) * N + n0 + (lane & 31)]; }
    LDS_WAIT(); asm volatile("" ::: "memory");
    const int c = lane & 7;
#pragma unroll
    for (int j = 0; j < 4; ++j) { const int n = (lane >> 3) + 8 * j; const LAS float* s = scr + (8 * c) * 33 + n;
        u32x4 o; o.x = pk_bf16(s[0 * 33], s[1 * 33]); o.y = pk_bf16(s[2 * 33], s[3 * 33]); o.z = pk_bf16(s[4 * 33], s[5 * 33]); o.w = pk_bf16(s[6 * 33], s[7 * 33]);
        *(u32x4*)(WTrow0 + (size_t)n * 2048 + k0 + 8 * c) = o; }
    LDS_WAIT(); asm volatile("" ::: "memory");
}

__device__ __forceinline__ void phase0(const Params& p, LAS unsigned char* lds) {
    const int tid = threadIdx.x, wid = tid >> 6, lane = tid & 63;
    unsigned char* ws = p.ws;
    if (blockIdx.x < 192) {
        LAS float* sl = (LAS float*)lds;
        LAS float* red = (LAS float*)lds + 6144;
        for (int i = tid; i < 3 * 2048; i += 512) { const int v = i >> 11, d = i & 2047; const float cv = (v < 2) ? p.c[v * 2048 + d] : p.c_ctx[d]; sl[i] = cv * sigmoidf_(cv); }
        __syncthreads();
        const int cg4 = tid & 7, kl = tid >> 3;
        const int col = blockIdx.x * 32 + cg4 * 4;
        f32x4 a0 = {0, 0, 0, 0}, a1 = {0, 0, 0, 0}, a2 = {0, 0, 0, 0};
        for (int k = kl; k < 2048; k += 64) { const f32x4 w = *(const f32x4*)(p.w_ada + (size_t)k * 6144 + col); a0 += sl[k] * w; a1 += sl[2048 + k] * w; a2 += sl[4096 + k] * w; }
        LAS float* rp = red + tid * 12;
#pragma unroll
        for (int e = 0; e < 4; ++e) { rp[e] = a0[e]; rp[4 + e] = a1[e]; rp[8 + e] = a2[e]; }
        __syncthreads();
        if (tid < 96) { const int v = tid >> 5, cc = tid & 31, g4 = cc >> 2, e = cc & 3; float s = 0.f;
            for (int k = 0; k < 64; ++k) s += red[(k * 8 + g4) * 12 + v * 4 + e];
            ((float*)(ws + WS_MOD))[v * 6144 + blockIdx.x * 32 + cc] = s + p.b_ada[blockIdx.x * 32 + cc]; }
        __syncthreads();
    }
    LAS float* scr = (LAS float*)(lds + 65536 + wid * 8448);
    const int gw = blockIdx.x * 8 + wid, NGW = gridDim.x * 8;
    constexpr int I_IN = 32 * 641, I_P = 32 * 64;
    u16* WTS = (u16*)(ws + WS_WTS); u16* WTG = (u16*)(ws + WS_WTG); u16* WTP = (u16*)(ws + WS_WTP);
    for (int it = gw; it < I_IN + 3 * I_P; it += NGW) {
        if (it < I_IN) {
            const int kb = it / 641, cb = it - kb * 641, n0 = cb * 32;
            u16* dst;
            if (n0 < 8192) dst = WTS + (size_t)n0 * 2048;
            else if (n0 < 10240) dst = WTG + (size_t)(n0 - 8192) * 2048;
            else if (n0 < 14336) dst = WTS + (size_t)(8192 + n0 - 10240) * 2048;
            else if (n0 == 14336) dst = WTS + (size_t)12288 * 2048;
            else if (n0 < 16416) dst = WTG + (size_t)(2048 + n0 - 14368) * 2048;
            else dst = WTG + (size_t)(4096 + n0 - 16416) * 2048;
            transpose_item(p.w_in, N_IN, n0, kb * 64, dst, scr, lane);
        } else {
            int r = it - I_IN; const int which = r / I_P; r -= which * I_P;
            const float* W = which == 0 ? p.w_pa : (which == 1 ? p.w_pb : p.w_out);
            const int kb = r >> 6, cb = r & 63;
            transpose_item(W, 2048, cb * 32, kb * 64, WTP + (size_t)which * 2048 * 2048 + (size_t)(cb * 32) * 2048, scr, lane);
        }
    }
    { u32x4* z = (u32x4*)(WTS + (size_t)12320 * 2048); const int nz = 224 * 2048 * 2 / 16;
      for (int i = blockIdx.x * 512 + tid; i < nz; i += gridDim.x * 512) z[i] = (u32x4){0u, 0u, 0u, 0u}; }
}

__device__ __forceinline__ void phase1(const Params& p) {
    const int tid = threadIdx.x, wid = tid >> 6, lane = tid & 63;
    const float* mod = (const float*)(p.ws + WS_MOD);
    u16* H = (u16*)(p.ws + WS_H);
    for (int m = blockIdx.x * 8 + wid; m < M_ALL; m += gridDim.x * 8) {
        const float* src = (m < M_LAT) ? p.x + (size_t)m * D : p.ctx + (size_t)(m - M_LAT) * D;
        const int v = (m < M_LAT) ? (m >> 13) : 2;
        const f32x4* s4 = (const f32x4*)src + lane;
        f32x4 xv[8]; float ss = 0.f;
#pragma unroll
        for (int j = 0; j < 8; ++j) { xv[j] = s4[64 * j]; ss += (xv[j][0] * xv[j][0] + xv[j][1] * xv[j][1]) + (xv[j][2] * xv[j][2] + xv[j][3] * xv[j][3]); }
        const float rstd = rsqrtf(wave_sum(ss) * (1.0f / D) + EPS);
        u32x2* o8 = (u32x2*)(H + (size_t)m * D) + lane;
#pragma unroll
        for (int j = 0; j < 8; ++j) { const int col = 4 * (lane + 64 * j);
            const f32x4 g = *(const f32x4*)(p.norm_g + col), sh = *(const f32x4*)(mod + v * 6144 + col), sc = *(const f32x4*)(mod + v * 6144 + 2048 + col);
            const f32x4 y = (xv[j] * rstd * g) * (sc + 1.0f) + sh;
            o8[64 * j] = (u32x2){pk_bf16(y[0], y[1]), pk_bf16(y[2], y[3])}; }
    }
}

__device__ __forceinline__ void phase2b(const Params& p) {
    const int tid = threadIdx.x;
    const float* R = (const float*)(p.ws + WS_R);
    u16* LFB = (u16*)(p.ws + WS_LFB);
    for (int item = blockIdx.x; item < NCHUNK * 2 * 2; item += gridDim.x) {
        const int chunk = item >> 2, dir = (item >> 1) & 1, half = item & 1;
        const int c = half * 512 + tid;
        float w[16];
#pragma unroll
        for (int r = 0; r < 16; ++r) w[r] = p.gk_w[(size_t)(dir * 16 + r) * 1024 + c];
        const float bias = p.gk_b[dir * 1024 + c];
        const float* rp = R + ((size_t)chunk * 32 + dir * 16) * 32;
        u16* dst = LFB + (((size_t)dir * NCHUNK + chunk) * 1024 + c) * 32;
#pragma unroll 1
        for (int t8 = 0; t8 < 4; ++t8) {
            float z[8];
#pragma unroll
            for (int e = 0; e < 8; ++e) z[e] = bias;
#pragma unroll
            for (int r = 0; r < 16; ++r)
#pragma unroll
                for (int e = 0; e < 8; ++e) z[e] += rp[r * 32 + t8 * 8 + e] * w[r];
#pragma unroll
            for (int e = 0; e < 8; ++e) { const float a = fabsf(z[e]); z[e] = (fminf(z[e], 0.f) - __logf(1.0f + __expf(-a))) * 0.0625f; }
            u32x4 o; o.x = pk_f16(z[0], z[1]); o.y = pk_f16(z[2], z[3]); o.z = pk_f16(z[4], z[5]); o.w = pk_f16(z[6], z[7]);
            *(u32x4*)(dst + t8 * 8) = o;
        }
    }
}

__device__ __forceinline__ bf16x8 pack8(const f32x16& x, int s) {
    u32x4 pk; pk.x = pk_bf16(x[8 * s + 0], x[8 * s + 1]); pk.y = pk_bf16(x[8 * s + 2], x[8 * s + 3]); pk.z = pk_bf16(x[8 * s + 4], x[8 * s + 5]); pk.w = pk_bf16(x[8 * s + 6], x[8 * s + 7]);
    return __builtin_bit_cast(bf16x8, pk);
}
__device__ __forceinline__ unsigned rot16(unsigned x) { return (x >> 16) | (x << 16); }
template <int NW> __device__ __forceinline__ void maybe_rev(unsigned (&w)[NW], bool rev) {
    unsigned r[NW];
#pragma unroll
    for (int k = 0; k < NW; ++k) r[k] = rot16(w[NW - 1 - k]);
#pragma unroll
    for (int k = 0; k < NW; ++k) w[k] = rev ? r[k] : w[k];
}
__device__ __forceinline__ void ld16(unsigned (&w)[8], const u16* p) { const u32x4 a = *(const u32x4*)p, b = *(const u32x4*)(p + 8); w[0] = a.x; w[1] = a.y; w[2] = a.z; w[3] = a.w; w[4] = b.x; w[5] = b.y; w[6] = b.z; w[7] = b.w; }
__device__ __forceinline__ void ld32(unsigned (&w)[16], const u16* p) {
#pragma unroll
    for (int k = 0; k < 4; ++k) { const u32x4 a = *(const u32x4*)(p + 8 * k); w[4 * k] = a.x; w[4 * k + 1] = a.y; w[4 * k + 2] = a.z; w[4 * k + 3] = a.w; }
}

template <int DK, bool IS_A>
__device__ __forceinline__ void scan_unit(const Params& p, LAS unsigned char* lds, int b, int hh, int quarter) {
    constexpr int NT = DK / 32;
    constexpr int QSTR = DK * 2 + 16;
    constexpr int RSTR = 80;
    constexpr int DIRB = 2 * 32 * QSTR + DK * RSTR + 128 * RSTR + 32 * RSTR + DK * 4;
    static_assert(2 * DIRB <= LDS_BYTES, "scan LDS");
    const int tid = threadIdx.x, wid = __builtin_amdgcn_readfirstlane(tid >> 6), lane = tid & 63;
    const int dir = wid >> 2, w = wid & 3, tg = tid & 255, h = lane >> 5, l31 = lane & 31;
    LAS unsigned char* QS = lds + dir * DIRB;
    LAS unsigned char* KS = QS + 32 * QSTR;
    LAS unsigned char* KST = KS + 32 * QSTR;
    LAS unsigned char* VT = KST + DK * RSTR;
    LAS unsigned char* PM = VT + 128 * RSTR;
    LAS float* DD = (LAS float*)(PM + 32 * RSTR);
    unsigned char* ws = p.ws;
    const u16* Qg = (const u16*)(ws + (IS_A ? WS_AQ : WS_BQ));
    const u16* Kg = (const u16*)(ws + WS_BK);
    const u16* Vg = (const u16*)(ws + (IS_A ? WS_AV : WS_BV));
    const u16* LFg = IS_A ? (const u16*)(ws + WS_ALF) + (size_t)dir * NCHUNK * 2048 * 32 : (const u16*)(ws + WS_LFB) + (size_t)dir * NCHUNK * 1024 * 32;
    u16* Og = (u16*)p.out + (IS_A ? 0 : (size_t)M_LAT * 2048);
    float* SSg = (float*)(ws + (IS_A ? WS_SSA : WS_SSB));
    const int ocol0 = IS_A ? hh * 128 + 32 * w : hh * 512 + quarter * 128 + 32 * w;
    const int sspart = IS_A ? hh * 4 + w : hh * 16 + quarter * 4 + w;
    const int prow = (l31 & 3) + 8 * ((l31 >> 2) & 1) + 4 * ((l31 >> 3) & 1) + 16 * (l31 >> 4);

    f32x16 S[NT];
#pragma unroll
    for (int t = 0; t < NT; ++t)
#pragma unroll
        for (int r = 0; r < 16; ++r) S[t][r] = 0.f;

#pragma unroll 1
    for (int s = 0; s < 264; ++s) {
        const bool is_ctx = s < 8;
        const int lc = is_ctx ? (dir ? 7 - s : s) : (dir ? 263 - s : s - 8);
        const int cidx = is_ctx ? 512 + b * 8 + lc : b * 256 + lc;
        if (IS_A) {
            const int c = 32 * w + l31, th = h;
            const int pb = dir ? 16 * (1 - th) : 16 * th;
            const size_t eo = ((size_t)cidx * 2048 + hh * 128 + c) * 32 + pb;
            unsigned lfw[8], qw[8], vw[8];
            ld16(lfw, LFg + eo); ld16(vw, Vg + eo);
            if (!is_ctx) ld16(qw, Qg + eo); else {
#pragma unroll
                for (int k = 0; k < 8; ++k) qw[k] = 0u; }
            maybe_rev<8>(lfw, dir != 0); maybe_rev<8>(qw, dir != 0); maybe_rev<8>(vw, dir != 0);
            float E[16], kk[16]; float run = 1.f;
#pragma unroll
            for (int it = 0; it < 16; ++it) { const float f = __expf(h_sel(lfw[it >> 1], it & 1)); run *= f; E[it] = run; kk[it] = 1.0f - f; }
            const float other = __shfl_xor(run, 32);
            const float pre = th ? other : 1.0f;
            unsigned kst[8];
#pragma unroll
            for (int it = 0; it < 16; it += 2) {
                float ks2[2];
#pragma unroll
                for (int e = 0; e < 2; ++e) { const int i2 = it + e; const float ev = E[i2] * pre; const float qs = bf_sel(qw[i2 >> 1], i2 & 1) * ev; ks2[e] = kk[i2] * __builtin_amdgcn_rcpf(fmaxf(ev, 1e-30f));
                    const int i = 16 * th + i2;
                    *(LAS u16*)(QS + i * QSTR + c * 2) = (u16)(pk_bf16(qs, 0.f) & 0xffffu);
                    *(LAS u16*)(KS + i * QSTR + c * 2) = (u16)(pk_bf16(ks2[e], 0.f) & 0xffffu); }
                kst[it >> 1] = pk_bf16(ks2[0], ks2[1]);
            }
            if (th) DD[c] = E[15] * pre;
            *(LAS u32x4*)(KST + c * RSTR + th * 32) = (u32x4){kst[0], kst[1], kst[2], kst[3]};
            *(LAS u32x4*)(KST + c * RSTR + th * 32 + 16) = (u32x4){kst[4], kst[5], kst[6], kst[7]};
            *(LAS u32x4*)(VT + c * RSTR + th * 32) = (u32x4){vw[0], vw[1], vw[2], vw[3]};
            *(LAS u32x4*)(VT + c * RSTR + th * 32 + 16) = (u32x4){vw[4], vw[5], vw[6], vw[7]};
        } else {
            const int c = tg;
            const size_t eo = ((size_t)cidx * 1024 + hh * 256 + c) * 32;
            float run = 1.f;
#pragma unroll 1
            for (int hb = 0; hb < 2; ++hb) {
                const int pb = dir ? 16 * (1 - hb) : 16 * hb;
                unsigned lfw[8], qw[8], kw[8];
                ld16(lfw, LFg + eo + pb); ld16(kw, Kg + eo + pb);
                if (!is_ctx) ld16(qw, Qg + eo + pb); else {
#pragma unroll
                    for (int k = 0; k < 8; ++k) qw[k] = 0u; }
                maybe_rev<8>(lfw, dir != 0); maybe_rev<8>(qw, dir != 0); maybe_rev<8>(kw, dir != 0);
                unsigned kst[8];
#pragma unroll
                for (int it = 0; it < 16; it += 2) {
                    float ks2[2];
#pragma unroll
                    for (int e = 0; e < 2; ++e) { const int i2 = it + e; const float f = __expf(h_sel(lfw[i2 >> 1], i2 & 1)); run *= f;
                        const float qs = bf_sel(qw[i2 >> 1], i2 & 1) * run; ks2[e] = bf_sel(kw[i2 >> 1], i2 & 1) * __builtin_amdgcn_rcpf(fmaxf(run, 1e-30f));
                        const int i = 16 * hb + i2;
                        *(LAS u16*)(QS + i * QSTR + c * 2) = (u16)(pk_bf16(qs, 0.f) & 0xffffu);
                        *(LAS u16*)(KS + i * QSTR + c * 2) = (u16)(pk_bf16(ks2[e], 0.f) & 0xffffu); }
                    kst[it >> 1] = pk_bf16(ks2[0], ks2[1]);
                }
                *(LAS u32x4*)(KST + c * RSTR + hb * 32) = (u32x4){kst[0], kst[1], kst[2], kst[3]};
                *(LAS u32x4*)(KST + c * RSTR + hb * 32 + 16) = (u32x4){kst[4], kst[5], kst[6], kst[7]};
            }
            DD[c] = run;
            const int col = tg & 127, th = tg >> 7;
            const int pb = dir ? 16 * (1 - th) : 16 * th;
            const size_t ev = ((size_t)cidx * 2048 + hh * 512 + quarter * 128 + col) * 32 + pb;
            unsigned vw[8]; ld16(vw, Vg + ev); maybe_rev<8>(vw, dir != 0);
            *(LAS u32x4*)(VT + col * RSTR + th * 32) = (u32x4){vw[0], vw[1], vw[2], vw[3]};
            *(LAS u32x4*)(VT + col * RSTR + th * 32 + 16) = (u32x4){vw[4], vw[5], vw[6], vw[7]};
        }
        __syncthreads();
        f32x16 OT;
#pragma unroll
        for (int r = 0; r < 16; ++r) OT[r] = 0.f;
        if (!is_ctx) {
            const int jq = w >> 1, iq = w & 1, l15 = lane & 15, g4 = lane >> 4;
            f32x4 pacc = {0.f, 0.f, 0.f, 0.f};
            if (!(jq == 1 && iq == 0)) {
#pragma unroll
                for (int ks = 0; ks < DK / 32; ++ks) {
                    const bf16x8 a = *(const LAS bf16x8*)(KS + (16 * jq + l15) * QSTR + (32 * ks + 8 * g4) * 2);
                    const bf16x8 bb = *(const LAS bf16x8*)(QS + (16 * iq + l15) * QSTR + (32 * ks + 8 * g4) * 2);
                    pacc = __builtin_amdgcn_mfma_f32_16x16x32_bf16(a, bb, pacc, 0, 0, 0);
                }
            }
            const int ii = 16 * iq + l15, j0 = 16 * jq + 4 * g4;
            float pv[4];
#pragma unroll
            for (int r = 0; r < 4; ++r) pv[r] = (j0 + r <= ii) ? pacc[r] : 0.f;
            *(LAS u32x2*)(PM + ii * RSTR + j0 * 2) = (u32x2){pk_bf16(pv[0], pv[1]), pk_bf16(pv[2], pv[3])};
#pragma unroll
            for (int idx = 0; idx < 2 * NT; ++idx) {
                const bf16x8 bq = *(const LAS bf16x8*)(QS + l31 * QSTR + (16 * idx + 8 * h) * 2);
                const bf16x8 a = pack8(S[idx >> 1], idx & 1);
                OT = __builtin_amdgcn_mfma_f32_32x32x16_bf16(a, bq, OT, 0, 0, 0);
                if (idx & 1) __builtin_amdgcn_sched_barrier(0);
            }
        }
        __syncthreads();
        bf16x8 vf[2];
#pragma unroll
        for (int s2 = 0; s2 < 2; ++s2) vf[s2] = *(const LAS bf16x8*)(VT + (32 * w + l31) * RSTR + (16 * s2 + 8 * h) * 2);
        if (!is_ctx) {
#pragma unroll
            for (int s2 = 0; s2 < 2; ++s2) { const bf16x8 pf = *(const LAS bf16x8*)(PM + l31 * RSTR + (16 * s2 + 8 * h) * 2); OT = __builtin_amdgcn_mfma_f32_32x32x16_bf16(vf[s2], pf, OT, 0, 0, 0); }
            const int pos = dir ? 31 - l31 : l31;
            int row;
            if (IS_A) row = b * SEQ + 32 * lc + pos;
            else { const int pp = 32 * lc + pos; row = b * SEQ + (pp & 127) * 64 + (pp >> 7); }
            u16* op = Og + (size_t)row * 2048 + ocol0 + 4 * h;
            const bool fin = s >= 136;
            float ss = 0.f;
#pragma unroll
            for (int g = 0; g < 4; ++g) {
                float o0 = OT[4 * g], o1 = OT[4 * g + 1], o2 = OT[4 * g + 2], o3 = OT[4 * g + 3];
                unsigned long long* a8 = (unsigned long long*)(op + 8 * g);
                if (fin) {
                    const unsigned long long pv = __hip_atomic_load(a8, __ATOMIC_RELAXED, __HIP_MEMORY_SCOPE_AGENT);
                    const unsigned lo = (unsigned)pv, hi = (unsigned)(pv >> 32);
                    o0 += bf_lo(lo); o1 += bf_hi(lo); o2 += bf_lo(hi); o3 += bf_hi(hi);
                    ss += (o0 * o0 + o1 * o1) + (o2 * o2 + o3 * o3);
                }
                *a8 = (unsigned long long)pk_bf16(o0, o1) | ((unsigned long long)pk_bf16(o2, o3) << 32);
            }
            if (fin) { ss += __shfl_xor(ss, 32); if (h == 0) SSg[(size_t)row * 64 + sspart] = ss; }
        }
        __builtin_amdgcn_sched_barrier(0);
#pragma unroll
        for (int t = 0; t < NT; ++t) {
            const bf16x8 k0 = *(const LAS bf16x8*)(KST + (32 * t + prow) * RSTR + (8 * h) * 2);
            const bf16x8 k1 = *(const LAS bf16x8*)(KST + (32 * t + prow) * RSTR + (16 + 8 * h) * 2);
            S[t] = __builtin_amdgcn_mfma_f32_32x32x16_bf16(k0, vf[0], S[t], 0, 0, 0);
            S[t] = __builtin_amdgcn_mfma_f32_32x32x16_bf16(k1, vf[1], S[t], 0, 0, 0);
            __builtin_amdgcn_sched_barrier(0);
        }
#pragma unroll
        for (int t = 0; t < NT; ++t) {
            const f32x4 d0 = *(const LAS f32x4*)(DD + 32 * t + 8 * h), d1 = *(const LAS f32x4*)(DD + 32 * t + 8 * h + 4);
            const f32x4 d2 = *(const LAS f32x4*)(DD + 32 * t + 16 + 8 * h), d3 = *(const LAS f32x4*)(DD + 32 * t + 16 + 8 * h + 4);
#pragma unroll
            for (int r = 0; r < 4; ++r) { S[t][r] *= d0[r]; S[t][4 + r] *= d1[r]; S[t][8 + r] *= d2[r]; S[t][12 + r] *= d3[r]; }
            __builtin_amdgcn_sched_barrier(0);
        }
        VM_WAIT();
        __syncthreads();
    }
}

__device__ __forceinline__ void phase7(const Params& p) {
    const int tid = threadIdx.x, wid = tid >> 6, lane = tid & 63;
    const float* sso = (const float*)(p.ws + WS_SSO);
    for (int m = blockIdx.x * 8 + wid; m < M_LAT; m += gridDim.x * 8) {
        float s = (lane < 32) ? sso[(size_t)m * 32 + lane] : 0.f;
        const float rstd = rsqrtf(wave_sum(s) * (1.0f / D) + EPS);
        f32x4* o4 = (f32x4*)(p.out + (size_t)m * D) + lane;
#pragma unroll
        for (int j = 0; j < 8; ++j) { const f32x4 g = *(const f32x4*)(p.final_g + 4 * (lane + 64 * j)); o4[64 * j] = o4[64 * j] * rstd * g; }
    }
}

__global__ void __launch_bounds__(512, 2) fwd_megakernel(Params p) {
    extern __shared__ __attribute__((aligned(16))) unsigned char lds_raw[];
    LAS unsigned char* lds = (LAS unsigned char*)lds_raw;
    cg::grid_group grid = cg::this_grid();
    const int lo = p.ph_lo, hi = p.ph_hi;
    const int G = gridDim.x, c = blockIdx.x;
    unsigned char* ws = p.ws;
#ifdef ONLY_PHASE
#define IN(k) ((k) == ONLY_PHASE && lo <= (k) && (k) < hi)
#else
#define IN(k) (lo <= (k) && (k) < hi)
#endif
#define SEAM(k) do { if (IN(k) && IN((k) + 1)) grid.sync(); } while (0)
    if (IN(0)) phase0(p, lds);
    SEAM(0);
    if (IN(1)) phase1(p);
    SEAM(1);
    if (IN(2)) { SchedScan S{G, c, (const char*)(ws + WS_H), (const char*)(ws + WS_WTS)}; EpiScan E{ws, p.lb_logits};
        pg8::gemm_phase<EpiScan, SchedScan, false, true, false>(lds, S, E); }
    SEAM(2);
    if (IN(3)) phase2b(p);
    SEAM(3);
    if (IN(4)) {
        if (c < 32) scan_unit<128, true>(p, lds, c >> 4, c & 15, 0);
        else if (c < 64) { const int u = c - 32; scan_unit<256, false>(p, lds, u >> 4, (u >> 2) & 3, u & 3); }
    }
    SEAM(4);
    if (IN(5)) { SchedStd S{G, c, 32, (const char*)(ws + WS_H), (const char*)(ws + WS_WTG)};
        EpiGate E{ws, (u16*)p.out, (u16*)p.out + (size_t)M_LAT * 2048, p.onorm_a, p.onorm_b};
        pg8::gemm_phase<EpiGate, SchedStd, true, false, true>(lds, S, E); }
    SEAM(5);
    if (IN(6)) {
        { SchedStd S{G, c, 8, (const char*)p.out, (const char*)(ws + WS_WTP)}; EpiY<0> E{ws}; pg8::gemm_phase<EpiY<0>, SchedStd, true, false, true>(lds, S, E); }
        { SchedStd S{G, c, 8, (const char*)p.out + (size_t)M_LAT * 2048 * 2, (const char*)(ws + WS_WTP) + (size_t)2048 * 4096}; EpiY<1> E{ws}; pg8::gemm_phase<EpiY<1>, SchedStd, true, false, true>(lds, S, E); }
    }
    SEAM(6);
    if (IN(7)) { SchedStd S{G, c, 8, (const char*)(ws + WS_Y), (const char*)(ws + WS_WTP) + (size_t)2 * 2048 * 4096};
        EpiOut E{p.x, p.out, (const float*)(ws + WS_MOD), (float*)(ws + WS_SSO)};
        pg8::gemm_phase<EpiOut, SchedStd, true, false, false>(lds, S, E); }
    SEAM(7);
    if (IN(8)) phase7(p);
#undef IN
#undef SEAM
}

#ifndef N_LAUNCHES
#define N_LAUNCHES 9
#endif
constexpr int N_PHASES = 9;

extern "C" void kernel_launch(void* const* d_in, const int* in_sizes, int n_in, void* d_out, int out_size, void* d_ws, size_t ws_size, hipStream_t stream) {
    static int grid = 0;
    if (grid == 0) {
        if (n_in != 17 || out_size != M_LAT * D || ws_size < WS_END) { fprintf(stderr, "kernel_launch: unexpected sizes (n_in %d out %d ws %zu need %zu)\n", n_in, out_size, ws_size, (size_t)WS_END); grid = -1; return; }
        int dev = 0, cus = 0, per_cu = 0;
        hipGetDevice(&dev);
        hipDeviceGetAttribute(&cus, hipDeviceAttributeMultiprocessorCount, dev);
        hipFuncSetAttribute((const void*)fwd_megakernel, hipFuncAttributeMaxDynamicSharedMemorySize, LDS_BYTES);
        hipOccupancyMaxActiveBlocksPerMultiprocessor(&per_cu, (const void*)fwd_megakernel, 512, LDS_BYTES);
        if (per_cu < 1) { fprintf(stderr, "kernel_launch: occupancy query reports %d blocks per CU\n", per_cu); grid = -1; return; }
        grid = cus;
    }
    if (grid < 0) return;
    Params p{};
    p.x = (const float*)d_in[0]; p.c = (const float*)d_in[1]; p.ctx = (const float*)d_in[2]; p.c_ctx = (const float*)d_in[3];
    p.w_ada = (const float*)d_in[4]; p.b_ada = (const float*)d_in[5]; p.norm_g = (const float*)d_in[6]; p.w_in = (const float*)d_in[7];
    p.lb_logits = (const float*)d_in[8]; p.gk_w = (const float*)d_in[9]; p.gk_b = (const float*)d_in[10]; p.onorm_a = (const float*)d_in[11];
    p.onorm_b = (const float*)d_in[12]; p.w_pa = (const float*)d_in[13]; p.w_pb = (const float*)d_in[14]; p.w_out = (const float*)d_in[15]; p.final_g = (const float*)d_in[16];
    p.out = (float*)d_out; p.ws = (unsigned char*)d_ws;
    const int per = (N_PHASES + N_LAUNCHES - 1) / N_LAUNCHES;
    for (int li = 0; li < N_LAUNCHES; ++li) {
        p.ph_lo = li * per; p.ph_hi = (li + 1) * per < N_PHASES ? (li + 1) * per : N_PHASES;
        if (p.ph_lo >= N_PHASES) break;
        void* args[] = {&p};
        hipError_t e = hipLaunchCooperativeKernel((const void*)fwd_megakernel, dim3(grid), dim3(512), args, LDS_BYTES, stream);
        if (e != hipSuccess) { fprintf(stderr, "cooperative launch failed: %s (grid %d)\n", hipGetErrorString(e), grid); break; }
    }
}
```

```cpp
#include <hip/hip_runtime.h>
#include <hip/hip_cooperative_groups.h>
#include <cstdio>
#include <cstdint>
namespace cg = cooperative_groups;

#define LAS __attribute__((address_space(3)))
typedef unsigned short u16;
typedef short bf16x8 __attribute__((ext_vector_type(8)));
typedef float f32x2 __attribute__((ext_vector_type(2)));
typedef float f32x4 __attribute__((ext_vector_type(4)));
typedef float f32x16 __attribute__((ext_vector_type(16)));
typedef unsigned u32x2 __attribute__((ext_vector_type(2)));
typedef unsigned u32x4 __attribute__((ext_vector_type(4)));
typedef __bf16 bf16x2_t __attribute__((ext_vector_type(2)));
typedef _Float16 f16x2_t __attribute__((ext_vector_type(2)));

constexpr int D = 2048, NB = 2, SEQ = 8192, LCTX = 256;
constexpr int M_LAT = NB * SEQ;
constexpr int M_ALL = M_LAT + NB * LCTX;
constexpr int N_IN = 20512;
constexpr int NCHUNK = M_ALL / 32;
constexpr float EPS = 1e-6f;
constexpr int NSCAN_ROWS = 12544;
constexpr int NGATE_ROWS = 8192;

constexpr size_t WS_BAR = 4096;
constexpr size_t WS_FLG = WS_BAR + 16384;
constexpr size_t WS_MOD = WS_FLG + 64 * 256 * 4 * 4;
constexpr size_t WS_SSO = WS_MOD + 3 * 6144 * 4;
constexpr size_t WS_SSA = WS_SSO + (size_t)M_LAT * 32 * 4;
constexpr size_t WS_SSB = WS_SSA + (size_t)M_LAT * 64 * 4;
constexpr size_t WS_WTG = WS_SSB + (size_t)M_LAT * 64 * 4;
constexpr size_t WS_H   = WS_WTG + (size_t)NGATE_ROWS * D * 2;
constexpr size_t WS_WTS = WS_H + (size_t)M_ALL * D * 2;
constexpr size_t WS_LFB = WS_WTS;
constexpr size_t WS_R   = WS_LFB + (size_t)2 * NCHUNK * 1024 * 32 * 2;
constexpr size_t WS_AQ  = WS_R + (size_t)NCHUNK * 32 * 32 * 4;
constexpr size_t WS_AV  = WS_AQ + (size_t)NCHUNK * 2048 * 32 * 2;
constexpr size_t WS_ALF = WS_AV + (size_t)NCHUNK * 2048 * 32 * 2;
constexpr size_t WS_BQ  = WS_ALF + (size_t)2 * NCHUNK * 2048 * 32 * 2;
constexpr size_t WS_BK  = WS_BQ + (size_t)NCHUNK * 1024 * 32 * 2;
constexpr size_t WS_BV  = WS_BK + (size_t)NCHUNK * 1024 * 32 * 2;
constexpr size_t WS_MGA = WS_BV + (size_t)NCHUNK * 2048 * 32 * 2;
constexpr size_t WS_END = WS_MGA + (size_t)M_LAT * 2048 * 2;
constexpr size_t WS_MGB = WS_AQ;
constexpr size_t WS_Y   = WS_ALF;
constexpr size_t WS_WTP = WS_ALF + (size_t)M_LAT * 2048 * 2;
static_assert(WS_WTS + (size_t)NSCAN_ROWS * D * 2 <= WS_R, "LFB overlay");
static_assert(WS_MGB + (size_t)M_LAT * 2048 * 2 <= WS_AV, "MGB overlay");
static_assert(WS_WTP + (size_t)3 * D * D * 2 <= WS_BQ, "WTP overlay");
static_assert(WS_END <= (size_t)672137216, "workspace");

constexpr int LDS_BYTES = 155648;

struct Params {
    const float *x, *c, *ctx, *c_ctx, *w_ada, *b_ada, *norm_g, *w_in, *lb_logits, *gk_w, *gk_b, *onorm_a, *onorm_b, *w_pa, *w_pb, *w_out, *final_g;
    float* out; unsigned char* ws;
    int ph_lo, ph_hi;
};

__device__ __forceinline__ unsigned pk_bf16(float lo, float hi) { f32x2 v = {lo, hi}; return __builtin_bit_cast(unsigned, __builtin_convertvector(v, bf16x2_t)); }
__device__ __forceinline__ unsigned pk_f16(float lo, float hi) { f32x2 v = {lo, hi}; return __builtin_bit_cast(unsigned, __builtin_convertvector(v, f16x2_t)); }
__device__ __forceinline__ float bf_lo(unsigned w) { return __uint_as_float(w << 16); }
__device__ __forceinline__ float bf_hi(unsigned w) { return __uint_as_float(w & 0xffff0000u); }
__device__ __forceinline__ float bf_sel(unsigned w, int hi) { return hi ? bf_hi(w) : bf_lo(w); }
__device__ __forceinline__ float h_sel(unsigned w, int hi) { return (float)__builtin_bit_cast(_Float16, (u16)(hi ? (w >> 16) : (w & 0xffffu))); }
__device__ __forceinline__ float sigmoidf_(float v) { return __builtin_amdgcn_rcpf(1.0f + __builtin_amdgcn_exp2f(v * -1.4426950408889634f)); }
__device__ __forceinline__ float wave_sum(float v) {
#pragma unroll
    for (int o = 1; o < 64; o <<= 1) v += __shfl_xor(v, o);
    return v;
}
#define LDS_WAIT() asm volatile("s_waitcnt lgkmcnt(0)" ::: "memory")
#define VM_WAIT() asm volatile("s_waitcnt vmcnt(0)" ::: "memory")

namespace pg8 {
constexpr int BM = 256, BK = 64, HALF = 128, HTB = HALF * BK * 2, STAGE_BYTES = 8 * HTB, KD = 2048, NT = KD / BK;
__device__ __forceinline__ int lds_byte(int r, int c) { const int st = (r >> 4) * 2 + (c >> 5), rr = r & 15, cc = c & 31, ob = rr * 64 + cc * 2; return st * 1024 + (ob ^ (((ob >> 9) & 1) << 5)); }
__device__ __forceinline__ void stage_rc(int b, int& R, int& C) { const int st = b / 1024, sb = b % 1024, swz = sb ^ (((sb >> 9) & 1) << 5); R = (st >> 1) * 16 + swz / 64; C = (st & 1) * 32 + (swz % 64) / 2; }
__device__ __forceinline__ int perm32(int rho) { const int n = rho >> 4, i = rho & 15; return 8 * (i >> 2) + 4 * n + (i & 3); }

struct Unit { const char* A; const char* B; unsigned mode; unsigned hstepA; unsigned kstepA; int pm, pn; };
__device__ __forceinline__ unsigned voffA_of(unsigned mode, int R, int C) {
    if (mode == 0u) return (unsigned)(R * KD + C) * 2u;
    if (mode == 1u) return (unsigned)(R * 64 * KD + C) * 2u;
    if (mode == 2u) return (unsigned)((((R >> 5) * 64 + (C >> 5)) * 1024) + (R & 31) * 32 + (C & 31)) * 2u;
    return (unsigned)((((R & 63) * 4 * 64 + (C >> 5)) * 1024) + (R >> 6) * 32 + (C & 31)) * 2u;
}

template <class Epi, class Sched, bool TRANS, bool PERM_A, bool PERM_B>
__device__ __forceinline__ void gemm_phase(LAS unsigned char* lds, const Sched& S, const Epi& E) {
    const int tid = threadIdx.x, wid = __builtin_amdgcn_readfirstlane(tid >> 6), lane = tid & 63, wr = wid >> 2, wc = wid & 3, fr = lane & 15, fq = lane >> 4;
    int RaA[2], CA[2]; unsigned voffB[2];
#pragma unroll
    for (int i = 0; i < 2; ++i) { int R, C; stage_rc(tid * 16 + i * 8192, R, C);
        RaA[i] = PERM_A ? ((R & ~31) + perm32(R & 31)) : R; CA[i] = C; const int Rb = PERM_B ? ((R & ~31) + perm32(R & 31)) : R;
        voffB[i] = (unsigned)(Rb * KD + C) * 2u; }
    constexpr size_t kstep = (size_t)(BK * 2);
    constexpr size_t hstepB = (size_t)HALF * KD * 2;
    const unsigned ldsw = (unsigned)wid * 1024u;
    const int aoff = lds_byte(wr * 64 + fr, fq * 8), boff = lds_byte(wc * 32 + fr, fq * 8);
#define PG8_SA(b, h) (((b) * 2 + (h)) * HTB)
#define PG8_SB(b, h) ((4 + (b) * 2 + (h)) * HTB)
#define PG8_STAGE(bufoff, gbase, voff) do { _Pragma("unroll") for (int _i = 0; _i < 2; ++_i) \
        __builtin_amdgcn_global_load_lds((const unsigned*)((const char*)(gbase) + (voff)[_i]), (LAS unsigned*)(lds + (bufoff) + ldsw + _i * 8192), 16, 0, 0); } while (0)
#define PG8_LDA(dst, b, h) do { _Pragma("unroll") for (int m = 0; m < 4; ++m) _Pragma("unroll") for (int k = 0; k < 2; ++k) dst[m][k] = *(const LAS bf16x8*)(lds + PG8_SA(b, h) + aoff + m * 2048 + k * 1024); } while (0)
#define PG8_LDB(dst, b, h) do { _Pragma("unroll") for (int n = 0; n < 2; ++n) _Pragma("unroll") for (int k = 0; k < 2; ++k) dst[n][k] = *(const LAS bf16x8*)(lds + PG8_SB(b, h) + boff + n * 2048 + k * 1024); } while (0)
#define PG8_MMA(ai, bj, At, Bt) do { __builtin_amdgcn_s_setprio(1); _Pragma("unroll") for (int m = 0; m < 4; ++m) _Pragma("unroll") for (int n = 0; n < 2; ++n) _Pragma("unroll") for (int k = 0; k < 2; ++k) \
        acc[ai][bj][m][n] = TRANS ? __builtin_amdgcn_mfma_f32_16x16x32_bf16(Bt[n][k], At[m][k], acc[ai][bj][m][n], 0, 0, 0) \
                                  : __builtin_amdgcn_mfma_f32_16x16x32_bf16(At[m][k], Bt[n][k], acc[ai][bj][m][n], 0, 0, 0); __builtin_amdgcn_s_setprio(0); } while (0)
#define PG8_WAIT_V(n) asm volatile("s_waitcnt vmcnt(" #n ")" ::: "memory")
#define PG8_WAIT_L(n) asm volatile("s_waitcnt lgkmcnt(" #n ")" ::: "memory")
#define PG8_BAR __builtin_amdgcn_s_barrier()
#define PG8_SCHED __builtin_amdgcn_sched_barrier(0)
    Unit cur, nxt; int ui = 0;
    if (!S.next(0, cur)) return;
    f32x4 acc[2][2][4][2];
#pragma unroll
    for (int a = 0; a < 2; ++a)
#pragma unroll
        for (int b = 0; b < 2; ++b)
#pragma unroll
            for (int m = 0; m < 4; ++m)
#pragma unroll
                for (int n = 0; n < 2; ++n) acc[a][b][m][n] = (f32x4){0.f, 0.f, 0.f, 0.f};
    bf16x8 At[4][2], B0[2][2], B1[2][2];
    const char* cA = cur.A; const char* cB = cur.B;
    unsigned vA[2] = {voffA_of(cur.mode, RaA[0], CA[0]), voffA_of(cur.mode, RaA[1], CA[1])};
    size_t hA = cur.hstepA, kA = cur.kstepA;
    PG8_STAGE(PG8_SB(0, 0), cB, voffB); PG8_STAGE(PG8_SA(0, 0), cA, vA); PG8_STAGE(PG8_SB(0, 1), cB + hstepB, voffB); PG8_STAGE(PG8_SA(0, 1), cA + hA, vA);
    if (wr == 1) PG8_BAR;
    PG8_WAIT_V(4); PG8_BAR;
    PG8_STAGE(PG8_SB(1, 0), cB + kstep, voffB); PG8_STAGE(PG8_SA(1, 0), cA + kA, vA); PG8_STAGE(PG8_SB(1, 1), cB + hstepB + kstep, voffB);
    PG8_WAIT_V(6); PG8_BAR;
    for (;;) {
        const bool has_next = S.next(ui + 1, nxt);
        const char* nA = has_next ? nxt.A : cA; const char* nB = has_next ? nxt.B : cB;
        unsigned vN[2]; size_t hN, kN;
        if (has_next) { vN[0] = voffA_of(nxt.mode, RaA[0], CA[0]); vN[1] = voffA_of(nxt.mode, RaA[1], CA[1]); hN = nxt.hstepA; kN = nxt.kstepA; } else { vN[0] = vA[0]; vN[1] = vA[1]; hN = hA; kN = kA; }
        for (int t = 0; t < NT; t += 2) {
            const bool last = (t == NT - 2);
            const char* a1 = cA + (size_t)(t + 1) * kA;
            const char* a2 = last ? nA : cA + (size_t)(t + 2) * kA; const char* b2 = last ? nB : cB + (size_t)(t + 2) * kstep;
            const char* a3 = a2 + (last ? kN : kA); const char* b3 = b2 + kstep;
            unsigned v2[2] = {last ? vN[0] : vA[0], last ? vN[1] : vA[1]}; const size_t h2 = last ? hN : hA;
            PG8_LDB(B0, 0, 0); PG8_SCHED; PG8_LDA(At, 0, 0); PG8_STAGE(PG8_SA(1, 1), a1 + hA, vA);
            PG8_WAIT_L(8); PG8_BAR; PG8_WAIT_L(0); PG8_MMA(0, 0, At, B0); PG8_BAR; PG8_SCHED;
            PG8_LDB(B1, 0, 1); PG8_STAGE(PG8_SB(0, 0), b2, voffB);
            PG8_BAR; PG8_WAIT_L(0); PG8_MMA(0, 1, At, B1); PG8_BAR;
            PG8_LDA(At, 0, 1); PG8_STAGE(PG8_SA(0, 0), a2, v2);
            PG8_BAR; PG8_WAIT_L(0); PG8_MMA(1, 0, At, B0); PG8_BAR; PG8_SCHED;
            PG8_STAGE(PG8_SB(0, 1), b2 + hstepB, voffB);
            PG8_WAIT_V(6); PG8_BAR; PG8_MMA(1, 1, At, B1); PG8_BAR;
            PG8_LDB(B0, 1, 0); PG8_SCHED; PG8_LDA(At, 1, 0); PG8_STAGE(PG8_SA(0, 1), a2 + h2, v2);
            PG8_WAIT_L(8); PG8_BAR; PG8_WAIT_L(0); PG8_MMA(0, 0, At, B0); PG8_BAR; PG8_SCHED;
            PG8_LDB(B1, 1, 1); PG8_STAGE(PG8_SB(1, 0), b3, voffB);
            PG8_BAR; PG8_WAIT_L(0); PG8_MMA(0, 1, At, B1); PG8_BAR;
            PG8_LDA(At, 1, 1); PG8_STAGE(PG8_SA(1, 0), a3, v2);
            PG8_BAR; PG8_WAIT_L(0); PG8_MMA(1, 0, At, B0); PG8_BAR; PG8_SCHED;
            PG8_STAGE(PG8_SB(1, 1), b3 + hstepB, voffB);
            PG8_WAIT_V(6); PG8_BAR; PG8_MMA(1, 1, At, B1); PG8_BAR;
        }
        E(acc, cur, wr, wc, fr, fq);
        if (!has_next) break;
#pragma unroll
        for (int a = 0; a < 2; ++a)
#pragma unroll
            for (int b = 0; b < 2; ++b)
#pragma unroll
                for (int m = 0; m < 4; ++m)
#pragma unroll
                    for (int n = 0; n < 2; ++n) acc[a][b][m][n] = (f32x4){0.f, 0.f, 0.f, 0.f};
        cur = nxt; cA = nA; cB = nB; vA[0] = vN[0]; vA[1] = vN[1]; hA = hN; kA = kN; ++ui;
    }
    PG8_WAIT_V(0);
    if (wr == 0) PG8_BAR;
    PG8_BAR;
#undef PG8_SA
#undef PG8_SB
#undef PG8_STAGE
#undef PG8_LDA
#undef PG8_LDB
#undef PG8_MMA
#undef PG8_WAIT_V
#undef PG8_WAIT_L
#undef PG8_BAR
#undef PG8_SCHED
}
}

typedef f32x4 AccT[2][2][4][2];

struct SchedScan {
    int G, c; const char* h; const char* wts;
    __device__ __forceinline__ bool next(int i, pg8::Unit& u) const {
        const int L = i * G + c;
        if (L >= 64 * 49 + 2 * 37) return false;
        int pm, pn;
        if (L < 64 * 49) { pm = L & 63; pn = L >> 6; }
        else { const int r = L - 64 * 49; pm = 64 + (r & 1); int q = r >> 1; pn = (q < 24) ? 8 + q : 36 + (q - 24); }
        u.pm = pm; u.pn = pn; u.B = wts + (size_t)pn * 256 * 4096;
        if (pn >= 32 && pm < 64) {
            const int b = pm >> 5, pp = pm & 31;
            u.A = h + (size_t)(b * 8192 + 2 * pp) * 4096; u.mode = 1u; u.hstepA = 4096u; u.kstepA = 128u;
        } else { u.A = h + (size_t)pm * 256 * 4096; u.mode = 0u; u.hstepA = 128u * 4096u; u.kstepA = 128u; }
        return true;
    }
};
struct SchedStd {
    int G, c, nN; const char* A; const char* B; unsigned mode;
    __device__ __forceinline__ bool next(int i, pg8::Unit& u) const {
        const int L = i * G + c;
        if (L >= 64 * nN) return false;
        u.pm = L & 63; u.pn = L >> 6; u.B = B + (size_t)u.pn * 256 * 4096; u.mode = mode;
        if (mode == 0u) { u.A = A + (size_t)u.pm * 256 * 4096; u.hstepA = 128u * 4096u; u.kstepA = 128u; }
        else if (mode == 2u) { u.A = A + (size_t)u.pm * 8 * 64 * 2048; u.hstepA = 4u * 64u * 2048u; u.kstepA = 4096u; }
        else { const int bb = u.pm >> 5, pp = u.pm & 31;
            u.A = A + ((size_t)(bb * 256 + (pp >> 3)) * 64 * 1024 + (size_t)(4 * (pp & 7)) * 32) * 2; u.hstepA = 2u * 32u * 2u; u.kstepA = 4096u; }
        return true;
    }
};

struct EpiScan {
    unsigned char* ws; const float* lbl;
    __device__ __forceinline__ void operator()(const AccT& acc, const pg8::Unit& u, int wr, int wc, int fr, int fq) const {
        const int pn = u.pn;
        int kind, pl, W; size_t base;
        if (pn < 8) { kind = 0; pl = pn; W = 2048; base = WS_AQ; }
        else if (pn < 16) { kind = 0; pl = pn - 8; W = 2048; base = WS_AV; }
        else if (pn < 24) { kind = 1; pl = pn - 16; W = 2048; base = WS_ALF; }
        else if (pn < 32) { kind = 2; pl = pn - 24; W = 2048; base = WS_ALF + (size_t)NCHUNK * 2048 * 32 * 2; }
        else if (pn < 36) { kind = 3; pl = pn - 32; W = 1024; base = WS_BQ; }
        else if (pn < 40) { kind = 0; pl = pn - 36; W = 1024; base = WS_BK; }
        else if (pn < 48) { kind = 0; pl = pn - 40; W = 2048; base = WS_BV; }
        else { kind = 4; pl = 0; W = 32; base = WS_R; }
#pragma unroll
        for (int bj = 0; bj < 2; ++bj)
#pragma unroll
            for (int n = 0; n < 2; ++n) {
                const int ch = pl * 256 + bj * 128 + wc * 32 + n * 16 + fr;
                float lb = 0.f;
                if (kind == 1 || kind == 2) { const int li = (kind == 2 ? 2048 : 0) + ch; lb = sigmoidf_(lbl[li] - lbl[4096 + li]); }
#pragma unroll
                for (int ai = 0; ai < 2; ++ai)
#pragma unroll
                    for (int q = 0; q < 2; ++q) {
                        const int chunk = u.pm * 8 + ai * 4 + wr * 2 + q;
                        f32x4 v0 = acc[ai][bj][2 * q][n], v1 = acc[ai][bj][2 * q + 1][n];
                        if (kind == 4) {
                            if (wc == 0 && bj == 0) { float* dst = (float*)(ws + base) + ((size_t)chunk * 32 + (n * 16 + fr)) * 32 + 8 * fq; *(f32x4*)dst = v0; *(f32x4*)(dst + 4) = v1; }
                        } else {
                            u32x4 w;
                            if (kind == 1 || kind == 2) {
                                float t[8] = {v0[0], v0[1], v0[2], v0[3], v1[0], v1[1], v1[2], v1[3]};
#pragma unroll
                                for (int e = 0; e < 8; ++e) t[e] = __log2f(lb + (1.0f - lb) * sigmoidf_(t[e]));
                                w.x = pk_f16(t[0], t[1]); w.y = pk_f16(t[2], t[3]); w.z = pk_f16(t[4], t[5]); w.w = pk_f16(t[6], t[7]);
                            } else {
                                if (kind == 3) { v0 = v0 * 0.0625f; v1 = v1 * 0.0625f; }
                                w.x = pk_bf16(v0[0], v0[1]); w.y = pk_bf16(v0[2], v0[3]); w.z = pk_bf16(v1[0], v1[1]); w.w = pk_bf16(v1[2], v1[3]);
                            }
                            u16* dst = (u16*)(ws + base) + (((size_t)chunk * 4 + fq) * W + ch) * 8;
                            *(u32x4*)dst = w;
                        }
                    }
            }
    }
};

struct EpiGate {
    unsigned char* ws; u16* OA; u16* OB; const float* gain_a; const float* gain_b; const unsigned* adone;
    __device__ __forceinline__ void operator()(const AccT& acc, const pg8::Unit& u, int wr, int wc, int fr, int fq) const {
        const int pn = u.pn;
        const int row0 = u.pm * 256 + wr * 64 + fr;
        if (pn < 8 || pn >= 24) {
            unsigned spins = 0;
            while (__hip_atomic_load(adone, __ATOMIC_RELAXED, __HIP_MEMORY_SCOPE_AGENT) < 64u) { __builtin_amdgcn_s_sleep(8); if (++spins > (1u << 22)) break; }
            __builtin_amdgcn_fence(__ATOMIC_ACQUIRE, "agent");
        }
        if (pn >= 16) {
            u16* MG = (u16*)(ws + (pn < 24 ? WS_MGA : WS_MGB));
            const int col0 = ((pn - 16) & 7) * 256 + wc * 32 + 8 * fq;
#pragma unroll
            for (int ai = 0; ai < 2; ++ai)
#pragma unroll
                for (int m = 0; m < 4; ++m) { u16* rowp = MG + (size_t)(row0 + ai * 128 + m * 16) * 2048 + col0;
#pragma unroll
                    for (int bj = 0; bj < 2; ++bj) { const f32x4 v0 = acc[ai][bj][m][0], v1 = acc[ai][bj][m][1]; u32x4 w;
                        w.x = pk_bf16(sigmoidf_(v0[0]), sigmoidf_(v0[1])); w.y = pk_bf16(sigmoidf_(v0[2]), sigmoidf_(v0[3]));
                        w.z = pk_bf16(sigmoidf_(v1[0]), sigmoidf_(v1[1])); w.w = pk_bf16(sigmoidf_(v1[2]), sigmoidf_(v1[3]));
                        *(u32x4*)(rowp + bj * 128) = w; } }
        } else {
            const bool isA = pn < 8; const int pl = isA ? pn : pn - 8;
            u16* O = isA ? OA : OB; const float* gain = isA ? gain_a : gain_b;
            const float* SS = (const float*)(ws + (isA ? WS_SSA : WS_SSB));
            const int col0 = pl * 256 + wc * 32 + 8 * fq;
            f32x4 g[2][2];
#pragma unroll
            for (int bj = 0; bj < 2; ++bj) { g[bj][0] = *(const f32x4*)(gain + col0 + bj * 128); g[bj][1] = *(const f32x4*)(gain + col0 + bj * 128 + 4); }
#pragma unroll
            for (int ai = 0; ai < 2; ++ai)
#pragma unroll
                for (int m = 0; m < 4; ++m) {
                    const int row = row0 + ai * 128 + m * 16;
                    float rstd[2];
                    if (isA) {
#pragma unroll
                        for (int bj = 0; bj < 2; ++bj) { const f32x4 s = *(const f32x4*)(SS + (size_t)row * 64 + (pl * 2 + bj) * 4); rstd[bj] = rsqrtf(((s[0] + s[1]) + (s[2] + s[3])) * (1.0f / 128.0f) + EPS); }
                    } else {
                        const float* sp = SS + (size_t)row * 64 + (pl >> 1) * 16; float t = 0.f;
#pragma unroll
                        for (int k = 0; k < 4; ++k) { const f32x4 s = *(const f32x4*)(sp + 4 * k); t += (s[0] + s[1]) + (s[2] + s[3]); }
                        rstd[0] = rstd[1] = rsqrtf(t * (1.0f / 512.0f) + EPS);
                    }
                    size_t tb;
                    if (isA) tb = ((size_t)(row >> 5) * 64) * 1024 + (size_t)(row & 31) * 32;
                    else { const int bb = row >> 13, t = row & 8191, ps = (t & 63) * 128 + (t >> 6); tb = ((size_t)(bb * 256 + (ps >> 5)) * 64) * 1024 + (size_t)(ps & 31) * 32; }
                    u16* rowp = O + tb + (size_t)(col0 >> 5) * 1024 + (col0 & 31);
#pragma unroll
                    for (int bj = 0; bj < 2; ++bj) {
                        const u32x4 ov = *(const u32x4*)(rowp + bj * 4 * 1024);
                        const f32x4 a0 = acc[ai][bj][m][0], a1 = acc[ai][bj][m][1];
                        float o[8] = {bf_lo(ov.x), bf_hi(ov.x), bf_lo(ov.y), bf_hi(ov.y), bf_lo(ov.z), bf_hi(ov.z), bf_lo(ov.w), bf_hi(ov.w)};
                        float gt[8] = {a0[0], a0[1], a0[2], a0[3], a1[0], a1[1], a1[2], a1[3]};
                        float gg[8] = {g[bj][0][0], g[bj][0][1], g[bj][0][2], g[bj][0][3], g[bj][1][0], g[bj][1][1], g[bj][1][2], g[bj][1][3]};
#pragma unroll
                        for (int e = 0; e < 8; ++e) o[e] = (o[e] * rstd[bj] * gg[e]) * (gt[e] * sigmoidf_(gt[e]));
                        u32x4 w; w.x = pk_bf16(o[0], o[1]); w.y = pk_bf16(o[2], o[3]); w.z = pk_bf16(o[4], o[5]); w.w = pk_bf16(o[6], o[7]);
                        *(u32x4*)(rowp + bj * 4 * 1024) = w;
                    }
                }
        }
    }
};
constexpr int NAG_SCAN = 8;
struct SchedHelp {
    int id; int n_first; const char* A; const char* B;
    __device__ __forceinline__ bool next(int i, pg8::Unit& u) const {
        int pm, tile;
        if (i < n_first) { const int L = i * 128 + id; pm = L & 63; tile = 16 + (L >> 6); }
        else { const int L = (i - n_first) * 192 + id; if (L >= 512 + 64 * NAG_SCAN) return false;
            if (L < 512) { pm = L & 63; tile = 24 + (L >> 6); } else { pm = (L - 512) & 63; tile = (L - 512) >> 6; } }
        u.pm = pm; u.pn = tile; u.A = A + (size_t)pm * 256 * 4096; u.B = B + (size_t)tile * 256 * 4096; u.mode = 0u; u.hstepA = 128u * 4096u; u.kstepA = 128u;
        return true;
    }
};
struct SchedTiles {
    int G, c, tile0, nT; const char* A; const char* B;
    __device__ __forceinline__ bool next(int i, pg8::Unit& u) const {
        const int L = i * G + c;
        if (L >= 64 * nT) return false;
        u.pm = L & 63; u.pn = tile0 + (L >> 6); u.A = A + (size_t)u.pm * 256 * 4096; u.B = B + (size_t)u.pn * 256 * 4096; u.mode = 0u; u.hstepA = 128u * 4096u; u.kstepA = 128u;
        return true;
    }
};

template <int SECOND> struct EpiY {
    unsigned char* ws;
    __device__ __forceinline__ void operator()(const AccT& acc, const pg8::Unit& u, int wr, int wc, int fr, int fq) const {
        const u16* MG = (const u16*)(ws + (SECOND ? WS_MGB : WS_MGA)); u16* Y = (u16*)(ws + WS_Y);
        const int row0 = u.pm * 256 + wr * 64 + fr, col0 = u.pn * 256 + wc * 32 + 8 * fq;
#pragma unroll
        for (int ai = 0; ai < 2; ++ai)
#pragma unroll
            for (int m = 0; m < 4; ++m) { const int row = row0 + ai * 128 + m * 16;
#pragma unroll
                for (int bj = 0; bj < 2; ++bj) {
                    const u32x4 mv = *(const u32x4*)(MG + (size_t)row * 2048 + col0 + bj * 128);
                    const f32x4 a0 = acc[ai][bj][m][0], a1 = acc[ai][bj][m][1];
                    float o[8] = {a0[0] * bf_lo(mv.x), a0[1] * bf_hi(mv.x), a0[2] * bf_lo(mv.y), a0[3] * bf_hi(mv.y), a1[0] * bf_lo(mv.z), a1[1] * bf_hi(mv.z), a1[2] * bf_lo(mv.w), a1[3] * bf_hi(mv.w)};
                    u16* yp = Y + (size_t)row * 2048 + col0 + bj * 128;
                    if (SECOND) { const u32x4 yv = *(const u32x4*)yp;
                        o[0] += bf_lo(yv.x); o[1] += bf_hi(yv.x); o[2] += bf_lo(yv.y); o[3] += bf_hi(yv.y); o[4] += bf_lo(yv.z); o[5] += bf_hi(yv.z); o[6] += bf_lo(yv.w); o[7] += bf_hi(yv.w); }
                    u32x4 w; w.x = pk_bf16(o[0], o[1]); w.y = pk_bf16(o[2], o[3]); w.z = pk_bf16(o[4], o[5]); w.w = pk_bf16(o[6], o[7]);
                    *(u32x4*)yp = w;
                } }
    }
};

struct SchedY {
    int G, c; const char* OA; const char* OB; const char* WP;
    __device__ __forceinline__ bool next(int i, pg8::Unit& u) const {
        const int L = (i >> 1) * G + c;
        if (L >= 512) return false;
        const int pm = L & 63, pn = L >> 6; u.pm = pm; u.kstepA = 4096u;
        if ((i & 1) == 0) { u.pn = pn | 0x100; u.mode = 2u; u.A = OA + (size_t)pm * 8 * 64 * 2048; u.hstepA = 4u * 64u * 2048u; u.B = WP + (size_t)pn * 256 * 4096; }
        else { u.pn = pn; u.mode = 3u; const int bb = pm >> 5, pp = pm & 31;
            u.A = OB + ((size_t)(bb * 256 + (pp >> 3)) * 64 * 1024 + (size_t)(4 * (pp & 7)) * 32) * 2; u.hstepA = 2u * 32u * 2u; u.B = WP + (size_t)2048 * 4096 + (size_t)pn * 256 * 4096; }
        return true;
    }
};
struct EpiY2 {
    unsigned char* ws;
    __device__ __forceinline__ void operator()(const AccT& acc, const pg8::Unit& u, int wr, int wc, int fr, int fq) const {
        pg8::Unit v = u; v.pn = u.pn & 0xff;
        if (u.pn & 0x100) { EpiY<0> e{ws}; e(acc, v, wr, wc, fr, fq); } else { EpiY<1> e{ws}; e(acc, v, wr, wc, fr, fq); }
    }
};

struct EpiOut {
    const float* x; float* out; const float* mod; float* sso;
    __device__ __forceinline__ void operator()(const AccT& acc, const pg8::Unit& u, int wr, int wc, int fr, int fq) const {
        const int row0 = u.pm * 256 + wr * 64 + fr, col0 = u.pn * 256 + wc * 32 + 4 * fq;
        const float* gate = mod + (size_t)(u.pm >> 5) * 6144 + 4096;
        f32x4 gv[2][2];
#pragma unroll
        for (int bj = 0; bj < 2; ++bj)
#pragma unroll
            for (int n = 0; n < 2; ++n) gv[bj][n] = *(const f32x4*)(gate + col0 + bj * 128 + n * 16);
#pragma unroll
        for (int ai = 0; ai < 2; ++ai)
#pragma unroll
            for (int mh = 0; mh < 2; ++mh) {
                f32x4 xv[2][2][2];
#pragma unroll
                for (int mm = 0; mm < 2; ++mm) { const size_t off = (size_t)(row0 + ai * 128 + (2 * mh + mm) * 16) * 2048 + col0;
#pragma unroll
                    for (int bj = 0; bj < 2; ++bj)
#pragma unroll
                        for (int n = 0; n < 2; ++n) xv[mm][bj][n] = *(const f32x4*)(x + off + bj * 128 + n * 16); }
#pragma unroll
                for (int mm = 0; mm < 2; ++mm) { const int m = 2 * mh + mm; const int row = row0 + ai * 128 + m * 16; const size_t off = (size_t)row * 2048 + col0; float s = 0.f;
#pragma unroll
                    for (int bj = 0; bj < 2; ++bj)
#pragma unroll
                        for (int n = 0; n < 2; ++n) { const f32x4 o = xv[mm][bj][n] + gv[bj][n] * acc[ai][bj][m][n];
                            *(f32x4*)(out + off + bj * 128 + n * 16) = o; s += (o[0] * o[0] + o[1] * o[1]) + (o[2] * o[2] + o[3] * o[3]); }
                    s += __shfl_xor(s, 16); s += __shfl_xor(s, 32);
                    if (fq == 0) sso[(size_t)row * 32 + u.pn * 4 + wc] = s; }
            }
    }
};

__device__ __forceinline__ void transpose_item(const float* W, int N, int n0, int k0, u16* WTrow0, LAS float* scr, int lane) {
    float tv[32];
#pragma unroll
    for (int i = 0; i < 32; ++i) tv[i] = W[(size_t)(k0 + 2 * i + (lane >> 5)) * N + n0 + (lane & 31)];
#pragma unroll
    for (int i = 0; i < 32; ++i) scr[(2 * i + (lane >> 5)) * 33 + (lane & 31)] = tv[i];
    LDS_WAIT(); asm volatile("" ::: "memory");
    const int c = lane & 7;
#pragma unroll
    for (int j = 0; j < 4; ++j) { const int n = (lane >> 3) + 8 * j; const LAS float* s = scr + (8 * c) * 33 + n;
        u32x4 o; o.x = pk_bf16(s[0 * 33], s[1 * 33]); o.y = pk_bf16(s[2 * 33], s[3 * 33]); o.z = pk_bf16(s[4 * 33], s[5 * 33]); o.w = pk_bf16(s[6 * 33], s[7 * 33]);
        *(u32x4*)(WTrow0 + (size_t)n * 2048 + k0 + 8 * c) = o; }
    LDS_WAIT(); asm volatile("" ::: "memory");
}

__device__ __forceinline__ void phase0(const Params& p, LAS unsigned char* lds) {
    const int tid = threadIdx.x, wid = tid >> 6, lane = tid & 63;
    unsigned char* ws = p.ws;
    if (blockIdx.x < 192) {
        LAS float* sl = (LAS float*)lds;
        LAS float* red = (LAS float*)lds + 6144;
        for (int i = tid; i < 3 * 2048; i += 512) { const int v = i >> 11, d = i & 2047; const float cv = (v < 2) ? p.c[v * 2048 + d] : p.c_ctx[d]; sl[i] = cv * sigmoidf_(cv); }
        __syncthreads();
        const int cg4 = tid & 7, kl = tid >> 3;
        const int col = blockIdx.x * 32 + cg4 * 4;
        f32x4 a0 = {0, 0, 0, 0}, a1 = {0, 0, 0, 0}, a2 = {0, 0, 0, 0};
#pragma unroll 8
        for (int k = kl; k < 2048; k += 64) { const f32x4 w = *(const f32x4*)(p.w_ada + (size_t)k * 6144 + col); a0 += sl[k] * w; a1 += sl[2048 + k] * w; a2 += sl[4096 + k] * w; }
        LAS float* rp = red + tid * 12;
#pragma unroll
        for (int e = 0; e < 4; ++e) { rp[e] = a0[e]; rp[4 + e] = a1[e]; rp[8 + e] = a2[e]; }
        __syncthreads();
        if (tid < 96) { const int v = tid >> 5, cc = tid & 31, g4 = cc >> 2, e = cc & 3; float s = 0.f;
            for (int k = 0; k < 64; ++k) s += red[(k * 8 + g4) * 12 + v * 4 + e];
            ((float*)(ws + WS_MOD))[v * 6144 + blockIdx.x * 32 + cc] = s + p.b_ada[blockIdx.x * 32 + cc]; }
        __syncthreads();
    }
    LAS float* scr = (LAS float*)(lds + 65536 + wid * 8448);
    const int gw = blockIdx.x * 8 + wid, NGW = gridDim.x * 8;
    constexpr int I_IN = 32 * 641;
    u16* WTS = (u16*)(ws + WS_WTS); u16* WTG = (u16*)(ws + WS_WTG);
    for (int it = gw; it < I_IN; it += NGW) {
        const int kb = it / 641, cb = it - kb * 641, n0 = cb * 32;
        u16* dst;
        if (n0 < 8192) dst = WTS + (size_t)n0 * 2048;
        else if (n0 < 10240) dst = WTG + (size_t)(n0 - 8192) * 2048;
        else if (n0 < 14336) dst = WTS + (size_t)(8192 + n0 - 10240) * 2048;
        else if (n0 == 14336) dst = WTS + (size_t)12288 * 2048;
        else if (n0 < 16416) dst = WTG + (size_t)(2048 + n0 - 14368) * 2048;
        else dst = WTG + (size_t)(4096 + n0 - 16416) * 2048;
        transpose_item(p.w_in, N_IN, n0, kb * 64, dst, scr, lane);
    }
    { u32x4* z = (u32x4*)(WTS + (size_t)12320 * 2048); const int nz = 224 * 2048 * 2 / 16;
      for (int i = blockIdx.x * 512 + tid; i < nz; i += gridDim.x * 512) z[i] = (u32x4){0u, 0u, 0u, 0u}; }
}

__device__ __forceinline__ void phase_wtp(const Params& p, LAS unsigned char* lds) {
    const int tid = threadIdx.x, wid = tid >> 6, lane = tid & 63;
    LAS float* scr = (LAS float*)(lds + wid * 8448);
    const int gw = blockIdx.x * 8 + wid, NGW = gridDim.x * 8;
    u16* WTP = (u16*)(p.ws + WS_WTP);
    for (int it = gw; it < 3 * 2048; it += NGW) {
        const int which = it >> 11, r = it & 2047;
        const float* W = which == 0 ? p.w_pa : (which == 1 ? p.w_pb : p.w_out);
        const int kb = r >> 6, cb = r & 63;
        transpose_item(W, 2048, cb * 32, kb * 64, WTP + (size_t)which * 2048 * 2048 + (size_t)(cb * 32) * 2048, scr, lane);
    }
    __syncthreads();
}

__device__ __forceinline__ void phase1(const Params& p) {
    const int tid = threadIdx.x, wid = tid >> 6, lane = tid & 63;
    const float* mod = (const float*)(p.ws + WS_MOD);
    u16* H = (u16*)(p.ws + WS_H);
    for (int i = blockIdx.x * 512 + tid; i < 64 * 256 * 4; i += gridDim.x * 512) ((unsigned*)(p.ws + WS_FLG))[i] = 0u;
    if (blockIdx.x == 0 && tid == 0) *(unsigned*)(p.ws + 256) = 0u;
    for (int m0 = 2 * (blockIdx.x * 8 + wid); m0 < M_ALL; m0 += 2 * gridDim.x * 8) {
        f32x4 xv[2][8]; float ss[2] = {0.f, 0.f};
#pragma unroll
        for (int rr = 0; rr < 2; ++rr) { const int m = m0 + rr;
            const float* src = (m < M_LAT) ? p.x + (size_t)m * D : p.ctx + (size_t)(m - M_LAT) * D;
            const f32x4* s4 = (const f32x4*)src + lane;
#pragma unroll
            for (int j = 0; j < 8; ++j) xv[rr][j] = s4[64 * j]; }
#pragma unroll
        for (int rr = 0; rr < 2; ++rr)
#pragma unroll
            for (int j = 0; j < 8; ++j) ss[rr] += (xv[rr][j][0] * xv[rr][j][0] + xv[rr][j][1] * xv[rr][j][1]) + (xv[rr][j][2] * xv[rr][j][2] + xv[rr][j][3] * xv[rr][j][3]);
#pragma unroll
        for (int rr = 0; rr < 2; ++rr) { const int m = m0 + rr;
            const int v = (m < M_LAT) ? (m >> 13) : 2;
            const float rstd = rsqrtf(wave_sum(ss[rr]) * (1.0f / D) + EPS);
            u32x2* o8 = (u32x2*)(H + (size_t)m * D) + lane;
#pragma unroll
            for (int j = 0; j < 8; ++j) { const int col = 4 * (lane + 64 * j);
                const f32x4 g = *(const f32x4*)(p.norm_g + col), sh = *(const f32x4*)(mod + v * 6144 + col), sc = *(const f32x4*)(mod + v * 6144 + 2048 + col);
                const f32x4 y = (xv[rr][j] * rstd * g) * (sc + 1.0f) + sh;
                o8[64 * j] = (u32x2){pk_bf16(y[0], y[1]), pk_bf16(y[2], y[3])}; } }
    }
}

__device__ __forceinline__ void phase2b(const Params& p, LAS unsigned char* lds) {
    const int tid = threadIdx.x;
    const float* R = (const float*)(p.ws + WS_R);
    u16* LFB = (u16*)(p.ws + WS_LFB);
    LAS float* rs = (LAS float*)lds;
    float w[2][2][16], bias[2][2];
#pragma unroll
    for (int d = 0; d < 2; ++d)
#pragma unroll
        for (int cc = 0; cc < 2; ++cc) { bias[d][cc] = p.gk_b[d * 1024 + cc * 512 + tid];
#pragma unroll
            for (int r = 0; r < 16; ++r) w[d][cc][r] = p.gk_w[(size_t)(d * 16 + r) * 1024 + cc * 512 + tid]; }
    int buf = 0;
    for (int chunk = blockIdx.x; chunk < NCHUNK; chunk += gridDim.x, buf ^= 1) {
        LAS float* rb = rs + buf * 1024;
        { const f32x2 v = *(const f32x2*)(R + (size_t)chunk * 1024 + 2 * tid); *(LAS f32x2*)(rb + 2 * tid) = v; }
        __syncthreads();
#pragma unroll
        for (int d = 0; d < 2; ++d)
#pragma unroll 1
            for (int t8 = 0; t8 < 4; ++t8) {
                float z[2][8];
#pragma unroll
                for (int cc = 0; cc < 2; ++cc)
#pragma unroll
                    for (int e = 0; e < 8; ++e) z[cc][e] = bias[d][cc];
#pragma unroll
                for (int r = 0; r < 16; ++r) {
                    LAS float* ra = rb + (d * 16 + r) * 32 + t8 * 8; asm volatile("" : "+v"(ra));
                    const f32x4 r0 = *(const LAS f32x4*)ra, r1 = *(const LAS f32x4*)(ra + 4);
#pragma unroll
                    for (int cc = 0; cc < 2; ++cc) { const float ww = w[d][cc][r];
#pragma unroll
                        for (int e = 0; e < 4; ++e) { z[cc][e] = __builtin_fmaf(r0[e], ww, z[cc][e]); z[cc][4 + e] = __builtin_fmaf(r1[e], ww, z[cc][4 + e]); } }
                }
#pragma unroll
                for (int cc = 0; cc < 2; ++cc) {
                    float zz[8];
#pragma unroll
                    for (int e = 0; e < 8; ++e) zz[e] = z[cc][e];
#pragma unroll
                    for (int e = 0; e < 8; ++e) { const float a = fabsf(zz[e]); zz[e] = (fminf(zz[e], 0.f) - __logf(1.0f + __expf(-a))) * (0.0625f * 1.4426950408889634f); }
                    u32x4 o; o.x = pk_f16(zz[0], zz[1]); o.y = pk_f16(zz[2], zz[3]); o.z = pk_f16(zz[4], zz[5]); o.w = pk_f16(zz[6], zz[7]);
                    *(u32x4*)(LFB + ((((size_t)d * NCHUNK + chunk) * 4 + t8) * 1024 + cc * 512 + tid) * 8) = o;
                }
            }
    }
    __syncthreads();
}

__device__ __forceinline__ bf16x8 pack8(const f32x16& x, int s) {
    u32x4 pk; pk.x = pk_bf16(x[8 * s + 0], x[8 * s + 1]); pk.y = pk_bf16(x[8 * s + 2], x[8 * s + 3]); pk.z = pk_bf16(x[8 * s + 4], x[8 * s + 5]); pk.w = pk_bf16(x[8 * s + 6], x[8 * s + 7]);
    return __builtin_bit_cast(bf16x8, pk);
}
__device__ __forceinline__ unsigned rot16(unsigned x) { return (x >> 16) | (x << 16); }
template <int NW> __device__ __forceinline__ void maybe_rev(unsigned (&w)[NW], bool rev) {
    unsigned r[NW];
#pragma unroll
    for (int k = 0; k < NW; ++k) r[k] = rot16(w[NW - 1 - k]);
#pragma unroll
    for (int k = 0; k < NW; ++k) w[k] = rev ? r[k] : w[k];
}
__device__ __forceinline__ void ld16(unsigned (&w)[8], const u16* p) { const u32x4 a = *(const u32x4*)p, b = *(const u32x4*)(p + 8); w[0] = a.x; w[1] = a.y; w[2] = a.z; w[3] = a.w; w[4] = b.x; w[5] = b.y; w[6] = b.z; w[7] = b.w; }
__device__ __forceinline__ void ld16q(unsigned (&w)[8], const u16* p, size_t qstride) { const u32x4 a = *(const u32x4*)p, b = *(const u32x4*)(p + qstride); w[0] = a.x; w[1] = a.y; w[2] = a.z; w[3] = a.w; w[4] = b.x; w[5] = b.y; w[6] = b.z; w[7] = b.w; }
__device__ __forceinline__ void ld32(unsigned (&w)[16], const u16* p) {
#pragma unroll
    for (int k = 0; k < 4; ++k) { const u32x4 a = *(const u32x4*)(p + 8 * k); w[4 * k] = a.x; w[4 * k + 1] = a.y; w[4 * k + 2] = a.z; w[4 * k + 3] = a.w; }
}

#define DSR128(dst, addr, off) asm volatile("ds_read_b128 %0, %1 offset:%2" : "=v"(dst) : "v"(addr), "i"(off))
#define SBAR() do { asm volatile("s_waitcnt lgkmcnt(0)" ::: "memory"); __builtin_amdgcn_s_barrier(); asm volatile("" ::: "memory"); } while (0)
__device__ __forceinline__ f32x2 h2_sel(unsigned w0, unsigned w1, int hi) { return (f32x2){h_sel(w0, hi), h_sel(w1, hi)}; }
__device__ __forceinline__ f32x2 bf2_sel(unsigned w0, unsigned w1, int hi) { return (f32x2){bf_sel(w0, hi), bf_sel(w1, hi)}; }
#define GLD128(dst, ptr) asm volatile("global_load_dwordx4 %0, %1, off" : "=v"(dst) : "v"(ptr) : "memory")
#define GLD128_SC1(dst, ptr, off) asm volatile("global_load_dwordx4 %0, %1, off offset:%2 sc1" : "=v"(dst) : "v"(ptr), "i"(off) : "memory")
__device__ __forceinline__ unsigned wsel(const u32x4 (&v)[2], int w) { return v[w >> 2][w & 3]; }
__device__ __forceinline__ float vmul(float a, float b) { float r; asm("v_mul_f32_e32 %0, %1, %2" : "=v"(r) : "v"(a), "v"(b)); return r; }
__device__ __forceinline__ float vmul_v(float a, float b) { float r; asm volatile("v_mul_f32_e32 %0, %1, %2" : "=v"(r) : "v"(a), "v"(b)); return r; }
__device__ __forceinline__ float vmul_t(float a, float b) { float r; asm("s_nop 1\n\tv_mul_f32_e32 %0, %1, %2" : "=v"(r) : "v"(a), "v"(b)); return r; }
template <int DK, bool IS_A, int DIRC>
__device__ __forceinline__ void producer_loop(const Params& p, LAS unsigned char* lds, int b, int hh, int quarter, int pair, int pw, int ptid, int lane) {
    constexpr int QSTR = DK * 2 + 16, RSTR = 80;
    constexpr int OFF_KS = 32 * QSTR, OFF_KST = 2 * 32 * QSTR, OFF_VT = OFF_KST + DK * RSTR, OFF_DD = OFF_VT + 128 * RSTR, OFF_PD = OFF_DD + DK * 4, BUFB = OFF_PD + 4 * 32 * RSTR;
    constexpr int dir = DIRC;
    constexpr int NS = IS_A ? 6 : 14;
    const int h = lane >> 5, l31 = lane & 31;
    unsigned char* ws = p.ws;
    const u16* Qg = (const u16*)(ws + (IS_A ? WS_AQ : WS_BQ));
    const u16* Kg = (const u16*)(ws + WS_BK);
    const u16* Vg = (const u16*)(ws + (IS_A ? WS_AV : WS_BV));
    const u16* LFg = IS_A ? (const u16*)(ws + WS_ALF) + (size_t)dir * NCHUNK * 2048 * 32 : (const u16*)(ws + WS_LFB) + (size_t)dir * NCHUNK * 1024 * 32;
    unsigned* flg = (unsigned*)(ws + WS_FLG) + pair * 1024;
    const u16* Ogc = (const u16*)p.out + (IS_A ? 0 : (size_t)M_LAT * 2048);
    (void)ptid; (void)Kg;
#define STEP_CHUNK(k, is_ctx_, lc_, cidx_) const bool is_ctx_ = (k) < 8; const int lc_ = is_ctx_ ? (dir ? 7 - (k) : (k)) : (dir ? 263 - (k) : (k) - 8); const int cidx_ = is_ctx_ ? 512 + b * 8 + lc_ : b * 256 + lc_;
#define PD_LOADS(kq_, PD4) do { \
        STEP_CHUNK(kq_, icf, lcf, cidxf); (void)icf; (void)cidxf; \
        const u16* src = Ogc + ((size_t)(b * 256 + lcf) * 64 + (IS_A ? hh * 4 : hh * 16 + quarter * 4) + pw) * 1024 + lane * 8; \
        GLD128_SC1(PD4[0], src, 0); GLD128_SC1(PD4[1], src, 1024); \
    } while (0)
#define PD_ISSUE(kk, PD4) do { const int kq2_ = ((kk) >= 136 && (kk) < 264) ? (kk) : 136; PD_LOADS(kq2_, PD4); } while (0)
#define PD_FIRST(kk, PD4) do { if ((kk) == 136) { \
        STEP_CHUNK(136, icg, lcg, cidxg); (void)icg; (void)cidxg; unsigned spins = 0; \
        while (__hip_atomic_load(flg + lcg * 4 + pw, __ATOMIC_RELAXED, __HIP_MEMORY_SCOPE_AGENT) == 0u) { __builtin_amdgcn_s_sleep(2); if (++spins > (1u << 22)) break; } \
        PD_LOADS(136, PD4); \
        asm volatile("s_waitcnt vmcnt(0)" : "+v"(PD4[0]), "+v"(PD4[1])); } } while (0)
#define PD_STORE(PD4) do { _Pragma("unroll") for (int j_ = 0; j_ < 2; ++j_) *(LAS u32x4*)(buf + OFF_PD + (pw * 32 + 16 * j_ + (lane >> 2)) * RSTR + (lane & 3) * 16) = PD4[j_]; } while (0)
#define BUF_PTRS(kk) LAS unsigned char* buf = lds + ((kk) & 1) * BUFB; LAS unsigned char* QS = buf; LAS unsigned char* KS = buf + OFF_KS; LAS unsigned char* KST = buf + OFF_KST; LAS unsigned char* VT = buf + OFF_VT; LAS float* DD = (LAS float*)(buf + OFF_DD);
#define WAITV(n, ...) asm volatile("s_waitcnt vmcnt(" #n ")" : __VA_ARGS__)
    if (IS_A) {
        const int c = 32 * pw + l31, th = h;
#define LOAD_A(LF, QW, VW, kk) do { const int kl_ = (kk) < 264 ? (kk) : 263; STEP_CHUNK(kl_, ic, lc, cidx); (void)lc; (void)ic; \
            const size_t eo = (((size_t)cidx * 4 + 2 * th) * 2048 + hh * 128 + c) * 8; \
            GLD128(LF[0], LFg + eo); GLD128(LF[1], LFg + eo + 2048 * 8); GLD128(QW[0], Qg + eo); GLD128(QW[1], Qg + eo + 2048 * 8); GLD128(VW[0], Vg + eo); GLD128(VW[1], Vg + eo + 2048 * 8); } while (0)
#define PROC_A(LF, QW, VW, kk, PC, PN) do { \
            BUF_PTRS(kk) \
            PD_FIRST(kk, PC); \
            PD_ISSUE((kk) + 1, PN); \
            asm volatile("s_waitcnt vmcnt(10)" : "+v"(LF[0]), "+v"(LF[1]), "+v"(QW[0]), "+v"(QW[1]), "+v"(VW[0]), "+v"(VW[1]));     \
            float E[16], kk_[16]; float run = 1.f; \
            _Pragma("unroll") for (int it_ = 0; it_ < 16; ++it_) { const int it = dir ? 15 - it_ : it_; const float f = __builtin_amdgcn_exp2f(h_sel(wsel(LF, it >> 1), it & 1)); run = vmul_t(run, f); E[it] = run; kk_[it] = 1.0f - f; } \
            const float other = __shfl_xor(run, 32); \
            const float pre = (dir ? (th == 0) : (th == 1)) ? other : 1.0f; \
            unsigned kst[8]; \
            _Pragma("unroll") for (int it = 0; it < 16; it += 2) { \
                float ks2[2]; \
                _Pragma("unroll") for (int e = 0; e < 2; ++e) { const int i2 = it + e; const float ev = vmul(E[i2], pre); const float qs = vmul(bf_sel(wsel(QW, i2 >> 1), i2 & 1), ev); ks2[e] = vmul_t(kk_[i2], __builtin_amdgcn_rcpf(fmaxf(ev, 1e-30f))); \
                    const int i = 16 * th + i2; \
                    *(LAS u16*)(QS + i * QSTR + c * 2) = (u16)(pk_bf16(qs, 0.f) & 0xffffu); \
                    *(LAS u16*)(KS + i * QSTR + c * 2) = (u16)(pk_bf16(ks2[e], 0.f) & 0xffffu); } \
                kst[it >> 1] = pk_bf16(ks2[0], ks2[1]); \
            } \
            if (dir ? (th == 0) : (th == 1)) DD[c] = vmul(dir ? E[0] : E[15], pre); \
            *(LAS u32x4*)(KST + c * RSTR + th * 32) = (u32x4){kst[0], kst[1], kst[2], kst[3]}; \
            *(LAS u32x4*)(KST + c * RSTR + th * 32 + 16) = (u32x4){kst[4], kst[5], kst[6], kst[7]}; \
            *(LAS u32x4*)(VT + c * RSTR + th * 32) = VW[0]; \
            *(LAS u32x4*)(VT + c * RSTR + th * 32 + 16) = VW[1]; \
            asm volatile("s_waitcnt vmcnt(8)" : "+v"(PC[0]), "+v"(PC[1]));     \
            PD_STORE(PC); \
        } while (0)
        static_assert(NS == 6 || !IS_A, "wait counts");
        u32x4 lf0[2], q0_[2], v0_[2], lf1[2], q1_[2], v1_[2]; u32x4 pe[2], po[2];
        LOAD_A(lf0, q0_, v0_, 0); PD_ISSUE(0, pe); LOAD_A(lf1, q1_, v1_, 1);
#pragma unroll 1
        for (int k = 0; k < 264; k += 2) {
            PROC_A(lf0, q0_, v0_, k, pe, po); LOAD_A(lf0, q0_, v0_, k + 2); SBAR();
            PROC_A(lf1, q1_, v1_, k + 1, po, pe); LOAD_A(lf1, q1_, v1_, k + 3); SBAR();
        }
        asm volatile("s_waitcnt vmcnt(0)" ::: "memory");
#undef LOAD_A
#undef PROC_A
    } else {
        const int cp = 32 * pw + l31, th = h;
        const int col = ptid & 127, thv = ptid >> 7;
#define LOAD_B(LF, QW, KW, VW, kk) do { const int kl_ = (kk) < 264 ? (kk) : 263; STEP_CHUNK(kl_, ic, lc, cidx); (void)lc; (void)ic; \
            const size_t eo = (((size_t)cidx * 4 + 2 * th) * 1024 + hh * 256 + 2 * cp) * 8; const size_t evv = (((size_t)cidx * 4 + 2 * thv) * 2048 + hh * 512 + quarter * 128 + col) * 8; \
            GLD128(LF[0][0], LFg + eo); GLD128(LF[0][1], LFg + eo + 1024 * 8); GLD128(LF[1][0], LFg + eo + 8); GLD128(LF[1][1], LFg + eo + 8 + 1024 * 8); \
            GLD128(KW[0][0], Kg + eo); GLD128(KW[0][1], Kg + eo + 1024 * 8); GLD128(KW[1][0], Kg + eo + 8); GLD128(KW[1][1], Kg + eo + 8 + 1024 * 8); \
            GLD128(QW[0][0], Qg + eo); GLD128(QW[0][1], Qg + eo + 1024 * 8); GLD128(QW[1][0], Qg + eo + 8); GLD128(QW[1][1], Qg + eo + 8 + 1024 * 8); \
            GLD128(VW[0], Vg + evv); GLD128(VW[1], Vg + evv + 2048 * 8); } while (0)
#define PROC_B(LF, QW, KW, VW, kk, PC, PN) do { \
            BUF_PTRS(kk) \
            PD_FIRST(kk, PC); \
            PD_ISSUE((kk) + 1, PN); \
            asm volatile("s_waitcnt vmcnt(18)" : "+v"(LF[0][0]), "+v"(LF[0][1]), "+v"(LF[1][0]), "+v"(LF[1][1]), "+v"(KW[0][0]), "+v"(KW[0][1]), "+v"(KW[1][0]), "+v"(KW[1][1]), \
                         "+v"(QW[0][0]), "+v"(QW[0][1]), "+v"(QW[1][0]), "+v"(QW[1][1]), "+v"(VW[0]), "+v"(VW[1]));     \
            float E0[16], E1[16]; float r0 = 1.f, r1 = 1.f; \
            _Pragma("unroll") for (int it_ = 0; it_ < 16; ++it_) { const int it = dir ? 15 - it_ : it_; \
                const float f0 = __builtin_amdgcn_exp2f(h_sel(wsel(LF[0], it >> 1), it & 1)), f1 = __builtin_amdgcn_exp2f(h_sel(wsel(LF[1], it >> 1), it & 1)); \
                r0 = vmul_t(r0, f0); r1 = vmul_t(r1, f1); E0[it] = r0; E1[it] = r1; } \
            const float o0 = __shfl_xor(r0, 32), o1 = __shfl_xor(r1, 32); \
            const bool tail = dir ? (th == 0) : (th == 1); \
            const float pre0 = tail ? o0 : 1.f, pre1 = tail ? o1 : 1.f; \
            unsigned kst0[8], kst1[8]; \
            _Pragma("unroll") for (int it = 0; it < 16; it += 2) { \
                float ka[2], kb[2]; \
                _Pragma("unroll") for (int e = 0; e < 2; ++e) { const int i2 = it + e; const float ev0 = vmul(E0[i2], pre0), ev1 = vmul(E1[i2], pre1); \
                    const float qs0 = vmul(bf_sel(wsel(QW[0], i2 >> 1), i2 & 1), ev0), qs1 = vmul(bf_sel(wsel(QW[1], i2 >> 1), i2 & 1), ev1); \
                    ka[e] = vmul_t(bf_sel(wsel(KW[0], i2 >> 1), i2 & 1), __builtin_amdgcn_rcpf(ev0)); kb[e] = vmul_t(bf_sel(wsel(KW[1], i2 >> 1), i2 & 1), __builtin_amdgcn_rcpf(ev1)); \
                    const int i = 16 * th + i2; \
                    *(LAS unsigned*)(QS + i * QSTR + cp * 4) = pk_bf16(qs0, qs1); \
                    *(LAS unsigned*)(KS + i * QSTR + cp * 4) = pk_bf16(ka[e], kb[e]); } \
                kst0[it >> 1] = pk_bf16(ka[0], ka[1]); kst1[it >> 1] = pk_bf16(kb[0], kb[1]); \
            } \
            if (tail) { *(LAS f32x2*)(DD + 2 * cp) = (f32x2){vmul(dir ? E0[0] : E0[15], pre0), vmul(dir ? E1[0] : E1[15], pre1)}; } \
            *(LAS u32x4*)(KST + (2 * cp) * RSTR + th * 32) = (u32x4){kst0[0], kst0[1], kst0[2], kst0[3]}; \
            *(LAS u32x4*)(KST + (2 * cp) * RSTR + th * 32 + 16) = (u32x4){kst0[4], kst0[5], kst0[6], kst0[7]}; \
            *(LAS u32x4*)(KST + (2 * cp + 1) * RSTR + th * 32) = (u32x4){kst1[0], kst1[1], kst1[2], kst1[3]}; \
            *(LAS u32x4*)(KST + (2 * cp + 1) * RSTR + th * 32 + 16) = (u32x4){kst1[4], kst1[5], kst1[6], kst1[7]}; \
            *(LAS u32x4*)(VT + col * RSTR + thv * 32) = VW[0]; \
            *(LAS u32x4*)(VT + col * RSTR + thv * 32 + 16) = VW[1]; \
            asm volatile("s_waitcnt vmcnt(16)" : "+v"(PC[0]), "+v"(PC[1]));     \
            PD_STORE(PC); \
        } while (0)
        static_assert(NS == 14 || IS_A, "wait counts");
        u32x4 lf0[2][2], q0_[2][2], k0_[2][2], v0_[2], lf1[2][2], q1_[2][2], k1_[2][2], v1_[2]; u32x4 pe[2], po[2];
        LOAD_B(lf0, q0_, k0_, v0_, 0); PD_ISSUE(0, pe); LOAD_B(lf1, q1_, k1_, v1_, 1);
#pragma unroll 1
        for (int k = 0; k < 264; k += 2) {
            PROC_B(lf0, q0_, k0_, v0_, k, pe, po); LOAD_B(lf0, q0_, k0_, v0_, k + 2); SBAR();
            PROC_B(lf1, q1_, k1_, v1_, k + 1, po, pe); LOAD_B(lf1, q1_, k1_, v1_, k + 3); SBAR();
        }
        asm volatile("s_waitcnt vmcnt(0)" ::: "memory");
#undef LOAD_B
#undef PROC_B
    }
#undef WAITV
#undef PD_LOADS
#undef PD_FIRST
#undef PD_ISSUE
#undef PD_STORE
#undef BUF_PTRS
#undef STEP_CHUNK
}

template <int DK, bool IS_A>
__device__ __forceinline__ void scan_unit(const Params& p, LAS unsigned char* lds, int b, int hh, int quarter, int dir, int pair) {
    constexpr int NT = DK / 32;
    constexpr int QSTR = DK * 2 + 16;
    constexpr int RSTR = 80;
    constexpr int OFF_KS = 32 * QSTR, OFF_KST = 2 * 32 * QSTR, OFF_VT = OFF_KST + DK * RSTR, OFF_DD = OFF_VT + 128 * RSTR, OFF_PD = OFF_DD + DK * 4, BUFB = OFF_PD + 4 * 32 * RSTR;
    static_assert(2 * BUFB <= LDS_BYTES, "scan LDS");
    const int tid = threadIdx.x, wid = __builtin_amdgcn_readfirstlane(tid >> 6), lane = tid & 63;
    const int h = lane >> 5, l31 = lane & 31;
    unsigned char* ws = p.ws;
    const u16* Qg = (const u16*)(ws + (IS_A ? WS_AQ : WS_BQ));
    const u16* Kg = (const u16*)(ws + WS_BK);
    const u16* Vg = (const u16*)(ws + (IS_A ? WS_AV : WS_BV));
    const u16* LFg = IS_A ? (const u16*)(ws + WS_ALF) + (size_t)dir * NCHUNK * 2048 * 32 : (const u16*)(ws + WS_LFB) + (size_t)dir * NCHUNK * 1024 * 32;
    unsigned* flg = (unsigned*)(ws + WS_FLG) + pair * 1024;
    const u16* Ogc = (const u16*)p.out + (IS_A ? 0 : (size_t)M_LAT * 2048);
#define STEP_CHUNK(k, is_ctx_, lc_, cidx_) const bool is_ctx_ = (k) < 8; const int lc_ = is_ctx_ ? (dir ? 7 - (k) : (k)) : (dir ? 263 - (k) : (k) - 8); const int cidx_ = is_ctx_ ? 512 + b * 8 + lc_ : b * 256 + lc_;
    if (wid >= 4) {
        const int pw = wid - 4, ptid = tid - 256;
        if (dir) producer_loop<DK, IS_A, 1>(p, lds, b, hh, quarter, pair, pw, ptid, lane);
        else producer_loop<DK, IS_A, 0>(p, lds, b, hh, quarter, pair, pw, ptid, lane);
        SBAR();
    } else {
        const int w = wid;
        u16* Og = (u16*)p.out + (IS_A ? 0 : (size_t)M_LAT * 2048);
        float* SSg = (float*)(ws + (IS_A ? WS_SSA : WS_SSB));
        const int ocol0 = IS_A ? hh * 128 + 32 * w : hh * 512 + quarter * 128 + 32 * w;
        const int sspart = IS_A ? hh * 4 + w : hh * 16 + quarter * 4 + w;
        const int prow = (l31 & 3) + 8 * ((l31 >> 2) & 1) + 4 * ((l31 >> 3) & 1) + 16 * (l31 >> 4);
        f32x16 S[NT];
#pragma unroll
        for (int t = 0; t < NT; ++t)
#pragma unroll
            for (int r = 0; r < 16; ++r) S[t][r] = 0.f;
        unsigned mk[2][4];
#pragma unroll
        for (int s2 = 0; s2 < 2; ++s2)
#pragma unroll
            for (int q = 0; q < 4; ++q) { const int r0 = 8 * s2 + 2 * q; const int j0 = (r0 & 3) + 8 * (r0 >> 2) + 4 * h, j1 = j0 + 1;
                const bool k0 = dir ? (j0 >= l31) : (j0 <= l31), k1 = dir ? (j1 >= l31) : (j1 <= l31);
                mk[s2][q] = (k0 ? 0xffffu : 0u) | (k1 ? 0xffff0000u : 0u); }
        SBAR();
#pragma unroll 1
        for (int k = 0; k < 264; ++k) {
            STEP_CHUNK(k, is_ctx, lc, cidx); (void)cidx;
            LAS unsigned char* buf = lds + (k & 1) * BUFB;
            LAS unsigned char* QS = buf; LAS unsigned char* KS = buf + OFF_KS; LAS unsigned char* KST = buf + OFF_KST; LAS unsigned char* VT = buf + OFF_VT; LAS float* DD = (LAS float*)(buf + OFF_DD);
            const bool fin = k >= 136;
            int row = 0;
            if (!is_ctx) { if (IS_A) row = b * SEQ + 32 * lc + l31; else { const int pp = 32 * lc + l31; row = b * SEQ + (pp & 127) * 64 + (pp >> 7); } }
            u16* otile = Og + ((size_t)(b * 256 + lc) * 64 + (IS_A ? hh * 4 : hh * 16 + quarter * 4) + w) * 1024;
            LAS unsigned char* orow = buf + OFF_PD + (w * 32 + l31) * RSTR + 8 * h;
            bf16x8 vk[2];
            f32x16 OT;
#pragma unroll
            for (int r = 0; r < 16; ++r) OT[r] = 0.f;
            if (!is_ctx) {
                f32x16 PT;
#pragma unroll
                for (int r = 0; r < 16; ++r) PT[r] = 0.f;
                {
                    LAS unsigned char* qa = QS + l31 * QSTR + 16 * h;
                    u32x4 fq[2][2], fk[2][2];
                    DSR128(fq[0][0], qa, 0); DSR128(fk[0][0], qa, OFF_KS); DSR128(fq[0][1], qa, 32); DSR128(fk[0][1], qa, OFF_KS + 32);
#define FSTEP(pp) if constexpr (NT > (pp)) { constexpr int s_ = (pp) & 1; \
                        if constexpr ((pp) + 1 < NT) { DSR128(fq[s_ ^ 1][0], qa, 64 * ((pp) + 1)); DSR128(fk[s_ ^ 1][0], qa, OFF_KS + 64 * ((pp) + 1)); \
                            DSR128(fq[s_ ^ 1][1], qa, 64 * ((pp) + 1) + 32); DSR128(fk[s_ ^ 1][1], qa, OFF_KS + 64 * ((pp) + 1) + 32); \
                            asm volatile("s_waitcnt lgkmcnt(4)" : "+v"(fq[s_][0]), "+v"(fk[s_][0]), "+v"(fq[s_][1]), "+v"(fk[s_][1])); } \
                        else asm volatile("s_waitcnt lgkmcnt(0)" : "+v"(fq[s_][0]), "+v"(fk[s_][0]), "+v"(fq[s_][1]), "+v"(fk[s_][1])); \
                        PT = __builtin_amdgcn_mfma_f32_32x32x16_bf16(__builtin_bit_cast(bf16x8, fk[s_][0]), __builtin_bit_cast(bf16x8, fq[s_][0]), PT, 0, 0, 0); \
                        OT = __builtin_amdgcn_mfma_f32_32x32x16_bf16(pack8(S[pp], 0), __builtin_bit_cast(bf16x8, fq[s_][0]), OT, 0, 0, 0); \
                        PT = __builtin_amdgcn_mfma_f32_32x32x16_bf16(__builtin_bit_cast(bf16x8, fk[s_][1]), __builtin_bit_cast(bf16x8, fq[s_][1]), PT, 0, 0, 0); \
                        OT = __builtin_amdgcn_mfma_f32_32x32x16_bf16(pack8(S[pp], 1), __builtin_bit_cast(bf16x8, fq[s_][1]), OT, 0, 0, 0); \
                        __builtin_amdgcn_sched_barrier(0); }
                    FSTEP(0) FSTEP(1) FSTEP(2) FSTEP(3) FSTEP(4) FSTEP(5) FSTEP(6) FSTEP(7)
#undef FSTEP
                }
#pragma unroll
                for (int s2 = 0; s2 < 2; ++s2) {
                    const u32x2 lo = *(const LAS u32x2*)(VT + (32 * w + l31) * RSTR + (16 * s2 + 4 * h) * 2);
                    const u32x2 hi = *(const LAS u32x2*)(VT + (32 * w + l31) * RSTR + (16 * s2 + 8 + 4 * h) * 2);
                    vk[s2] = __builtin_bit_cast(bf16x8, (u32x4){lo.x, lo.y, hi.x, hi.y});
                    u32x4 pw4 = __builtin_bit_cast(u32x4, pack8(PT, s2));
                    pw4.x &= mk[s2][0]; pw4.y &= mk[s2][1]; pw4.z &= mk[s2][2]; pw4.w &= mk[s2][3];
                    OT = __builtin_amdgcn_mfma_f32_32x32x16_bf16(vk[s2], __builtin_bit_cast(bf16x8, pw4), OT, 0, 0, 0);
                }
                float ss = 0.f;
#pragma unroll
                for (int g = 0; g < 4; ++g) {
                    float o0 = OT[4 * g], o1 = OT[4 * g + 1], o2 = OT[4 * g + 2], o3 = OT[4 * g + 3];
                    if (fin) {
                        const u32x2 pvv = *(const LAS u32x2*)(orow + 16 * g); const unsigned lo = pvv.x, hi = pvv.y;
                        o0 += bf_lo(lo); o1 += bf_hi(lo); o2 += bf_lo(hi); o3 += bf_hi(hi);
                        ss += (o0 * o0 + o1 * o1) + (o2 * o2 + o3 * o3);
                    }
                    *(LAS u32x2*)(orow + 16 * g) = (u32x2){pk_bf16(o0, o1), pk_bf16(o2, o3)};
                }
                asm volatile("s_waitcnt lgkmcnt(0)" ::: "memory");
#pragma unroll
                for (int j = 0; j < 2; ++j) {
                    const u32x4 tv = *(const LAS u32x4*)(buf + OFF_PD + (w * 32 + 16 * j + (lane >> 2)) * RSTR + (lane & 3) * 16);
                    u16* dst = otile + j * 512 + lane * 8;
                    if (fin) *(u32x4*)dst = tv;
                    else asm volatile("global_store_dwordx4 %0, %1, off sc1\n\ts_nop 1" :: "v"(dst), "v"(tv) : "memory");
                }
                if (fin) { ss += __shfl_xor(ss, 32); if (h == 0) SSg[(size_t)row * 64 + sspart] = ss; }
            }
            {
                bf16x8 vf[2];
#pragma unroll
                for (int s2 = 0; s2 < 2; ++s2) vf[s2] = *(const LAS bf16x8*)(VT + (32 * w + l31) * RSTR + (16 * s2 + 8 * h) * 2);
                LAS unsigned char* ka = KST + prow * RSTR + 16 * h;
                LAS unsigned char* da = (LAS unsigned char*)(DD + 8 * h);
                u32x4 kf[2][2];
                DSR128(kf[0][0], ka, 0); DSR128(kf[0][1], ka, 32);
#define USTEP(t) if constexpr (NT > (t)) { constexpr int s_ = (t) & 1; \
                    if constexpr ((t) + 1 < NT) { DSR128(kf[s_ ^ 1][0], ka, 32 * RSTR * ((t) + 1)); DSR128(kf[s_ ^ 1][1], ka, 32 * RSTR * ((t) + 1) + 32); \
                        asm volatile("s_waitcnt lgkmcnt(2)" : "+v"(kf[s_][0]), "+v"(kf[s_][1])); } \
                    else asm volatile("s_waitcnt lgkmcnt(0)" : "+v"(kf[s_][0]), "+v"(kf[s_][1])); \
                    S[t] = __builtin_amdgcn_mfma_f32_32x32x16_bf16(__builtin_bit_cast(bf16x8, kf[s_][0]), vf[0], S[t], 0, 0, 0); \
                    S[t] = __builtin_amdgcn_mfma_f32_32x32x16_bf16(__builtin_bit_cast(bf16x8, kf[s_][1]), vf[1], S[t], 0, 0, 0); \
                    __builtin_amdgcn_sched_barrier(0); }
                USTEP(0) USTEP(1) USTEP(2) USTEP(3) USTEP(4) USTEP(5) USTEP(6) USTEP(7)
#undef USTEP
                f32x4 dd[2][4];
                asm volatile("s_nop 15\n\ts_nop 15" ::: "memory");
                DSR128(dd[0][0], da, 0); DSR128(dd[0][1], da, 16); DSR128(dd[0][2], da, 64); DSR128(dd[0][3], da, 80);
#define DSTEP(t) if constexpr (NT > (t)) { constexpr int s_ = (t) & 1; \
                    if constexpr ((t) + 1 < NT) { DSR128(dd[s_ ^ 1][0], da, 128 * ((t) + 1)); DSR128(dd[s_ ^ 1][1], da, 128 * ((t) + 1) + 16); DSR128(dd[s_ ^ 1][2], da, 128 * ((t) + 1) + 64); DSR128(dd[s_ ^ 1][3], da, 128 * ((t) + 1) + 80); \
                        asm volatile("s_waitcnt lgkmcnt(4)" : "+v"(dd[s_][0]), "+v"(dd[s_][1]), "+v"(dd[s_][2]), "+v"(dd[s_][3])); } \
                    else asm volatile("s_waitcnt lgkmcnt(0)" : "+v"(dd[s_][0]), "+v"(dd[s_][1]), "+v"(dd[s_][2]), "+v"(dd[s_][3])); \
                    _Pragma("unroll") for (int r = 0; r < 4; ++r) { S[t][r] = vmul_v(S[t][r], dd[s_][0][r]); S[t][4 + r] = vmul_v(S[t][4 + r], dd[s_][1][r]); S[t][8 + r] = vmul_v(S[t][8 + r], dd[s_][2][r]); S[t][12 + r] = vmul_v(S[t][12 + r], dd[s_][3][r]); } \
                    asm volatile("" : "+v"(S[t])); __builtin_amdgcn_sched_barrier(0); }
                DSTEP(0) DSTEP(1) DSTEP(2) DSTEP(3) DSTEP(4) DSTEP(5) DSTEP(6) DSTEP(7)
#undef DSTEP
            }
            constexpr int FLAG_LAG = 8;
            if (k >= 8 + FLAG_LAG && k < 135) {
                asm volatile("s_waitcnt vmcnt(24)" ::: "memory"); static_assert(FLAG_LAG * 3 == 24, "vmcnt literal");
                const int kp = k - FLAG_LAG; const int lcp = dir ? 263 - kp : kp - 8;
                if (lane == 0) __hip_atomic_store(flg + lcp * 4 + w, 1u, __ATOMIC_RELAXED, __HIP_MEMORY_SCOPE_AGENT);
            } else if (k == 135) {
                VM_WAIT();
                if (lane == 0) {
#pragma unroll
                    for (int q = 0; q <= FLAG_LAG; ++q) { const int kp = 135 - q; const int lcp = dir ? 263 - kp : kp - 8; __hip_atomic_store(flg + lcp * 4 + w, 1u, __ATOMIC_RELAXED, __HIP_MEMORY_SCOPE_AGENT); }
                }
            }
            SBAR();
        }
    }
#undef STEP_CHUNK
}

__device__ __forceinline__ void phase7(const Params& p) {
    const int tid = threadIdx.x, wid = tid >> 6, lane = tid & 63;
    const float* sso = (const float*)(p.ws + WS_SSO);
    for (int m0 = 2 * (blockIdx.x * 8 + wid); m0 < M_LAT; m0 += 2 * gridDim.x * 8) {
        f32x4 ov[2][8]; float sv[2];
#pragma unroll
        for (int rr = 0; rr < 2; ++rr) { const int m = m0 + rr; sv[rr] = (lane < 32) ? sso[(size_t)m * 32 + lane] : 0.f;
            const f32x4* o4 = (const f32x4*)(p.out + (size_t)m * D) + lane;
#pragma unroll
            for (int j = 0; j < 8; ++j) ov[rr][j] = o4[64 * j]; }
#pragma unroll
        for (int rr = 0; rr < 2; ++rr) { const int m = m0 + rr;
            const float rstd = rsqrtf(wave_sum(sv[rr]) * (1.0f / D) + EPS);
            f32x4* o4 = (f32x4*)(p.out + (size_t)m * D) + lane;
#pragma unroll
            for (int j = 0; j < 8; ++j) { const f32x4 g = *(const f32x4*)(p.final_g + 4 * (lane + 64 * j)); o4[64 * j] = ov[rr][j] * rstd * g; } }
    }
}


#define XB_TMO      128
#define XB_XCNT(j)  (256  + 64 * (j))
#define XB_XSUB(j)  (1280 + 64 * (j))
#define XB_XGEN(j)  (2304 + 64 * (j))
#define XB_TOP      3328
#define XB_TOPGEN   3392
#define XCD_BAR_WORDS 3456
#define XB_SPIN_CAP (1u << 18)
__device__ __forceinline__ unsigned xb_ld(unsigned* p)              { return __hip_atomic_load(p, __ATOMIC_RELAXED, __HIP_MEMORY_SCOPE_AGENT); }
__device__ __forceinline__ unsigned xb_add(unsigned* p, unsigned v) { return __hip_atomic_fetch_add(p, v, __ATOMIC_RELAXED, __HIP_MEMORY_SCOPE_AGENT); }
__device__ __forceinline__ unsigned xb_xcc_id() { return (unsigned)__builtin_amdgcn_s_getreg((3 << 11) | 20) & 0xFu; }
#define XB_SPIN(cond, bar) do { unsigned _sp = 0; while (cond) { __builtin_amdgcn_s_sleep(1); \
    if ((++_sp & 255u) == 0u) { if (xb_ld(&(bar)[XB_TMO])) break; if (_sp > XB_SPIN_CAP) { atomicAdd(&(bar)[XB_TMO], 1u); break; } } } } while (0)
struct XcdBarrier { unsigned* bar; unsigned x; volatile LAS unsigned* st; };
__device__ __forceinline__ XcdBarrier xcd_barrier_post(unsigned* bar, volatile LAS unsigned* st) {
    XcdBarrier b; b.bar = bar; b.x = xb_xcc_id(); b.st = st;
    if (threadIdx.x == 0) (void)xb_add(&bar[XB_XCNT(b.x)], 1u);
    return b;
}
__device__ __forceinline__ void xcd_barrier_complete(unsigned* bar, unsigned x, unsigned& nloc, unsigned& nx) {
    const unsigned G = gridDim.x * gridDim.y * gridDim.z;
    unsigned sum, cnt, mine, sp = 0u;
    for (;;) {
        sum = 0u; cnt = 0u; mine = 0u;
#pragma unroll
        for (unsigned j = 0; j < 16; ++j) { const unsigned c = xb_ld(&bar[XB_XCNT(j)]); sum += c; cnt += (c > 0u) ? 1u : 0u; mine = (j == x) ? c : mine; }
        if (sum == G) break;
        __builtin_amdgcn_s_sleep(1);
        if ((++sp & 255u) == 0u) { if (xb_ld(&bar[XB_TMO])) break; if (sp > XB_SPIN_CAP) { atomicAdd(&bar[XB_TMO], 1u); break; } }
    }
    nloc = mine > 0u ? mine : 1u; nx = cnt > 0u ? cnt : 1u;
}
__device__ __forceinline__ void xcd_barrier(const XcdBarrier& b) {
    asm volatile("s_waitcnt vmcnt(0)" ::: "memory");
    __syncthreads();
    if (threadIdx.x == 0) {
        unsigned* bar = b.bar;
        __builtin_amdgcn_s_waitcnt(0);
        unsigned nloc = b.st[0], nx = b.st[1];
        if (nloc == 0u) { xcd_barrier_complete(bar, b.x, nloc, nx); b.st[0] = nloc; b.st[1] = nx; }
        const unsigned old = xb_add(&bar[XB_XSUB(b.x)], 1u);
        const unsigned gen = old / nloc;
        if (old + 1u == (gen + 1u) * nloc) {
            __builtin_amdgcn_fence(__ATOMIC_RELEASE, "agent");
            asm volatile("s_waitcnt vmcnt(0)" ::: "memory");
            const unsigned og = xb_add(&bar[XB_TOP], 1u);
            const unsigned tg = og / nx;
            if (og + 1u == (tg + 1u) * nx) xb_add(&bar[XB_TOPGEN], 1u);
            else XB_SPIN(xb_ld(&bar[XB_TOPGEN]) == tg, bar);
            __builtin_amdgcn_fence(__ATOMIC_ACQUIRE, "agent");
            xb_add(&bar[XB_XGEN(b.x)], 1u);
            asm volatile("s_waitcnt vmcnt(0)" ::: "memory");
        } else {
            XB_SPIN(xb_ld(&bar[XB_XGEN(b.x)]) == gen, bar);
            __builtin_amdgcn_fence(__ATOMIC_ACQUIRE, "agent");
            asm volatile("s_waitcnt vmcnt(0)" ::: "memory");
        }
    }
    __syncthreads();
}

__global__ void __launch_bounds__(512, 2) fwd_megakernel(Params p) {
    extern __shared__ __attribute__((aligned(16))) unsigned char lds_raw[];
    LAS unsigned char* lds = (LAS unsigned char*)lds_raw;
    volatile LAS unsigned* bst = (volatile LAS unsigned*)(lds + LDS_BYTES - 16);
    if (threadIdx.x < 4) bst[threadIdx.x] = 0u;
    __syncthreads();
    const XcdBarrier xbar = xcd_barrier_post((unsigned*)(p.ws + WS_BAR), bst);
    const int lo = p.ph_lo, hi = p.ph_hi;
    const int G = gridDim.x, c = blockIdx.x;
    unsigned char* ws = p.ws;
#ifdef ONLY_PHASE
#define IN(k) ((k) == ONLY_PHASE && lo <= (k) && (k) < hi)
#else
#define IN(k) (lo <= (k) && (k) < hi)
#endif
#define SEAM(k) do { if (IN(k) && IN((k) + 1)) xcd_barrier(xbar); } while (0)
#ifndef DUP_PHASE
#define DUP_PHASE -1
#endif
#define REP(k) for (int rep_ = 0; rep_ < ((k) == DUP_PHASE ? 2 : 1); ++rep_)
    if (IN(0)) REP(0) phase0(p, lds);
    SEAM(0);
    if (IN(1)) REP(1) phase1(p);
    SEAM(1);
    if (IN(2)) REP(2) { SchedScan S{G, c, (const char*)(ws + WS_H), (const char*)(ws + WS_WTS)}; EpiScan E{ws, p.lb_logits};
        pg8::gemm_phase<EpiScan, SchedScan, false, true, false>(lds, S, E); }
    SEAM(2);
    if (IN(3)) REP(3) phase2b(p, lds);
    SEAM(3);
    if (IN(4)) {
        unsigned* adone = (unsigned*)(ws + 256);
        EpiGate E{ws, (u16*)p.out, (u16*)p.out + (size_t)M_LAT * 2048, p.onorm_a, p.onorm_b, adone};
        if (c < 64) {
            scan_unit<128, true>(p, lds, c >> 5, (c >> 1) & 15, 0, c & 1, c >> 1);
            VM_WAIT(); __syncthreads();
            if (threadIdx.x == 0) { __builtin_amdgcn_fence(__ATOMIC_RELEASE, "agent"); VM_WAIT(); __hip_atomic_fetch_add(adone, 1u, __ATOMIC_RELAXED, __HIP_MEMORY_SCOPE_AGENT); }
            __syncthreads();
            SchedHelp S{128 + c, 0, (const char*)(ws + WS_H), (const char*)(ws + WS_WTG)};
            pg8::gemm_phase<EpiGate, SchedHelp, true, false, true>(lds, S, E);
        } else if (c < 128) { const int u = c - 64; scan_unit<256, false>(p, lds, u >> 5, (u >> 3) & 3, (u >> 1) & 3, u & 1, 32 + (u >> 1)); }
        else { SchedHelp S{c - 128, 4, (const char*)(ws + WS_H), (const char*)(ws + WS_WTG)};
            pg8::gemm_phase<EpiGate, SchedHelp, true, false, true>(lds, S, E); }
    }
    SEAM(4);
    if (IN(5)) { phase_wtp(p, lds);
        SchedTiles S{G, c, NAG_SCAN, 16 - NAG_SCAN, (const char*)(ws + WS_H), (const char*)(ws + WS_WTG)};
        EpiGate E{ws, (u16*)p.out, (u16*)p.out + (size_t)M_LAT * 2048, p.onorm_a, p.onorm_b, (const unsigned*)(ws + 256)};
        pg8::gemm_phase<EpiGate, SchedTiles, true, false, true>(lds, S, E); }
    SEAM(5);
    if (IN(6)) { SchedY S{G, c, (const char*)p.out, (const char*)p.out + (size_t)M_LAT * 2048 * 2, (const char*)(ws + WS_WTP)}; EpiY2 E{ws};
        pg8::gemm_phase<EpiY2, SchedY, true, false, true>(lds, S, E); }
    SEAM(6);
    if (IN(7)) REP(7) { SchedStd S{G, c, 8, (const char*)(ws + WS_Y), (const char*)(ws + WS_WTP) + (size_t)2 * 2048 * 4096, 0u};
        EpiOut E{p.x, p.out, (const float*)(ws + WS_MOD), (float*)(ws + WS_SSO)};
        pg8::gemm_phase<EpiOut, SchedStd, true, false, false>(lds, S, E); }
    SEAM(7);
    if (IN(8)) phase7(p);
#undef IN
#undef SEAM
}

#ifndef N_LAUNCHES
#define N_LAUNCHES 1
#endif
constexpr int N_PHASES = 9;

extern "C" void kernel_launch(void* const* d_in, const int* in_sizes, int n_in, void* d_out, int out_size, void* d_ws, size_t ws_size, hipStream_t stream) {
    static int grid = 0;
    if (grid == 0) {
        if (n_in != 17 || out_size != M_LAT * D || ws_size < WS_END) { fprintf(stderr, "kernel_launch: unexpected sizes (n_in %d out %d ws %zu need %zu)\n", n_in, out_size, ws_size, (size_t)WS_END); grid = -1; return; }
        int dev = 0, cus = 0, per_cu = 0;
        hipGetDevice(&dev);
        hipDeviceGetAttribute(&cus, hipDeviceAttributeMultiprocessorCount, dev);
        hipFuncSetAttribute((const void*)fwd_megakernel, hipFuncAttributeMaxDynamicSharedMemorySize, LDS_BYTES);
        hipOccupancyMaxActiveBlocksPerMultiprocessor(&per_cu, (const void*)fwd_megakernel, 512, LDS_BYTES);
        if (per_cu < 1) { fprintf(stderr, "kernel_launch: occupancy query reports %d blocks per CU\n", per_cu); grid = -1; return; }
        grid = cus;
    }
    if (grid < 0) return;
    Params p{};
    p.x = (const float*)d_in[0]; p.c = (const float*)d_in[1]; p.ctx = (const float*)d_in[2]; p.c_ctx = (const float*)d_in[3];
    p.w_ada = (const float*)d_in[4]; p.b_ada = (const float*)d_in[5]; p.norm_g = (const float*)d_in[6]; p.w_in = (const float*)d_in[7];
    p.lb_logits = (const float*)d_in[8]; p.gk_w = (const float*)d_in[9]; p.gk_b = (const float*)d_in[10]; p.onorm_a = (const float*)d_in[11];
    p.onorm_b = (const float*)d_in[12]; p.w_pa = (const float*)d_in[13]; p.w_pb = (const float*)d_in[14]; p.w_out = (const float*)d_in[15]; p.final_g = (const float*)d_in[16];
    p.out = (float*)d_out; p.ws = (unsigned char*)d_ws;
    (void)hipMemsetAsync((char*)d_ws + WS_BAR, 0, 16384, stream);
    const int per = (N_PHASES + N_LAUNCHES - 1) / N_LAUNCHES;
    for (int li = 0; li < N_LAUNCHES; ++li) {
        p.ph_lo = li * per; p.ph_hi = (li + 1) * per < N_PHASES ? (li + 1) * per : N_PHASES;
        if (p.ph_lo >= N_PHASES) break;
        void* args[] = {&p};
        hipError_t e = hipLaunchCooperativeKernel((const void*)fwd_megakernel, dim3(grid), dim3(512), args, LDS_BYTES, stream);
        if (e != hipSuccess) { fprintf(stderr, "cooperative launch failed: %s (grid %d)\n", hipGetErrorString(e), grid); break; }
    }
}
```

```cpp
#include <hip/hip_runtime.h>
#include <cstdio>
#include <cstdint>

#define LAS __attribute__((address_space(3)))
typedef unsigned short u16;
typedef short bf16x8 __attribute__((ext_vector_type(8)));
typedef float f32x2 __attribute__((ext_vector_type(2)));
typedef float f32x4 __attribute__((ext_vector_type(4)));
typedef float f32x16 __attribute__((ext_vector_type(16)));
typedef unsigned u32x2 __attribute__((ext_vector_type(2)));
typedef unsigned u32x4 __attribute__((ext_vector_type(4)));
typedef __bf16 bf16x2_t __attribute__((ext_vector_type(2)));
typedef _Float16 f16x2_t __attribute__((ext_vector_type(2)));

constexpr int D = 2048, NB = 2, SEQ = 8192, LCTX = 256;
constexpr int M_LAT = NB * SEQ;
constexpr int M_ALL = M_LAT + NB * LCTX;
constexpr int N_IN = 20512;
constexpr int NCHUNK = M_ALL / 32;
constexpr float EPS = 1e-6f;
constexpr int NSCAN_ROWS = 12544;
constexpr int NGATE_ROWS = 8192;

constexpr size_t WS_BAR = 4096;
constexpr size_t WS_FLG = WS_BAR + 16384;
constexpr size_t WS_MOD = WS_FLG + 64 * 256 * 4 * 4;
constexpr size_t WS_SSO = WS_MOD + 3 * 6144 * 4;
constexpr size_t WS_SSA = WS_SSO + (size_t)M_LAT * 32 * 4;
constexpr size_t WS_SSB = WS_SSA + (size_t)M_LAT * 64 * 4;
constexpr size_t WS_WTG = WS_SSB + (size_t)M_LAT * 64 * 4;
constexpr size_t WS_H   = WS_WTG + (size_t)NGATE_ROWS * D * 2;
constexpr size_t WS_WTS = WS_H + (size_t)M_ALL * D * 2;
constexpr size_t WS_LFB = WS_WTS;
constexpr size_t WS_R   = WS_LFB + (size_t)2 * NCHUNK * 1024 * 32 * 2;
constexpr size_t WS_AQ  = WS_R + (size_t)NCHUNK * 32 * 32 * 4;
constexpr size_t WS_AV  = WS_AQ + (size_t)NCHUNK * 2048 * 32 * 2;
constexpr size_t WS_ALF = WS_AV + (size_t)NCHUNK * 2048 * 32 * 2;
constexpr size_t WS_BQ  = WS_ALF + (size_t)2 * NCHUNK * 2048 * 32 * 2;
constexpr size_t WS_BK  = WS_BQ + (size_t)NCHUNK * 1024 * 32 * 2;
constexpr size_t WS_BV  = WS_BK + (size_t)NCHUNK * 1024 * 32 * 2;
constexpr size_t WS_MGA = WS_BV + (size_t)NCHUNK * 2048 * 32 * 2;
constexpr size_t WS_END = WS_MGA + (size_t)M_LAT * 2048 * 2;
constexpr size_t WS_MGB = WS_AQ;
constexpr size_t WS_Y   = WS_ALF;
constexpr size_t WS_WTP = WS_ALF + (size_t)M_LAT * 2048 * 2;
static_assert(WS_WTS + (size_t)NSCAN_ROWS * D * 2 <= WS_R, "LFB overlay");
static_assert(WS_MGB + (size_t)M_LAT * 2048 * 2 <= WS_AV, "MGB overlay");
static_assert(WS_WTP + (size_t)3 * D * D * 2 <= WS_BQ, "WTP overlay");
static_assert(WS_END <= (size_t)672137216, "workspace");

constexpr int LDS_BYTES = 155648;

struct Params {
    const float *x, *c, *ctx, *c_ctx, *w_ada, *b_ada, *norm_g, *w_in, *lb_logits, *gk_w, *gk_b, *onorm_a, *onorm_b, *w_pa, *w_pb, *w_out, *final_g;
    float* out; unsigned char* ws;
    int ph_lo, ph_hi;
};

__device__ __forceinline__ unsigned pk_bf16(float lo, float hi) { f32x2 v = {lo, hi}; return __builtin_bit_cast(unsigned, __builtin_convertvector(v, bf16x2_t)); }
__device__ __forceinline__ unsigned pk_f16(float lo, float hi) { f32x2 v = {lo, hi}; return __builtin_bit_cast(unsigned, __builtin_convertvector(v, f16x2_t)); }
__device__ __forceinline__ float bf_lo(unsigned w) { return __uint_as_float(w << 16); }
__device__ __forceinline__ float bf_hi(unsigned w) { return __uint_as_float(w & 0xffff0000u); }
__device__ __forceinline__ float bf_sel(unsigned w, int hi) { return hi ? bf_hi(w) : bf_lo(w); }
__device__ __forceinline__ float h_sel(unsigned w, int hi) { return (float)__builtin_bit_cast(_Float16, (u16)(hi ? (w >> 16) : (w & 0xffffu))); }
__device__ __forceinline__ float sigmoidf_(float v) { return __builtin_amdgcn_rcpf(1.0f + __builtin_amdgcn_exp2f(v * -1.4426950408889634f)); }
__device__ __forceinline__ float wave_sum(float v) {
#pragma unroll
    for (int o = 1; o < 64; o <<= 1) v += __shfl_xor(v, o);
    return v;
}
#define LDS_WAIT() asm volatile("s_waitcnt lgkmcnt(0)" ::: "memory")
#define VM_WAIT() asm volatile("s_waitcnt vmcnt(0)" ::: "memory")

namespace pg8 {
constexpr int BM = 256, BK = 64, HALF = 128, HTB = HALF * BK * 2, STAGE_BYTES = 8 * HTB, KD = 2048, NT = KD / BK;
__device__ __forceinline__ int lds_byte(int r, int c) { const int st = (r >> 4) * 2 + (c >> 5), rr = r & 15, cc = c & 31, ob = rr * 64 + cc * 2; return st * 1024 + (ob ^ (((ob >> 9) & 1) << 5)); }
__device__ __forceinline__ void stage_rc(int b, int& R, int& C) { const int st = b / 1024, sb = b % 1024, swz = sb ^ (((sb >> 9) & 1) << 5); R = (st >> 1) * 16 + swz / 64; C = (st & 1) * 32 + (swz % 64) / 2; }
__device__ __forceinline__ int perm32(int rho) { const int n = rho >> 4, i = rho & 15; return 8 * (i >> 2) + 4 * n + (i & 3); }

struct Unit { const char* A; const char* B; unsigned mode; unsigned hstepA; unsigned kstepA; int pm, pn; };
__device__ __forceinline__ unsigned voffA_of(unsigned mode, int R, int C) {
    if (mode == 0u) return (unsigned)(R * KD + C) * 2u;
    if (mode == 1u) return (unsigned)(R * 64 * KD + C) * 2u;
    if (mode == 2u) return (unsigned)((((R >> 5) * 64 + (C >> 5)) * 1024) + (R & 31) * 32 + (C & 31)) * 2u;
    return (unsigned)((((R & 63) * 4 * 64 + (C >> 5)) * 1024) + (R >> 6) * 32 + (C & 31)) * 2u;
}

template <class Epi, class Sched, bool TRANS, bool PERM_A, bool PERM_B>
__device__ __forceinline__ void gemm_phase(LAS unsigned char* lds, const Sched& S, const Epi& E) {
    const int tid = threadIdx.x, wid = __builtin_amdgcn_readfirstlane(tid >> 6), lane = tid & 63, wr = wid >> 2, wc = wid & 3, fr = lane & 15, fq = lane >> 4;
    int RaA[2], CA[2]; unsigned voffB[2];
#pragma unroll
    for (int i = 0; i < 2; ++i) { int R, C; stage_rc(tid * 16 + i * 8192, R, C);
        RaA[i] = PERM_A ? ((R & ~31) + perm32(R & 31)) : R; CA[i] = C; const int Rb = PERM_B ? ((R & ~31) + perm32(R & 31)) : R;
        voffB[i] = (unsigned)(Rb * KD + C) * 2u; }
    constexpr size_t kstep = (size_t)(BK * 2);
    constexpr size_t hstepB = (size_t)HALF * KD * 2;
    const unsigned ldsw = (unsigned)wid * 1024u;
    const int aoff = lds_byte(wr * 64 + fr, fq * 8), boff = lds_byte(wc * 32 + fr, fq * 8);
#define PG8_SA(b, h) (((b) * 2 + (h)) * HTB)
#define PG8_SB(b, h) ((4 + (b) * 2 + (h)) * HTB)
#define PG8_STAGE(bufoff, gbase, voff) do { _Pragma("unroll") for (int _i = 0; _i < 2; ++_i) \
        __builtin_amdgcn_global_load_lds((const unsigned*)((const char*)(gbase) + (voff)[_i]), (LAS unsigned*)(lds + (bufoff) + ldsw + _i * 8192), 16, 0, 0); } while (0)
#define PG8_LDA(dst, b, h) do { _Pragma("unroll") for (int m = 0; m < 4; ++m) _Pragma("unroll") for (int k = 0; k < 2; ++k) dst[m][k] = *(const LAS bf16x8*)(lds + PG8_SA(b, h) + aoff + m * 2048 + k * 1024); } while (0)
#define PG8_LDB(dst, b, h) do { _Pragma("unroll") for (int n = 0; n < 2; ++n) _Pragma("unroll") for (int k = 0; k < 2; ++k) dst[n][k] = *(const LAS bf16x8*)(lds + PG8_SB(b, h) + boff + n * 2048 + k * 1024); } while (0)
#define PG8_MMA(ai, bj, At, Bt) do { __builtin_amdgcn_s_setprio(1); _Pragma("unroll") for (int m = 0; m < 4; ++m) _Pragma("unroll") for (int n = 0; n < 2; ++n) _Pragma("unroll") for (int k = 0; k < 2; ++k) \
        acc[ai][bj][m][n] = TRANS ? __builtin_amdgcn_mfma_f32_16x16x32_bf16(Bt[n][k], At[m][k], acc[ai][bj][m][n], 0, 0, 0) \
                                  : __builtin_amdgcn_mfma_f32_16x16x32_bf16(At[m][k], Bt[n][k], acc[ai][bj][m][n], 0, 0, 0); __builtin_amdgcn_s_setprio(0); } while (0)
#define PG8_WAIT_V(n) asm volatile("s_waitcnt vmcnt(" #n ")" ::: "memory")
#define PG8_WAIT_L(n) asm volatile("s_waitcnt lgkmcnt(" #n ")" ::: "memory")
#define PG8_BAR __builtin_amdgcn_s_barrier()
#define PG8_SCHED __builtin_amdgcn_sched_barrier(0)
    Unit cur, nxt; int ui = 0;
    if (!S.next(0, cur)) return;
    f32x4 acc[2][2][4][2];
#pragma unroll
    for (int a = 0; a < 2; ++a)
#pragma unroll
        for (int b = 0; b < 2; ++b)
#pragma unroll
            for (int m = 0; m < 4; ++m)
#pragma unroll
                for (int n = 0; n < 2; ++n) acc[a][b][m][n] = (f32x4){0.f, 0.f, 0.f, 0.f};
    bf16x8 At[4][2], B0[2][2], B1[2][2];
    const char* cA = cur.A; const char* cB = cur.B;
    unsigned vA[2] = {voffA_of(cur.mode, RaA[0], CA[0]), voffA_of(cur.mode, RaA[1], CA[1])};
    size_t hA = cur.hstepA, kA = cur.kstepA;
    PG8_STAGE(PG8_SB(0, 0), cB, voffB); PG8_STAGE(PG8_SA(0, 0), cA, vA); PG8_STAGE(PG8_SB(0, 1), cB + hstepB, voffB); PG8_STAGE(PG8_SA(0, 1), cA + hA, vA);
    if (wr == 1) PG8_BAR;
    PG8_WAIT_V(4); PG8_BAR;
    PG8_STAGE(PG8_SB(1, 0), cB + kstep, voffB); PG8_STAGE(PG8_SA(1, 0), cA + kA, vA); PG8_STAGE(PG8_SB(1, 1), cB + hstepB + kstep, voffB);
    PG8_WAIT_V(6); PG8_BAR;
    for (;;) {
        const bool has_next = S.next(ui + 1, nxt);
        const char* nA = has_next ? nxt.A : cA; const char* nB = has_next ? nxt.B : cB;
        unsigned vN[2]; size_t hN, kN;
        if (has_next) { vN[0] = voffA_of(nxt.mode, RaA[0], CA[0]); vN[1] = voffA_of(nxt.mode, RaA[1], CA[1]); hN = nxt.hstepA; kN = nxt.kstepA; } else { vN[0] = vA[0]; vN[1] = vA[1]; hN = hA; kN = kA; }
        for (int t = 0; t < NT; t += 2) {
            const bool last = (t == NT - 2);
            const char* a1 = cA + (size_t)(t + 1) * kA;
            const char* a2 = last ? nA : cA + (size_t)(t + 2) * kA; const char* b2 = last ? nB : cB + (size_t)(t + 2) * kstep;
            const char* a3 = a2 + (last ? kN : kA); const char* b3 = b2 + kstep;
            unsigned v2[2] = {last ? vN[0] : vA[0], last ? vN[1] : vA[1]}; const size_t h2 = last ? hN : hA;
            PG8_LDB(B0, 0, 0); PG8_SCHED; PG8_LDA(At, 0, 0); PG8_STAGE(PG8_SA(1, 1), a1 + hA, vA);
            PG8_WAIT_L(8); PG8_BAR; PG8_WAIT_L(0); PG8_MMA(0, 0, At, B0); PG8_BAR; PG8_SCHED;
            PG8_LDB(B1, 0, 1); PG8_STAGE(PG8_SB(0, 0), b2, voffB);
            PG8_BAR; PG8_WAIT_L(0); PG8_MMA(0, 1, At, B1); PG8_BAR;
            PG8_LDA(At, 0, 1); PG8_STAGE(PG8_SA(0, 0), a2, v2);
            PG8_BAR; PG8_WAIT_L(0); PG8_MMA(1, 0, At, B0); PG8_BAR; PG8_SCHED;
            PG8_STAGE(PG8_SB(0, 1), b2 + hstepB, voffB);
            PG8_WAIT_V(6); PG8_BAR; PG8_MMA(1, 1, At, B1); PG8_BAR;
            PG8_LDB(B0, 1, 0); PG8_SCHED; PG8_LDA(At, 1, 0); PG8_STAGE(PG8_SA(0, 1), a2 + h2, v2);
            PG8_WAIT_L(8); PG8_BAR; PG8_WAIT_L(0); PG8_MMA(0, 0, At, B0); PG8_BAR; PG8_SCHED;
            PG8_LDB(B1, 1, 1); PG8_STAGE(PG8_SB(1, 0), b3, voffB);
            PG8_BAR; PG8_WAIT_L(0); PG8_MMA(0, 1, At, B1); PG8_BAR;
            PG8_LDA(At, 1, 1); PG8_STAGE(PG8_SA(1, 0), a3, v2);
            PG8_BAR; PG8_WAIT_L(0); PG8_MMA(1, 0, At, B0); PG8_BAR; PG8_SCHED;
            PG8_STAGE(PG8_SB(1, 1), b3 + hstepB, voffB);
            PG8_WAIT_V(6); PG8_BAR; PG8_MMA(1, 1, At, B1); PG8_BAR;
        }
        E(acc, cur, wr, wc, fr, fq);
        if (!has_next) break;
#pragma unroll
        for (int a = 0; a < 2; ++a)
#pragma unroll
            for (int b = 0; b < 2; ++b)
#pragma unroll
                for (int m = 0; m < 4; ++m)
#pragma unroll
                    for (int n = 0; n < 2; ++n) acc[a][b][m][n] = (f32x4){0.f, 0.f, 0.f, 0.f};
        cur = nxt; cA = nA; cB = nB; vA[0] = vN[0]; vA[1] = vN[1]; hA = hN; kA = kN; ++ui;
    }
    PG8_WAIT_V(0);
    if (wr == 0) PG8_BAR;
    PG8_BAR;
#undef PG8_SA
#undef PG8_SB
#undef PG8_STAGE
#undef PG8_LDA
#undef PG8_LDB
#undef PG8_MMA
#undef PG8_WAIT_V
#undef PG8_WAIT_L
#undef PG8_BAR
#undef PG8_SCHED
}
}

typedef f32x4 AccT[2][2][4][2];

struct SchedScan {
    int G, c; const char* h; const char* wts;
    __device__ __forceinline__ bool next(int i, pg8::Unit& u) const {
        const int L = i * G + c;
        if (L >= 64 * 49 + 2 * 37) return false;
        int pm, pn;
        if (L < 64 * 49) { pm = L & 63; pn = L >> 6; }
        else { const int r = L - 64 * 49; pm = 64 + (r & 1); int q = r >> 1; pn = (q < 24) ? 8 + q : 36 + (q - 24); }
        u.pm = pm; u.pn = pn; u.B = wts + (size_t)pn * 256 * 4096;
        if (pn >= 32 && pm < 64) {
            const int b = pm >> 5, pp = pm & 31;
            u.A = h + (size_t)(b * 8192 + 2 * pp) * 4096; u.mode = 1u; u.hstepA = 4096u; u.kstepA = 128u;
        } else { u.A = h + (size_t)pm * 256 * 4096; u.mode = 0u; u.hstepA = 128u * 4096u; u.kstepA = 128u; }
        return true;
    }
};
struct SchedStd {
    int G, c, nN; const char* A; const char* B; unsigned mode;
    __device__ __forceinline__ bool next(int i, pg8::Unit& u) const {
        const int L = i * G + c;
        if (L >= 64 * nN) return false;
        u.pm = L & 63; u.pn = L >> 6; u.B = B + (size_t)u.pn * 256 * 4096; u.mode = mode;
        if (mode == 0u) { u.A = A + (size_t)u.pm * 256 * 4096; u.hstepA = 128u * 4096u; u.kstepA = 128u; }
        else if (mode == 2u) { u.A = A + (size_t)u.pm * 8 * 64 * 2048; u.hstepA = 4u * 64u * 2048u; u.kstepA = 4096u; }
        else { const int bb = u.pm >> 5, pp = u.pm & 31;
            u.A = A + ((size_t)(bb * 256 + (pp >> 3)) * 64 * 1024 + (size_t)(4 * (pp & 7)) * 32) * 2; u.hstepA = 2u * 32u * 2u; u.kstepA = 4096u; }
        return true;
    }
};

struct EpiScan {
    unsigned char* ws; const float* lbl;
    __device__ __forceinline__ void operator()(const AccT& acc, const pg8::Unit& u, int wr, int wc, int fr, int fq) const {
        const int pn = u.pn;
        int kind, pl, W; size_t base;
        if (pn < 8) { kind = 0; pl = pn; W = 2048; base = WS_AQ; }
        else if (pn < 16) { kind = 0; pl = pn - 8; W = 2048; base = WS_AV; }
        else if (pn < 24) { kind = 1; pl = pn - 16; W = 2048; base = WS_ALF; }
        else if (pn < 32) { kind = 2; pl = pn - 24; W = 2048; base = WS_ALF + (size_t)NCHUNK * 2048 * 32 * 2; }
        else if (pn < 36) { kind = 3; pl = pn - 32; W = 1024; base = WS_BQ; }
        else if (pn < 40) { kind = 0; pl = pn - 36; W = 1024; base = WS_BK; }
        else if (pn < 48) { kind = 0; pl = pn - 40; W = 2048; base = WS_BV; }
        else { kind = 4; pl = 0; W = 32; base = WS_R; }
#pragma unroll
        for (int bj = 0; bj < 2; ++bj)
#pragma unroll
            for (int n = 0; n < 2; ++n) {
                const int ch = pl * 256 + bj * 128 + wc * 32 + n * 16 + fr;
                float lb = 0.f;
                if (kind == 1 || kind == 2) { const int li = (kind == 2 ? 2048 : 0) + ch; lb = sigmoidf_(lbl[li] - lbl[4096 + li]); }
#pragma unroll
                for (int ai = 0; ai < 2; ++ai)
#pragma unroll
                    for (int q = 0; q < 2; ++q) {
                        const int chunk = u.pm * 8 + ai * 4 + wr * 2 + q;
                        f32x4 v0 = acc[ai][bj][2 * q][n], v1 = acc[ai][bj][2 * q + 1][n];
                        if (kind == 4) {
                            if (wc == 0 && bj == 0) { float* dst = (float*)(ws + base) + ((size_t)chunk * 32 + (n * 16 + fr)) * 32 + 8 * fq; *(f32x4*)dst = v0; *(f32x4*)(dst + 4) = v1; }
                        } else {
                            u32x4 w;
                            if (kind == 1 || kind == 2) {
                                float t[8] = {v0[0], v0[1], v0[2], v0[3], v1[0], v1[1], v1[2], v1[3]};
#pragma unroll
                                for (int e = 0; e < 8; ++e) t[e] = __log2f(lb + (1.0f - lb) * sigmoidf_(t[e]));
                                w.x = pk_f16(t[0], t[1]); w.y = pk_f16(t[2], t[3]); w.z = pk_f16(t[4], t[5]); w.w = pk_f16(t[6], t[7]);
                            } else {
                                if (kind == 3) { v0 = v0 * 0.0625f; v1 = v1 * 0.0625f; }
                                w.x = pk_bf16(v0[0], v0[1]); w.y = pk_bf16(v0[2], v0[3]); w.z = pk_bf16(v1[0], v1[1]); w.w = pk_bf16(v1[2], v1[3]);
                            }
                            u16* dst = (u16*)(ws + base) + (((size_t)chunk * 4 + fq) * W + ch) * 8;
                            *(u32x4*)dst = w;
                        }
                    }
            }
    }
};

struct EpiGate {
    unsigned char* ws; u16* OA; u16* OB; const float* gain_a; const float* gain_b; const unsigned* adone;
    __device__ __forceinline__ void operator()(const AccT& acc, const pg8::Unit& u, int wr, int wc, int fr, int fq) const {
        const int pn = u.pn;
        const int row0 = u.pm * 256 + wr * 64 + fr;
        if (pn < 8 || pn >= 24) {
            unsigned spins = 0;
            while (__hip_atomic_load(adone, __ATOMIC_RELAXED, __HIP_MEMORY_SCOPE_AGENT) < 64u) { __builtin_amdgcn_s_sleep(8); if (++spins > (1u << 22)) break; }
            __builtin_amdgcn_fence(__ATOMIC_ACQUIRE, "agent");
        }
        if (pn >= 16) {
            u16* MG = (u16*)(ws + (pn < 24 ? WS_MGA : WS_MGB));
            const int col0 = ((pn - 16) & 7) * 256 + wc * 32 + 8 * fq;
#pragma unroll
            for (int ai = 0; ai < 2; ++ai)
#pragma unroll
                for (int m = 0; m < 4; ++m) { u16* rowp = MG + (size_t)(row0 + ai * 128 + m * 16) * 2048 + col0;
#pragma unroll
                    for (int bj = 0; bj < 2; ++bj) { const f32x4 v0 = acc[ai][bj][m][0], v1 = acc[ai][bj][m][1]; u32x4 w;
                        w.x = pk_bf16(sigmoidf_(v0[0]), sigmoidf_(v0[1])); w.y = pk_bf16(sigmoidf_(v0[2]), sigmoidf_(v0[3]));
                        w.z = pk_bf16(sigmoidf_(v1[0]), sigmoidf_(v1[1])); w.w = pk_bf16(sigmoidf_(v1[2]), sigmoidf_(v1[3]));
                        *(u32x4*)(rowp + bj * 128) = w; } }
        } else {
            const bool isA = pn < 8; const int pl = isA ? pn : pn - 8;
            u16* O = isA ? OA : OB; const float* gain = isA ? gain_a : gain_b;
            const float* SS = (const float*)(ws + (isA ? WS_SSA : WS_SSB));
            const int col0 = pl * 256 + wc * 32 + 8 * fq;
            f32x4 g[2][2];
#pragma unroll
            for (int bj = 0; bj < 2; ++bj) { g[bj][0] = *(const f32x4*)(gain + col0 + bj * 128); g[bj][1] = *(const f32x4*)(gain + col0 + bj * 128 + 4); }
#pragma unroll
            for (int ai = 0; ai < 2; ++ai)
#pragma unroll
                for (int m = 0; m < 4; ++m) {
                    const int row = row0 + ai * 128 + m * 16;
                    float rstd[2];
                    if (isA) {
#pragma unroll
                        for (int bj = 0; bj < 2; ++bj) { const f32x4 s = *(const f32x4*)(SS + (size_t)row * 64 + (pl * 2 + bj) * 4); rstd[bj] = rsqrtf(((s[0] + s[1]) + (s[2] + s[3])) * (1.0f / 128.0f) + EPS); }
                    } else {
                        const float* sp = SS + (size_t)row * 64 + (pl >> 1) * 16; float t = 0.f;
#pragma unroll
                        for (int k = 0; k < 4; ++k) { const f32x4 s = *(const f32x4*)(sp + 4 * k); t += (s[0] + s[1]) + (s[2] + s[3]); }
                        rstd[0] = rstd[1] = rsqrtf(t * (1.0f / 512.0f) + EPS);
                    }
                    size_t tb;
                    if (isA) tb = ((size_t)(row >> 5) * 64) * 1024 + (size_t)(row & 31) * 32;
                    else { const int bb = row >> 13, t = row & 8191, ps = (t & 63) * 128 + (t >> 6); tb = ((size_t)(bb * 256 + (ps >> 5)) * 64) * 1024 + (size_t)(ps & 31) * 32; }
                    u16* rowp = O + tb + (size_t)(col0 >> 5) * 1024 + (col0 & 31);
#pragma unroll
                    for (int bj = 0; bj < 2; ++bj) {
                        const u32x4 ov = *(const u32x4*)(rowp + bj * 4 * 1024);
                        const f32x4 a0 = acc[ai][bj][m][0], a1 = acc[ai][bj][m][1];
                        float o[8] = {bf_lo(ov.x), bf_hi(ov.x), bf_lo(ov.y), bf_hi(ov.y), bf_lo(ov.z), bf_hi(ov.z), bf_lo(ov.w), bf_hi(ov.w)};
                        float gt[8] = {a0[0], a0[1], a0[2], a0[3], a1[0], a1[1], a1[2], a1[3]};
                        float gg[8] = {g[bj][0][0], g[bj][0][1], g[bj][0][2], g[bj][0][3], g[bj][1][0], g[bj][1][1], g[bj][1][2], g[bj][1][3]};
#pragma unroll
                        for (int e = 0; e < 8; ++e) o[e] = (o[e] * rstd[bj] * gg[e]) * (gt[e] * sigmoidf_(gt[e]));
                        u32x4 w; w.x = pk_bf16(o[0], o[1]); w.y = pk_bf16(o[2], o[3]); w.z = pk_bf16(o[4], o[5]); w.w = pk_bf16(o[6], o[7]);
                        *(u32x4*)(rowp + bj * 4 * 1024) = w;
                    }
                }
        }
    }
};
constexpr int NAG_SCAN = 8;
struct SchedHelp {
    int id; int n_first; const char* A; const char* B;
    __device__ __forceinline__ bool next(int i, pg8::Unit& u) const {
        int pm, tile;
        if (i < n_first) { const int L = i * 128 + id; pm = L & 63; tile = 16 + (L >> 6); }
        else { const int L = (i - n_first) * 192 + id; if (L >= 512 + 64 * NAG_SCAN) return false;
            if (L < 512) { pm = L & 63; tile = 24 + (L >> 6); } else { pm = (L - 512) & 63; tile = (L - 512) >> 6; } }
        u.pm = pm; u.pn = tile; u.A = A + (size_t)pm * 256 * 4096; u.B = B + (size_t)tile * 256 * 4096; u.mode = 0u; u.hstepA = 128u * 4096u; u.kstepA = 128u;
        return true;
    }
};
struct SchedTiles {
    int G, c, tile0, nT; const char* A; const char* B;
    __device__ __forceinline__ bool next(int i, pg8::Unit& u) const {
        const int L = i * G + c;
        if (L >= 64 * nT) return false;
        u.pm = L & 63; u.pn = tile0 + (L >> 6); u.A = A + (size_t)u.pm * 256 * 4096; u.B = B + (size_t)u.pn * 256 * 4096; u.mode = 0u; u.hstepA = 128u * 4096u; u.kstepA = 128u;
        return true;
    }
};

template <int SECOND> struct EpiY {
    unsigned char* ws;
    __device__ __forceinline__ void operator()(const AccT& acc, const pg8::Unit& u, int wr, int wc, int fr, int fq) const {
        const u16* MG = (const u16*)(ws + (SECOND ? WS_MGB : WS_MGA)); u16* Y = (u16*)(ws + WS_Y);
        const int row0 = u.pm * 256 + wr * 64 + fr, col0 = u.pn * 256 + wc * 32 + 8 * fq;
#pragma unroll
        for (int ai = 0; ai < 2; ++ai)
#pragma unroll
            for (int m = 0; m < 4; ++m) { const int row = row0 + ai * 128 + m * 16;
#pragma unroll
                for (int bj = 0; bj < 2; ++bj) {
                    const u32x4 mv = *(const u32x4*)(MG + (size_t)row * 2048 + col0 + bj * 128);
                    const f32x4 a0 = acc[ai][bj][m][0], a1 = acc[ai][bj][m][1];
                    float o[8] = {a0[0] * bf_lo(mv.x), a0[1] * bf_hi(mv.x), a0[2] * bf_lo(mv.y), a0[3] * bf_hi(mv.y), a1[0] * bf_lo(mv.z), a1[1] * bf_hi(mv.z), a1[2] * bf_lo(mv.w), a1[3] * bf_hi(mv.w)};
                    u16* yp = Y + (size_t)row * 2048 + col0 + bj * 128;
                    if (SECOND) { const u32x4 yv = *(const u32x4*)yp;
                        o[0] += bf_lo(yv.x); o[1] += bf_hi(yv.x); o[2] += bf_lo(yv.y); o[3] += bf_hi(yv.y); o[4] += bf_lo(yv.z); o[5] += bf_hi(yv.z); o[6] += bf_lo(yv.w); o[7] += bf_hi(yv.w); }
                    u32x4 w; w.x = pk_bf16(o[0], o[1]); w.y = pk_bf16(o[2], o[3]); w.z = pk_bf16(o[4], o[5]); w.w = pk_bf16(o[6], o[7]);
                    *(u32x4*)yp = w;
                } }
    }
};

struct SchedY {
    int G, c; const char* OA; const char* OB; const char* WP;
    __device__ __forceinline__ bool next(int i, pg8::Unit& u) const {
        const int L = (i >> 1) * G + c;
        if (L >= 512) return false;
        const int pm = L & 63, pn = L >> 6; u.pm = pm; u.kstepA = 4096u;
        if ((i & 1) == 0) { u.pn = pn | 0x100; u.mode = 2u; u.A = OA + (size_t)pm * 8 * 64 * 2048; u.hstepA = 4u * 64u * 2048u; u.B = WP + (size_t)pn * 256 * 4096; }
        else { u.pn = pn; u.mode = 3u; const int bb = pm >> 5, pp = pm & 31;
            u.A = OB + ((size_t)(bb * 256 + (pp >> 3)) * 64 * 1024 + (size_t)(4 * (pp & 7)) * 32) * 2; u.hstepA = 2u * 32u * 2u; u.B = WP + (size_t)2048 * 4096 + (size_t)pn * 256 * 4096; }
        return true;
    }
};
struct EpiY2 {
    unsigned char* ws;
    __device__ __forceinline__ void operator()(const AccT& acc, const pg8::Unit& u, int wr, int wc, int fr, int fq) const {
        pg8::Unit v = u; v.pn = u.pn & 0xff;
        if (u.pn & 0x100) { EpiY<0> e{ws}; e(acc, v, wr, wc, fr, fq); } else { EpiY<1> e{ws}; e(acc, v, wr, wc, fr, fq); }
    }
};

struct EpiOut {
    const float* x; float* out; const float* mod; float* sso;
    __device__ __forceinline__ void operator()(const AccT& acc, const pg8::Unit& u, int wr, int wc, int fr, int fq) const {
        const int row0 = u.pm * 256 + wr * 64 + fr, col0 = u.pn * 256 + wc * 32 + 4 * fq;
        const float* gate = mod + (size_t)(u.pm >> 5) * 6144 + 4096;
        f32x4 gv[2][2];
#pragma unroll
        for (int bj = 0; bj < 2; ++bj)
#pragma unroll
            for (int n = 0; n < 2; ++n) gv[bj][n] = *(const f32x4*)(gate + col0 + bj * 128 + n * 16);
#pragma unroll
        for (int ai = 0; ai < 2; ++ai)
#pragma unroll
            for (int mh = 0; mh < 2; ++mh) {
                f32x4 xv[2][2][2];
#pragma unroll
                for (int mm = 0; mm < 2; ++mm) { const size_t off = (size_t)(row0 + ai * 128 + (2 * mh + mm) * 16) * 2048 + col0;
#pragma unroll
                    for (int bj = 0; bj < 2; ++bj)
#pragma unroll
                        for (int n = 0; n < 2; ++n) xv[mm][bj][n] = *(const f32x4*)(x + off + bj * 128 + n * 16); }
#pragma unroll
                for (int mm = 0; mm < 2; ++mm) { const int m = 2 * mh + mm; const int row = row0 + ai * 128 + m * 16; const size_t off = (size_t)row * 2048 + col0; float s = 0.f;
#pragma unroll
                    for (int bj = 0; bj < 2; ++bj)
#pragma unroll
                        for (int n = 0; n < 2; ++n) { const f32x4 o = xv[mm][bj][n] + gv[bj][n] * acc[ai][bj][m][n];
                            *(f32x4*)(out + off + bj * 128 + n * 16) = o; s += (o[0] * o[0] + o[1] * o[1]) + (o[2] * o[2] + o[3] * o[3]); }
                    s += __shfl_xor(s, 16); s += __shfl_xor(s, 32);
                    if (fq == 0) sso[(size_t)row * 32 + u.pn * 4 + wc] = s; }
            }
    }
};

__device__ __forceinline__ void transpose_item(const float* W, int N, int n0, int k0, u16* WTrow0, LAS float* scr, int lane) {
    float tv[32];
#pragma unroll
    for (int i = 0; i < 32; ++i) tv[i] = W[(size_t)(k0 + 2 * i + (lane >> 5)) * N + n0 + (lane & 31)];
#pragma unroll
    for (int i = 0; i < 32; ++i) scr[(2 * i + (lane >> 5)) * 33 + (lane & 31)] = tv[i];
    LDS_WAIT(); asm volatile("" ::: "memory");
    const int c = lane & 7;
#pragma unroll
    for (int j = 0; j < 4; ++j) { const int n = (lane >> 3) + 8 * j; const LAS float* s = scr + (8 * c) * 33 + n;
        u32x4 o; o.x = pk_bf16(s[0 * 33], s[1 * 33]); o.y = pk_bf16(s[2 * 33], s[3 * 33]); o.z = pk_bf16(s[4 * 33], s[5 * 33]); o.w = pk_bf16(s[6 * 33], s[7 * 33]);
        *(u32x4*)(WTrow0 + (size_t)n * 2048 + k0 + 8 * c) = o; }
    LDS_WAIT(); asm volatile("" ::: "memory");
}

__device__ __forceinline__ void phase0(const Params& p, LAS unsigned char* lds) {
    const int tid = threadIdx.x, wid = tid >> 6, lane = tid & 63;
    unsigned char* ws = p.ws;
    if (blockIdx.x < 192) {
        LAS float* sl = (LAS float*)lds;
        LAS float* red = (LAS float*)lds + 6144;
        for (int i = tid; i < 3 * 2048; i += 512) { const int v = i >> 11, d = i & 2047; const float cv = (v < 2) ? p.c[v * 2048 + d] : p.c_ctx[d]; sl[i] = cv * sigmoidf_(cv); }
        __syncthreads();
        const int cg4 = tid & 7, kl = tid >> 3;
        const int col = blockIdx.x * 32 + cg4 * 4;
        f32x4 a0 = {0, 0, 0, 0}, a1 = {0, 0, 0, 0}, a2 = {0, 0, 0, 0};
#pragma unroll 8
        for (int k = kl; k < 2048; k += 64) { const f32x4 w = *(const f32x4*)(p.w_ada + (size_t)k * 6144 + col); a0 += sl[k] * w; a1 += sl[2048 + k] * w; a2 += sl[4096 + k] * w; }
        LAS float* rp = red + tid * 12;
#pragma unroll
        for (int e = 0; e < 4; ++e) { rp[e] = a0[e]; rp[4 + e] = a1[e]; rp[8 + e] = a2[e]; }
        __syncthreads();
        if (tid < 96) { const int v = tid >> 5, cc = tid & 31, g4 = cc >> 2, e = cc & 3; float s = 0.f;
            for (int k = 0; k < 64; ++k) s += red[(k * 8 + g4) * 12 + v * 4 + e];
            ((float*)(ws + WS_MOD))[v * 6144 + blockIdx.x * 32 + cc] = s + p.b_ada[blockIdx.x * 32 + cc]; }
        __syncthreads();
    }
    LAS float* scr = (LAS float*)(lds + 65536 + wid * 8448);
    const int gw = blockIdx.x * 8 + wid, NGW = gridDim.x * 8;
    constexpr int I_IN = 32 * 641;
    u16* WTS = (u16*)(ws + WS_WTS); u16* WTG = (u16*)(ws + WS_WTG);
    for (int it = gw; it < I_IN; it += NGW) {
        const int kb = it / 641, cb = it - kb * 641, n0 = cb * 32;
        u16* dst;
        if (n0 < 8192) dst = WTS + (size_t)n0 * 2048;
        else if (n0 < 10240) dst = WTG + (size_t)(n0 - 8192) * 2048;
        else if (n0 < 14336) dst = WTS + (size_t)(8192 + n0 - 10240) * 2048;
        else if (n0 == 14336) dst = WTS + (size_t)12288 * 2048;
        else if (n0 < 16416) dst = WTG + (size_t)(2048 + n0 - 14368) * 2048;
        else dst = WTG + (size_t)(4096 + n0 - 16416) * 2048;
        transpose_item(p.w_in, N_IN, n0, kb * 64, dst, scr, lane);
    }
    { u32x4* z = (u32x4*)(WTS + (size_t)12320 * 2048); const int nz = 224 * 2048 * 2 / 16;
      for (int i = blockIdx.x * 512 + tid; i < nz; i += gridDim.x * 512) z[i] = (u32x4){0u, 0u, 0u, 0u}; }
}

__device__ __forceinline__ void phase_wtp(const Params& p, LAS unsigned char* lds) {
    const int tid = threadIdx.x, wid = tid >> 6, lane = tid & 63;
    LAS float* scr = (LAS float*)(lds + wid * 8448);
    const int gw = blockIdx.x * 8 + wid, NGW = gridDim.x * 8;
    u16* WTP = (u16*)(p.ws + WS_WTP);
    for (int it = gw; it < 3 * 2048; it += NGW) {
        const int which = it >> 11, r = it & 2047;
        const float* W = which == 0 ? p.w_pa : (which == 1 ? p.w_pb : p.w_out);
        const int kb = r >> 6, cb = r & 63;
        transpose_item(W, 2048, cb * 32, kb * 64, WTP + (size_t)which * 2048 * 2048 + (size_t)(cb * 32) * 2048, scr, lane);
    }
    __syncthreads();
}

__device__ __forceinline__ void phase1(const Params& p) {
    const int tid = threadIdx.x, wid = tid >> 6, lane = tid & 63;
    const float* mod = (const float*)(p.ws + WS_MOD);
    u16* H = (u16*)(p.ws + WS_H);
    for (int i = blockIdx.x * 512 + tid; i < 64 * 256 * 4; i += gridDim.x * 512) ((unsigned*)(p.ws + WS_FLG))[i] = 0u;
    if (blockIdx.x == 0 && tid == 0) *(unsigned*)(p.ws + 256) = 0u;
    for (int m0 = 2 * (blockIdx.x * 8 + wid); m0 < M_ALL; m0 += 2 * gridDim.x * 8) {
        f32x4 xv[2][8]; float ss[2] = {0.f, 0.f};
#pragma unroll
        for (int rr = 0; rr < 2; ++rr) { const int m = m0 + rr;
            const float* src = (m < M_LAT) ? p.x + (size_t)m * D : p.ctx + (size_t)(m - M_LAT) * D;
            const f32x4* s4 = (const f32x4*)src + lane;
#pragma unroll
            for (int j = 0; j < 8; ++j) xv[rr][j] = s4[64 * j]; }
#pragma unroll
        for (int rr = 0; rr < 2; ++rr)
#pragma unroll
            for (int j = 0; j < 8; ++j) ss[rr] += (xv[rr][j][0] * xv[rr][j][0] + xv[rr][j][1] * xv[rr][j][1]) + (xv[rr][j][2] * xv[rr][j][2] + xv[rr][j][3] * xv[rr][j][3]);
#pragma unroll
        for (int rr = 0; rr < 2; ++rr) { const int m = m0 + rr;
            const int v = (m < M_LAT) ? (m >> 13) : 2;
            const float rstd = rsqrtf(wave_sum(ss[rr]) * (1.0f / D) + EPS);
            u32x2* o8 = (u32x2*)(H + (size_t)m * D) + lane;
#pragma unroll
            for (int j = 0; j < 8; ++j) { const int col = 4 * (lane + 64 * j);
                const f32x4 g = *(const f32x4*)(p.norm_g + col), sh = *(const f32x4*)(mod + v * 6144 + col), sc = *(const f32x4*)(mod + v * 6144 + 2048 + col);
                const f32x4 y = (xv[rr][j] * rstd * g) * (sc + 1.0f) + sh;
                o8[64 * j] = (u32x2){pk_bf16(y[0], y[1]), pk_bf16(y[2], y[3])}; } }
    }
}

__device__ __forceinline__ void phase2b(const Params& p, LAS unsigned char* lds) {
    const int tid = threadIdx.x;
    const float* R = (const float*)(p.ws + WS_R);
    u16* LFB = (u16*)(p.ws + WS_LFB);
    LAS float* rs = (LAS float*)lds;
    float w[2][2][16], bias[2][2];
#pragma unroll
    for (int d = 0; d < 2; ++d)
#pragma unroll
        for (int cc = 0; cc < 2; ++cc) { bias[d][cc] = p.gk_b[d * 1024 + cc * 512 + tid];
#pragma unroll
            for (int r = 0; r < 16; ++r) w[d][cc][r] = p.gk_w[(size_t)(d * 16 + r) * 1024 + cc * 512 + tid]; }
    int buf = 0;
    for (int chunk = blockIdx.x; chunk < NCHUNK; chunk += gridDim.x, buf ^= 1) {
        LAS float* rb = rs + buf * 1024;
        { const f32x2 v = *(const f32x2*)(R + (size_t)chunk * 1024 + 2 * tid); *(LAS f32x2*)(rb + 2 * tid) = v; }
        __syncthreads();
#pragma unroll
        for (int d = 0; d < 2; ++d)
#pragma unroll 1
            for (int t8 = 0; t8 < 4; ++t8) {
                float z[2][8];
#pragma unroll
                for (int cc = 0; cc < 2; ++cc)
#pragma unroll
                    for (int e = 0; e < 8; ++e) z[cc][e] = bias[d][cc];
#pragma unroll
                for (int r = 0; r < 16; ++r) {
                    LAS float* ra = rb + (d * 16 + r) * 32 + t8 * 8; asm volatile("" : "+v"(ra));
                    const f32x4 r0 = *(const LAS f32x4*)ra, r1 = *(const LAS f32x4*)(ra + 4);
#pragma unroll
                    for (int cc = 0; cc < 2; ++cc) { const float ww = w[d][cc][r];
#pragma unroll
                        for (int e = 0; e < 4; ++e) { z[cc][e] = __builtin_fmaf(r0[e], ww, z[cc][e]); z[cc][4 + e] = __builtin_fmaf(r1[e], ww, z[cc][4 + e]); } }
                }
#pragma unroll
                for (int cc = 0; cc < 2; ++cc) {
                    float zz[8];
#pragma unroll
                    for (int e = 0; e < 8; ++e) zz[e] = z[cc][e];
#pragma unroll
                    for (int e = 0; e < 8; ++e) { const float a = fabsf(zz[e]); zz[e] = (fminf(zz[e], 0.f) - __logf(1.0f + __expf(-a))) * (0.0625f * 1.4426950408889634f); }
                    u32x4 o; o.x = pk_f16(zz[0], zz[1]); o.y = pk_f16(zz[2], zz[3]); o.z = pk_f16(zz[4], zz[5]); o.w = pk_f16(zz[6], zz[7]);
                    *(u32x4*)(LFB + ((((size_t)d * NCHUNK + chunk) * 4 + t8) * 1024 + cc * 512 + tid) * 8) = o;
                }
            }
    }
    __syncthreads();
}

__device__ __forceinline__ bf16x8 pack8(const f32x16& x, int s) {
    u32x4 pk; pk.x = pk_bf16(x[8 * s + 0], x[8 * s + 1]); pk.y = pk_bf16(x[8 * s + 2], x[8 * s + 3]); pk.z = pk_bf16(x[8 * s + 4], x[8 * s + 5]); pk.w = pk_bf16(x[8 * s + 6], x[8 * s + 7]);
    return __builtin_bit_cast(bf16x8, pk);
}
__device__ __forceinline__ unsigned rot16(unsigned x) { return (x >> 16) | (x << 16); }
template <int NW> __device__ __forceinline__ void maybe_rev(unsigned (&w)[NW], bool rev) {
    unsigned r[NW];
#pragma unroll
    for (int k = 0; k < NW; ++k) r[k] = rot16(w[NW - 1 - k]);
#pragma unroll
    for (int k = 0; k < NW; ++k) w[k] = rev ? r[k] : w[k];
}
__device__ __forceinline__ void ld16(unsigned (&w)[8], const u16* p) { const u32x4 a = *(const u32x4*)p, b = *(const u32x4*)(p + 8); w[0] = a.x; w[1] = a.y; w[2] = a.z; w[3] = a.w; w[4] = b.x; w[5] = b.y; w[6] = b.z; w[7] = b.w; }
__device__ __forceinline__ void ld16q(unsigned (&w)[8], const u16* p, size_t qstride) { const u32x4 a = *(const u32x4*)p, b = *(const u32x4*)(p + qstride); w[0] = a.x; w[1] = a.y; w[2] = a.z; w[3] = a.w; w[4] = b.x; w[5] = b.y; w[6] = b.z; w[7] = b.w; }
__device__ __forceinline__ void ld32(unsigned (&w)[16], const u16* p) {
#pragma unroll
    for (int k = 0; k < 4; ++k) { const u32x4 a = *(const u32x4*)(p + 8 * k); w[4 * k] = a.x; w[4 * k + 1] = a.y; w[4 * k + 2] = a.z; w[4 * k + 3] = a.w; }
}

#define DSR128(dst, addr, off) asm volatile("ds_read_b128 %0, %1 offset:%2" : "=v"(dst) : "v"(addr), "i"(off))
#define SBAR() do { asm volatile("s_waitcnt lgkmcnt(0)" ::: "memory"); __builtin_amdgcn_s_barrier(); asm volatile("" ::: "memory"); } while (0)
__device__ __forceinline__ f32x2 h2_sel(unsigned w0, unsigned w1, int hi) { return (f32x2){h_sel(w0, hi), h_sel(w1, hi)}; }
__device__ __forceinline__ f32x2 bf2_sel(unsigned w0, unsigned w1, int hi) { return (f32x2){bf_sel(w0, hi), bf_sel(w1, hi)}; }
#define GLD128(dst, ptr) asm volatile("global_load_dwordx4 %0, %1, off" : "=v"(dst) : "v"(ptr) : "memory")
#define GLD128_SC1(dst, ptr, off) asm volatile("global_load_dwordx4 %0, %1, off offset:%2 sc1" : "=v"(dst) : "v"(ptr), "i"(off) : "memory")
__device__ __forceinline__ unsigned wsel(const u32x4 (&v)[2], int w) { return v[w >> 2][w & 3]; }
__device__ __forceinline__ float vmul(float a, float b) { float r; asm("v_mul_f32_e32 %0, %1, %2" : "=v"(r) : "v"(a), "v"(b)); return r; }
__device__ __forceinline__ float vmul_v(float a, float b) { float r; asm volatile("v_mul_f32_e32 %0, %1, %2" : "=v"(r) : "v"(a), "v"(b)); return r; }
__device__ __forceinline__ float vmul_t(float a, float b) { float r; asm("s_nop 1\n\tv_mul_f32_e32 %0, %1, %2" : "=v"(r) : "v"(a), "v"(b)); return r; }
template <int DK, bool IS_A, int DIRC>
__device__ __forceinline__ void producer_loop(const Params& p, LAS unsigned char* lds, int b, int hh, int quarter, int pair, int pw, int ptid, int lane) {
    constexpr int QSTR = DK * 2 + 16, RSTR = 80;
    constexpr int OFF_KS = 32 * QSTR, OFF_KST = 2 * 32 * QSTR, OFF_VT = OFF_KST + DK * RSTR, OFF_DD = OFF_VT + 128 * RSTR, OFF_PD = OFF_DD + DK * 4, BUFB = OFF_PD + 4 * 32 * RSTR;
    constexpr int dir = DIRC;
    constexpr int NS = IS_A ? 6 : 14;
    const int h = lane >> 5, l31 = lane & 31;
    unsigned char* ws = p.ws;
    const u16* Qg = (const u16*)(ws + (IS_A ? WS_AQ : WS_BQ));
    const u16* Kg = (const u16*)(ws + WS_BK);
    const u16* Vg = (const u16*)(ws + (IS_A ? WS_AV : WS_BV));
    const u16* LFg = IS_A ? (const u16*)(ws + WS_ALF) + (size_t)dir * NCHUNK * 2048 * 32 : (const u16*)(ws + WS_LFB) + (size_t)dir * NCHUNK * 1024 * 32;
    unsigned* flg = (unsigned*)(ws + WS_FLG) + pair * 1024;
    const u16* Ogc = (const u16*)p.out + (IS_A ? 0 : (size_t)M_LAT * 2048);
    (void)ptid; (void)Kg;
#define STEP_CHUNK(k, is_ctx_, lc_, cidx_) const bool is_ctx_ = (k) < 8; const int lc_ = is_ctx_ ? (dir ? 7 - (k) : (k)) : (dir ? 263 - (k) : (k) - 8); const int cidx_ = is_ctx_ ? 512 + b * 8 + lc_ : b * 256 + lc_;
#define PD_LOADS(kq_, PD4) do { \
        STEP_CHUNK(kq_, icf, lcf, cidxf); (void)icf; (void)cidxf; \
        const u16* src = Ogc + ((size_t)(b * 256 + lcf) * 64 + (IS_A ? hh * 4 : hh * 16 + quarter * 4) + pw) * 1024 + lane * 8; \
        GLD128_SC1(PD4[0], src, 0); GLD128_SC1(PD4[1], src, 1024); \
    } while (0)
#define PD_ISSUE(kk, PD4) do { const int kq2_ = ((kk) >= 136 && (kk) < 264) ? (kk) : 136; PD_LOADS(kq2_, PD4); } while (0)
#define PD_FIRST(kk, PD4) do { if ((kk) == 136) { \
        STEP_CHUNK(136, icg, lcg, cidxg); (void)icg; (void)cidxg; unsigned spins = 0; \
        while (__hip_atomic_load(flg + lcg * 4 + pw, __ATOMIC_RELAXED, __HIP_MEMORY_SCOPE_AGENT) == 0u) { __builtin_amdgcn_s_sleep(2); if (++spins > (1u << 22)) break; } \
        PD_LOADS(136, PD4); \
        asm volatile("s_waitcnt vmcnt(0)" : "+v"(PD4[0]), "+v"(PD4[1])); } } while (0)
#define PD_STORE(PD4) do { _Pragma("unroll") for (int j_ = 0; j_ < 2; ++j_) *(LAS u32x4*)(buf + OFF_PD + (pw * 32 + 16 * j_ + (lane >> 2)) * RSTR + (lane & 3) * 16) = PD4[j_]; } while (0)
#define BUF_PTRS(kk) LAS unsigned char* buf = lds + ((kk) & 1) * BUFB; LAS unsigned char* QS = buf; LAS unsigned char* KS = buf + OFF_KS; LAS unsigned char* KST = buf + OFF_KST; LAS unsigned char* VT = buf + OFF_VT; LAS float* DD = (LAS float*)(buf + OFF_DD);
#define WAITV(n, ...) asm volatile("s_waitcnt vmcnt(" #n ")" : __VA_ARGS__)
    if (IS_A) {
        const int c = 32 * pw + l31, th = h;
#define LOAD_A(LF, QW, VW, kk) do { const int kl_ = (kk) < 264 ? (kk) : 263; STEP_CHUNK(kl_, ic, lc, cidx); (void)lc; (void)ic; \
            const size_t eo = (((size_t)cidx * 4 + 2 * th) * 2048 + hh * 128 + c) * 8; \
            GLD128(LF[0], LFg + eo); GLD128(LF[1], LFg + eo + 2048 * 8); GLD128(QW[0], Qg + eo); GLD128(QW[1], Qg + eo + 2048 * 8); GLD128(VW[0], Vg + eo); GLD128(VW[1], Vg + eo + 2048 * 8); } while (0)
#define PROC_A(LF, QW, VW, kk, PC, PN) do { \
            BUF_PTRS(kk) \
            PD_FIRST(kk, PC); \
            PD_ISSUE((kk) + 1, PN); \
            asm volatile("s_waitcnt vmcnt(10)" : "+v"(LF[0]), "+v"(LF[1]), "+v"(QW[0]), "+v"(QW[1]), "+v"(VW[0]), "+v"(VW[1]));     \
            float E[16], kk_[16]; float run = 1.f; \
            _Pragma("unroll") for (int it_ = 0; it_ < 16; ++it_) { const int it = dir ? 15 - it_ : it_; const float f = __builtin_amdgcn_exp2f(h_sel(wsel(LF, it >> 1), it & 1)); run = vmul_t(run, f); E[it] = run; kk_[it] = 1.0f - f; } \
            const float other = __shfl_xor(run, 32); \
            const float pre = (dir ? (th == 0) : (th == 1)) ? other : 1.0f; \
            unsigned kst[8]; \
            _Pragma("unroll") for (int it = 0; it < 16; it += 2) { \
                float ks2[2]; \
                _Pragma("unroll") for (int e = 0; e < 2; ++e) { const int i2 = it + e; const float ev = vmul(E[i2], pre); const float qs = vmul(bf_sel(wsel(QW, i2 >> 1), i2 & 1), ev); ks2[e] = vmul_t(kk_[i2], __builtin_amdgcn_rcpf(fmaxf(ev, 1e-30f))); \
                    const int i = 16 * th + i2; \
                    *(LAS u16*)(QS + i * QSTR + c * 2) = (u16)(pk_bf16(qs, 0.f) & 0xffffu); \
                    *(LAS u16*)(KS + i * QSTR + c * 2) = (u16)(pk_bf16(ks2[e], 0.f) & 0xffffu); } \
                kst[it >> 1] = pk_bf16(ks2[0], ks2[1]); \
            } \
            if (dir ? (th == 0) : (th == 1)) DD[c] = vmul(dir ? E[0] : E[15], pre); \
            *(LAS u32x4*)(KST + c * RSTR + th * 32) = (u32x4){kst[0], kst[1], kst[2], kst[3]}; \
            *(LAS u32x4*)(KST + c * RSTR + th * 32 + 16) = (u32x4){kst[4], kst[5], kst[6], kst[7]}; \
            *(LAS u32x4*)(VT + c * RSTR + th * 32) = VW[0]; \
            *(LAS u32x4*)(VT + c * RSTR + th * 32 + 16) = VW[1]; \
            asm volatile("s_waitcnt vmcnt(8)" : "+v"(PC[0]), "+v"(PC[1]));     \
            PD_STORE(PC); \
        } while (0)
        static_assert(NS == 6 || !IS_A, "wait counts");
        u32x4 lf0[2], q0_[2], v0_[2], lf1[2], q1_[2], v1_[2]; u32x4 pe[2], po[2];
        LOAD_A(lf0, q0_, v0_, 0); PD_ISSUE(0, pe); LOAD_A(lf1, q1_, v1_, 1);
#pragma unroll 1
        for (int k = 0; k < 264; k += 2) {
            PROC_A(lf0, q0_, v0_, k, pe, po); LOAD_A(lf0, q0_, v0_, k + 2); SBAR();
            PROC_A(lf1, q1_, v1_, k + 1, po, pe); LOAD_A(lf1, q1_, v1_, k + 3); SBAR();
        }
        asm volatile("s_waitcnt vmcnt(0)" ::: "memory");
#undef LOAD_A
#undef PROC_A
    } else {
        const int cp = 32 * pw + l31, th = h;
        const int col = ptid & 127, thv = ptid >> 7;
#define LOAD_B(LF, QW, KW, VW, kk) do { const int kl_ = (kk) < 264 ? (kk) : 263; STEP_CHUNK(kl_, ic, lc, cidx); (void)lc; (void)ic; \
            const size_t eo = (((size_t)cidx * 4 + 2 * th) * 1024 + hh * 256 + 2 * cp) * 8; const size_t evv = (((size_t)cidx * 4 + 2 * thv) * 2048 + hh * 512 + quarter * 128 + col) * 8; \
            GLD128(LF[0][0], LFg + eo); GLD128(LF[0][1], LFg + eo + 1024 * 8); GLD128(LF[1][0], LFg + eo + 8); GLD128(LF[1][1], LFg + eo + 8 + 1024 * 8); \
            GLD128(KW[0][0], Kg + eo); GLD128(KW[0][1], Kg + eo + 1024 * 8); GLD128(KW[1][0], Kg + eo + 8); GLD128(KW[1][1], Kg + eo + 8 + 1024 * 8); \
            GLD128(QW[0][0], Qg + eo); GLD128(QW[0][1], Qg + eo + 1024 * 8); GLD128(QW[1][0], Qg + eo + 8); GLD128(QW[1][1], Qg + eo + 8 + 1024 * 8); \
            GLD128(VW[0], Vg + evv); GLD128(VW[1], Vg + evv + 2048 * 8); } while (0)
#define PROC_B(LF, QW, KW, VW, kk, PC, PN) do { \
            BUF_PTRS(kk) \
            PD_FIRST(kk, PC); \
            PD_ISSUE((kk) + 1, PN); \
            asm volatile("s_waitcnt vmcnt(18)" : "+v"(LF[0][0]), "+v"(LF[0][1]), "+v"(LF[1][0]), "+v"(LF[1][1]), "+v"(KW[0][0]), "+v"(KW[0][1]), "+v"(KW[1][0]), "+v"(KW[1][1]), \
                         "+v"(QW[0][0]), "+v"(QW[0][1]), "+v"(QW[1][0]), "+v"(QW[1][1]), "+v"(VW[0]), "+v"(VW[1]));     \
            float E0[16], E1[16]; float r0 = 1.f, r1 = 1.f; \
            _Pragma("unroll") for (int it_ = 0; it_ < 16; ++it_) { const int it = dir ? 15 - it_ : it_; \
                const float f0 = __builtin_amdgcn_exp2f(h_sel(wsel(LF[0], it >> 1), it & 1)), f1 = __builtin_amdgcn_exp2f(h_sel(wsel(LF[1], it >> 1), it & 1)); \
                r0 = vmul_t(r0, f0); r1 = vmul_t(r1, f1); E0[it] = r0; E1[it] = r1; } \
            const float o0 = __shfl_xor(r0, 32), o1 = __shfl_xor(r1, 32); \
            const bool tail = dir ? (th == 0) : (th == 1); \
            const float pre0 = tail ? o0 : 1.f, pre1 = tail ? o1 : 1.f; \
            unsigned kst0[8], kst1[8]; \
            _Pragma("unroll") for (int it = 0; it < 16; it += 2) { \
                float ka[2], kb[2]; \
                _Pragma("unroll") for (int e = 0; e < 2; ++e) { const int i2 = it + e; const float ev0 = vmul(E0[i2], pre0), ev1 = vmul(E1[i2], pre1); \
                    const float qs0 = vmul(bf_sel(wsel(QW[0], i2 >> 1), i2 & 1), ev0), qs1 = vmul(bf_sel(wsel(QW[1], i2 >> 1), i2 & 1), ev1); \
                    ka[e] = vmul_t(bf_sel(wsel(KW[0], i2 >> 1), i2 & 1), __builtin_amdgcn_rcpf(ev0)); kb[e] = vmul_t(bf_sel(wsel(KW[1], i2 >> 1), i2 & 1), __builtin_amdgcn_rcpf(ev1)); \
                    const int i = 16 * th + i2; \
                    *(LAS unsigned*)(QS + i * QSTR + cp * 4) = pk_bf16(qs0, qs1); \
                    *(LAS unsigned*)(KS + i * QSTR + cp * 4) = pk_bf16(ka[e], kb[e]); } \
                kst0[it >> 1] = pk_bf16(ka[0], ka[1]); kst1[it >> 1] = pk_bf16(kb[0], kb[1]); \
            } \
            if (tail) { *(LAS f32x2*)(DD + 2 * cp) = (f32x2){vmul(dir ? E0[0] : E0[15], pre0), vmul(dir ? E1[0] : E1[15], pre1)}; } \
            *(LAS u32x4*)(KST + (2 * cp) * RSTR + th * 32) = (u32x4){kst0[0], kst0[1], kst0[2], kst0[3]}; \
            *(LAS u32x4*)(KST + (2 * cp) * RSTR + th * 32 + 16) = (u32x4){kst0[4], kst0[5], kst0[6], kst0[7]}; \
            *(LAS u32x4*)(KST + (2 * cp + 1) * RSTR + th * 32) = (u32x4){kst1[0], kst1[1], kst1[2], kst1[3]}; \
            *(LAS u32x4*)(KST + (2 * cp + 1) * RSTR + th * 32 + 16) = (u32x4){kst1[4], kst1[5], kst1[6], kst1[7]}; \
            *(LAS u32x4*)(VT + col * RSTR + thv * 32) = VW[0]; \
            *(LAS u32x4*)(VT + col * RSTR + thv * 32 + 16) = VW[1]; \
            asm volatile("s_waitcnt vmcnt(16)" : "+v"(PC[0]), "+v"(PC[1]));     \
            PD_STORE(PC); \
        } while (0)
        static_assert(NS == 14 || IS_A, "wait counts");
        u32x4 lf0[2][2], q0_[2][2], k0_[2][2], v0_[2], lf1[2][2], q1_[2][2], k1_[2][2], v1_[2]; u32x4 pe[2], po[2];
        LOAD_B(lf0, q0_, k0_, v0_, 0); PD_ISSUE(0, pe); LOAD_B(lf1, q1_, k1_, v1_, 1);
#pragma unroll 1
        for (int k = 0; k < 264; k += 2) {
            PROC_B(lf0, q0_, k0_, v0_, k, pe, po); LOAD_B(lf0, q0_, k0_, v0_, k + 2); SBAR();
            PROC_B(lf1, q1_, k1_, v1_, k + 1, po, pe); LOAD_B(lf1, q1_, k1_, v1_, k + 3); SBAR();
        }
        asm volatile("s_waitcnt vmcnt(0)" ::: "memory");
#undef LOAD_B
#undef PROC_B
    }
#undef WAITV
#undef PD_LOADS
#undef PD_FIRST
#undef PD_ISSUE
#undef PD_STORE
#undef BUF_PTRS
#undef STEP_CHUNK
}

template <int DK, bool IS_A>
__device__ __forceinline__ void scan_unit(const Params& p, LAS unsigned char* lds, int b, int hh, int quarter, int dir, int pair) {
    constexpr int NT = DK / 32;
    constexpr int QSTR = DK * 2 + 16;
    constexpr int RSTR = 80;
    constexpr int OFF_KS = 32 * QSTR, OFF_KST = 2 * 32 * QSTR, OFF_VT = OFF_KST + DK * RSTR, OFF_DD = OFF_VT + 128 * RSTR, OFF_PD = OFF_DD + DK * 4, BUFB = OFF_PD + 4 * 32 * RSTR;
    static_assert(2 * BUFB <= LDS_BYTES, "scan LDS");
    const int tid = threadIdx.x, wid = __builtin_amdgcn_readfirstlane(tid >> 6), lane = tid & 63;
    const int h = lane >> 5, l31 = lane & 31;
    unsigned char* ws = p.ws;
    const u16* Qg = (const u16*)(ws + (IS_A ? WS_AQ : WS_BQ));
    const u16* Kg = (const u16*)(ws + WS_BK);
    const u16* Vg = (const u16*)(ws + (IS_A ? WS_AV : WS_BV));
    const u16* LFg = IS_A ? (const u16*)(ws + WS_ALF) + (size_t)dir * NCHUNK * 2048 * 32 : (const u16*)(ws + WS_LFB) + (size_t)dir * NCHUNK * 1024 * 32;
    unsigned* flg = (unsigned*)(ws + WS_FLG) + pair * 1024;
    const u16* Ogc = (const u16*)p.out + (IS_A ? 0 : (size_t)M_LAT * 2048);
#define STEP_CHUNK(k, is_ctx_, lc_, cidx_) const bool is_ctx_ = (k) < 8; const int lc_ = is_ctx_ ? (dir ? 7 - (k) : (k)) : (dir ? 263 - (k) : (k) - 8); const int cidx_ = is_ctx_ ? 512 + b * 8 + lc_ : b * 256 + lc_;
    if (wid >= 4) {
        const int pw = wid - 4, ptid = tid - 256;
        if (dir) producer_loop<DK, IS_A, 1>(p, lds, b, hh, quarter, pair, pw, ptid, lane);
        else producer_loop<DK, IS_A, 0>(p, lds, b, hh, quarter, pair, pw, ptid, lane);
        SBAR();
    } else {
        const int w = wid;
        u16* Og = (u16*)p.out + (IS_A ? 0 : (size_t)M_LAT * 2048);
        float* SSg = (float*)(ws + (IS_A ? WS_SSA : WS_SSB));
        const int ocol0 = IS_A ? hh * 128 + 32 * w : hh * 512 + quarter * 128 + 32 * w;
        const int sspart = IS_A ? hh * 4 + w : hh * 16 + quarter * 4 + w;
        const int prow = (l31 & 3) + 8 * ((l31 >> 2) & 1) + 4 * ((l31 >> 3) & 1) + 16 * (l31 >> 4);
        f32x16 S[NT];
#pragma unroll
        for (int t = 0; t < NT; ++t)
#pragma unroll
            for (int r = 0; r < 16; ++r) S[t][r] = 0.f;
        unsigned mk[2][4];
#pragma unroll
        for (int s2 = 0; s2 < 2; ++s2)
#pragma unroll
            for (int q = 0; q < 4; ++q) { const int r0 = 8 * s2 + 2 * q; const int j0 = (r0 & 3) + 8 * (r0 >> 2) + 4 * h, j1 = j0 + 1;
                const bool k0 = dir ? (j0 >= l31) : (j0 <= l31), k1 = dir ? (j1 >= l31) : (j1 <= l31);
                mk[s2][q] = (k0 ? 0xffffu : 0u) | (k1 ? 0xffff0000u : 0u); }
        SBAR();
#pragma unroll 1
        for (int k = 0; k < 264; ++k) {
            STEP_CHUNK(k, is_ctx, lc, cidx); (void)cidx;
            LAS unsigned char* buf = lds + (k & 1) * BUFB;
            LAS unsigned char* QS = buf; LAS unsigned char* KS = buf + OFF_KS; LAS unsigned char* KST = buf + OFF_KST; LAS unsigned char* VT = buf + OFF_VT; LAS float* DD = (LAS float*)(buf + OFF_DD);
            const bool fin = k >= 136;
            int row = 0;
            if (!is_ctx) { if (IS_A) row = b * SEQ + 32 * lc + l31; else { const int pp = 32 * lc + l31; row = b * SEQ + (pp & 127) * 64 + (pp >> 7); } }
            u16* otile = Og + ((size_t)(b * 256 + lc) * 64 + (IS_A ? hh * 4 : hh * 16 + quarter * 4) + w) * 1024;
            LAS unsigned char* orow = buf + OFF_PD + (w * 32 + l31) * RSTR + 8 * h;
            bf16x8 vk[2];
            f32x16 OT;
#pragma unroll
            for (int r = 0; r < 16; ++r) OT[r] = 0.f;
            if (!is_ctx) {
                f32x16 PT;
#pragma unroll
                for (int r = 0; r < 16; ++r) PT[r] = 0.f;
                {
                    LAS unsigned char* qa = QS + l31 * QSTR + 16 * h;
                    u32x4 fq[2][2], fk[2][2];
                    DSR128(fq[0][0], qa, 0); DSR128(fk[0][0], qa, OFF_KS); DSR128(fq[0][1], qa, 32); DSR128(fk[0][1], qa, OFF_KS + 32);
#define FSTEP(pp) if constexpr (NT > (pp)) { constexpr int s_ = (pp) & 1; \
                        if constexpr ((pp) + 1 < NT) { DSR128(fq[s_ ^ 1][0], qa, 64 * ((pp) + 1)); DSR128(fk[s_ ^ 1][0], qa, OFF_KS + 64 * ((pp) + 1)); \
                            DSR128(fq[s_ ^ 1][1], qa, 64 * ((pp) + 1) + 32); DSR128(fk[s_ ^ 1][1], qa, OFF_KS + 64 * ((pp) + 1) + 32); \
                            asm volatile("s_waitcnt lgkmcnt(4)" : "+v"(fq[s_][0]), "+v"(fk[s_][0]), "+v"(fq[s_][1]), "+v"(fk[s_][1])); } \
                        else asm volatile("s_waitcnt lgkmcnt(0)" : "+v"(fq[s_][0]), "+v"(fk[s_][0]), "+v"(fq[s_][1]), "+v"(fk[s_][1])); \
                        PT = __builtin_amdgcn_mfma_f32_32x32x16_bf16(__builtin_bit_cast(bf16x8, fk[s_][0]), __builtin_bit_cast(bf16x8, fq[s_][0]), PT, 0, 0, 0); \
                        OT = __builtin_amdgcn_mfma_f32_32x32x16_bf16(pack8(S[pp], 0), __builtin_bit_cast(bf16x8, fq[s_][0]), OT, 0, 0, 0); \
                        PT = __builtin_amdgcn_mfma_f32_32x32x16_bf16(__builtin_bit_cast(bf16x8, fk[s_][1]), __builtin_bit_cast(bf16x8, fq[s_][1]), PT, 0, 0, 0); \
                        OT = __builtin_amdgcn_mfma_f32_32x32x16_bf16(pack8(S[pp], 1), __builtin_bit_cast(bf16x8, fq[s_][1]), OT, 0, 0, 0); \
                        __builtin_amdgcn_sched_barrier(0); }
                    FSTEP(0) FSTEP(1) FSTEP(2) FSTEP(3) FSTEP(4) FSTEP(5) FSTEP(6) FSTEP(7)
#undef FSTEP
                }
#pragma unroll
                for (int s2 = 0; s2 < 2; ++s2) {
                    const u32x2 lo = *(const LAS u32x2*)(VT + (32 * w + l31) * RSTR + (16 * s2 + 4 * h) * 2);
                    const u32x2 hi = *(const LAS u32x2*)(VT + (32 * w + l31) * RSTR + (16 * s2 + 8 + 4 * h) * 2);
                    vk[s2] = __builtin_bit_cast(bf16x8, (u32x4){lo.x, lo.y, hi.x, hi.y});
                    u32x4 pw4 = __builtin_bit_cast(u32x4, pack8(PT, s2));
                    pw4.x &= mk[s2][0]; pw4.y &= mk[s2][1]; pw4.z &= mk[s2][2]; pw4.w &= mk[s2][3];
                    OT = __builtin_amdgcn_mfma_f32_32x32x16_bf16(vk[s2], __builtin_bit_cast(bf16x8, pw4), OT, 0, 0, 0);
                }
                float ss = 0.f;
#pragma unroll
                for (int g = 0; g < 4; ++g) {
                    float o0 = OT[4 * g], o1 = OT[4 * g + 1], o2 = OT[4 * g + 2], o3 = OT[4 * g + 3];
                    if (fin) {
                        const u32x2 pvv = *(const LAS u32x2*)(orow + 16 * g); const unsigned lo = pvv.x, hi = pvv.y;
                        o0 += bf_lo(lo); o1 += bf_hi(lo); o2 += bf_lo(hi); o3 += bf_hi(hi);
                        ss += (o0 * o0 + o1 * o1) + (o2 * o2 + o3 * o3);
                    }
                    *(LAS u32x2*)(orow + 16 * g) = (u32x2){pk_bf16(o0, o1), pk_bf16(o2, o3)};
                }
                asm volatile("s_waitcnt lgkmcnt(0)" ::: "memory");
#pragma unroll
                for (int j = 0; j < 2; ++j) {
                    const u32x4 tv = *(const LAS u32x4*)(buf + OFF_PD + (w * 32 + 16 * j + (lane >> 2)) * RSTR + (lane & 3) * 16);
                    u16* dst = otile + j * 512 + lane * 8;
                    if (fin) *(u32x4*)dst = tv;
                    else asm volatile("global_store_dwordx4 %0, %1, off sc1\n\ts_nop 1" :: "v"(dst), "v"(tv) : "memory");
                }
                if (fin) { ss += __shfl_xor(ss, 32); if (h == 0) SSg[(size_t)row * 64 + sspart] = ss; }
            }
            {
                bf16x8 vf[2];
#pragma unroll
                for (int s2 = 0; s2 < 2; ++s2) vf[s2] = *(const LAS bf16x8*)(VT + (32 * w + l31) * RSTR + (16 * s2 + 8 * h) * 2);
                LAS unsigned char* ka = KST + prow * RSTR + 16 * h;
                LAS unsigned char* da = (LAS unsigned char*)(DD + 8 * h);
                u32x4 kf[2][2];
                DSR128(kf[0][0], ka, 0); DSR128(kf[0][1], ka, 32);
#define USTEP(t) if constexpr (NT > (t)) { constexpr int s_ = (t) & 1; \
                    if constexpr ((t) + 1 < NT) { DSR128(kf[s_ ^ 1][0], ka, 32 * RSTR * ((t) + 1)); DSR128(kf[s_ ^ 1][1], ka, 32 * RSTR * ((t) + 1) + 32); \
                        asm volatile("s_waitcnt lgkmcnt(2)" : "+v"(kf[s_][0]), "+v"(kf[s_][1])); } \
                    else asm volatile("s_waitcnt lgkmcnt(0)" : "+v"(kf[s_][0]), "+v"(kf[s_][1])); \
                    S[t] = __builtin_amdgcn_mfma_f32_32x32x16_bf16(__builtin_bit_cast(bf16x8, kf[s_][0]), vf[0], S[t], 0, 0, 0); \
                    S[t] = __builtin_amdgcn_mfma_f32_32x32x16_bf16(__builtin_bit_cast(bf16x8, kf[s_][1]), vf[1], S[t], 0, 0, 0); \
                    __builtin_amdgcn_sched_barrier(0); }
                USTEP(0) USTEP(1) USTEP(2) USTEP(3) USTEP(4) USTEP(5) USTEP(6) USTEP(7)
#undef USTEP
                f32x4 dd[2][4];
                asm volatile("s_nop 15\n\ts_nop 15" ::: "memory");
                DSR128(dd[0][0], da, 0); DSR128(dd[0][1], da, 16); DSR128(dd[0][2], da, 64); DSR128(dd[0][3], da, 80);
#define DSTEP(t) if constexpr (NT > (t)) { constexpr int s_ = (t) & 1; \
                    if constexpr ((t) + 1 < NT) { DSR128(dd[s_ ^ 1][0], da, 128 * ((t) + 1)); DSR128(dd[s_ ^ 1][1], da, 128 * ((t) + 1) + 16); DSR128(dd[s_ ^ 1][2], da, 128 * ((t) + 1) + 64); DSR128(dd[s_ ^ 1][3], da, 128 * ((t) + 1) + 80); \
                        asm volatile("s_waitcnt lgkmcnt(4)" : "+v"(dd[s_][0]), "+v"(dd[s_][1]), "+v"(dd[s_][2]), "+v"(dd[s_][3])); } \
                    else asm volatile("s_waitcnt lgkmcnt(0)" : "+v"(dd[s_][0]), "+v"(dd[s_][1]), "+v"(dd[s_][2]), "+v"(dd[s_][3])); \
                    _Pragma("unroll") for (int r = 0; r < 4; ++r) { S[t][r] = vmul_v(S[t][r], dd[s_][0][r]); S[t][4 + r] = vmul_v(S[t][4 + r], dd[s_][1][r]); S[t][8 + r] = vmul_v(S[t][8 + r], dd[s_][2][r]); S[t][12 + r] = vmul_v(S[t][12 + r], dd[s_][3][r]); } \
                    asm volatile("" : "+v"(S[t])); __builtin_amdgcn_sched_barrier(0); }
                DSTEP(0) DSTEP(1) DSTEP(2) DSTEP(3) DSTEP(4) DSTEP(5) DSTEP(6) DSTEP(7)
#undef DSTEP
            }
            constexpr int FLAG_LAG = 8;
            if (k >= 8 + FLAG_LAG && k < 135) {
                asm volatile("s_waitcnt vmcnt(24)" ::: "memory"); static_assert(FLAG_LAG * 3 == 24, "vmcnt literal");
                const int kp = k - FLAG_LAG; const int lcp = dir ? 263 - kp : kp - 8;
                if (lane == 0) __hip_atomic_store(flg + lcp * 4 + w, 1u, __ATOMIC_RELAXED, __HIP_MEMORY_SCOPE_AGENT);
            } else if (k == 135) {
                VM_WAIT();
                if (lane == 0) {
#pragma unroll
                    for (int q = 0; q <= FLAG_LAG; ++q) { const int kp = 135 - q; const int lcp = dir ? 263 - kp : kp - 8; __hip_atomic_store(flg + lcp * 4 + w, 1u, __ATOMIC_RELAXED, __HIP_MEMORY_SCOPE_AGENT); }
                }
            }
            SBAR();
        }
    }
#undef STEP_CHUNK
}

__device__ __forceinline__ void phase7(const Params& p) {
    const int tid = threadIdx.x, wid = tid >> 6, lane = tid & 63;
    const float* sso = (const float*)(p.ws + WS_SSO);
    for (int m0 = 2 * (blockIdx.x * 8 + wid); m0 < M_LAT; m0 += 2 * gridDim.x * 8) {
        f32x4 ov[2][8]; float sv[2];
#pragma unroll
        for (int rr = 0; rr < 2; ++rr) { const int m = m0 + rr; sv[rr] = (lane < 32) ? sso[(size_t)m * 32 + lane] : 0.f;
            const f32x4* o4 = (const f32x4*)(p.out + (size_t)m * D) + lane;
#pragma unroll
            for (int j = 0; j < 8; ++j) ov[rr][j] = o4[64 * j]; }
#pragma unroll
        for (int rr = 0; rr < 2; ++rr) { const int m = m0 + rr;
            const float rstd = rsqrtf(wave_sum(sv[rr]) * (1.0f / D) + EPS);
            f32x4* o4 = (f32x4*)(p.out + (size_t)m * D) + lane;
#pragma unroll
            for (int j = 0; j < 8; ++j) { const f32x4 g = *(const f32x4*)(p.final_g + 4 * (lane + 64 * j)); o4[64 * j] = ov[rr][j] * rstd * g; } }
    }
}


#define XB_TMO      128
#define XB_XCNT(j)  (256  + 64 * (j))
#define XB_XSUB(j)  (1280 + 64 * (j))
#define XB_XGEN(j)  (2304 + 64 * (j))
#define XB_TOP      3328
#define XB_TOPGEN   3392
#define XCD_BAR_WORDS 3456
#define XB_SPIN_CAP (1u << 18)
__device__ __forceinline__ unsigned xb_ld(unsigned* p)              { return __hip_atomic_load(p, __ATOMIC_RELAXED, __HIP_MEMORY_SCOPE_AGENT); }
__device__ __forceinline__ unsigned xb_add(unsigned* p, unsigned v) { return __hip_atomic_fetch_add(p, v, __ATOMIC_RELAXED, __HIP_MEMORY_SCOPE_AGENT); }
__device__ __forceinline__ unsigned xb_xcc_id() { return (unsigned)__builtin_amdgcn_s_getreg((3 << 11) | 20) & 0xFu; }
#define XB_SPIN(cond, bar) do { unsigned _sp = 0; while (cond) { __builtin_amdgcn_s_sleep(1); \
    if ((++_sp & 255u) == 0u) { if (xb_ld(&(bar)[XB_TMO])) break; if (_sp > XB_SPIN_CAP) { atomicAdd(&(bar)[XB_TMO], 1u); break; } } } } while (0)
struct XcdBarrier { unsigned* bar; unsigned x; volatile LAS unsigned* st; };
__device__ __forceinline__ XcdBarrier xcd_barrier_post(unsigned* bar, volatile LAS unsigned* st) {
    XcdBarrier b; b.bar = bar; b.x = xb_xcc_id(); b.st = st;
    if (threadIdx.x == 0) (void)xb_add(&bar[XB_XCNT(b.x)], 1u);
    return b;
}
__device__ __forceinline__ void xcd_barrier_complete(unsigned* bar, unsigned x, unsigned& nloc, unsigned& nx) {
    const unsigned G = gridDim.x * gridDim.y * gridDim.z;
    unsigned sum, cnt, mine, sp = 0u;
    for (;;) {
        sum = 0u; cnt = 0u; mine = 0u;
#pragma unroll
        for (unsigned j = 0; j < 16; ++j) { const unsigned c = xb_ld(&bar[XB_XCNT(j)]); sum += c; cnt += (c > 0u) ? 1u : 0u; mine = (j == x) ? c : mine; }
        if (sum == G) break;
        __builtin_amdgcn_s_sleep(1);
        if ((++sp & 255u) == 0u) { if (xb_ld(&bar[XB_TMO])) break; if (sp > XB_SPIN_CAP) { atomicAdd(&bar[XB_TMO], 1u); break; } }
    }
    nloc = mine > 0u ? mine : 1u; nx = cnt > 0u ? cnt : 1u;
}
__device__ __forceinline__ void xcd_barrier(const XcdBarrier& b) {
    asm volatile("s_waitcnt vmcnt(0)" ::: "memory");
    __syncthreads();
    if (threadIdx.x == 0) {
        unsigned* bar = b.bar;
        __builtin_amdgcn_s_waitcnt(0);
        unsigned nloc = b.st[0], nx = b.st[1];
        if (nloc == 0u) { xcd_barrier_complete(bar, b.x, nloc, nx); b.st[0] = nloc; b.st[1] = nx; }
        const unsigned old = xb_add(&bar[XB_XSUB(b.x)], 1u);
        const unsigned gen = old / nloc;
        if (old + 1u == (gen + 1u) * nloc) {
            __builtin_amdgcn_fence(__ATOMIC_RELEASE, "agent");
            asm volatile("s_waitcnt vmcnt(0)" ::: "memory");
            const unsigned og = xb_add(&bar[XB_TOP], 1u);
            const unsigned tg = og / nx;
            if (og + 1u == (tg + 1u) * nx) xb_add(&bar[XB_TOPGEN], 1u);
            else XB_SPIN(xb_ld(&bar[XB_TOPGEN]) == tg, bar);
            __builtin_amdgcn_fence(__ATOMIC_ACQUIRE, "agent");
            xb_add(&bar[XB_XGEN(b.x)], 1u);
            asm volatile("s_waitcnt vmcnt(0)" ::: "memory");
        } else {
            XB_SPIN(xb_ld(&bar[XB_XGEN(b.x)]) == gen, bar);
            __builtin_amdgcn_fence(__ATOMIC_ACQUIRE, "agent");
            asm volatile("s_waitcnt vmcnt(0)" ::: "memory");
        }
    }
    __syncthreads();
}

__global__ void __launch_bounds__(512, 2) fwd_megakernel(Params p) {
    extern __shared__ __attribute__((aligned(16))) unsigned char lds_raw[];
    LAS unsigned char* lds = (LAS unsigned char*)lds_raw;
    volatile LAS unsigned* bst = (volatile LAS unsigned*)(lds + LDS_BYTES - 16);
    if (threadIdx.x < 4) bst[threadIdx.x] = 0u;
    __syncthreads();
    const XcdBarrier xbar = xcd_barrier_post((unsigned*)(p.ws + WS_BAR), bst);
    const int lo = p.ph_lo, hi = p.ph_hi;
    const int G = gridDim.x, c = blockIdx.x;
    unsigned char* ws = p.ws;
#ifdef ONLY_PHASE
#define IN(k) ((k) == ONLY_PHASE && lo <= (k) && (k) < hi)
#else
#define IN(k) (lo <= (k) && (k) < hi)
#endif
#define SEAM(k) do { if (IN(k) && IN((k) + 1)) xcd_barrier(xbar); } while (0)
#ifndef DUP_PHASE
#define DUP_PHASE -1
#endif
#define REP(k) for (int rep_ = 0; rep_ < ((k) == DUP_PHASE ? 2 : 1); ++rep_)
    if (IN(0)) REP(0) phase0(p, lds);
    SEAM(0);
    if (IN(1)) REP(1) phase1(p);
    SEAM(1);
    if (IN(2)) REP(2) { SchedScan S{G, c, (const char*)(ws + WS_H), (const char*)(ws + WS_WTS)}; EpiScan E{ws, p.lb_logits};
        pg8::gemm_phase<EpiScan, SchedScan, false, true, false>(lds, S, E); }
    SEAM(2);
    if (IN(3)) REP(3) phase2b(p, lds);
    SEAM(3);
    if (IN(4)) {
        unsigned* adone = (unsigned*)(ws + 256);
        EpiGate E{ws, (u16*)p.out, (u16*)p.out + (size_t)M_LAT * 2048, p.onorm_a, p.onorm_b, adone};
        if (c < 64) {
            scan_unit<128, true>(p, lds, c >> 5, (c >> 1) & 15, 0, c & 1, c >> 1);
            VM_WAIT(); __syncthreads();
            if (threadIdx.x == 0) { __builtin_amdgcn_fence(__ATOMIC_RELEASE, "agent"); VM_WAIT(); __hip_atomic_fetch_add(adone, 1u, __ATOMIC_RELAXED, __HIP_MEMORY_SCOPE_AGENT); }
            __syncthreads();
            SchedHelp S{128 + c, 0, (const char*)(ws + WS_H), (const char*)(ws + WS_WTG)};
            pg8::gemm_phase<EpiGate, SchedHelp, true, false, true>(lds, S, E);
        } else if (c < 128) { const int u = c - 64; scan_unit<256, false>(p, lds, u >> 5, (u >> 3) & 3, (u >> 1) & 3, u & 1, 32 + (u >> 1)); }
        else { SchedHelp S{c - 128, 4, (const char*)(ws + WS_H), (const char*)(ws + WS_WTG)};
            pg8::gemm_phase<EpiGate, SchedHelp, true, false, true>(lds, S, E); }
    }
    SEAM(4);
    if (IN(5)) { phase_wtp(p, lds);
        SchedTiles S{G, c, NAG_SCAN, 16 - NAG_SCAN, (const char*)(ws + WS_H), (const char*)(ws + WS_WTG)};
        EpiGate E{ws, (u16*)p.out, (u16*)p.out + (size_t)M_LAT * 2048, p.onorm_a, p.onorm_b, (const unsigned*)(ws + 256)};
        pg8::gemm_phase<EpiGate, SchedTiles, true, false, true>(lds, S, E); }
    SEAM(5);
    if (IN(6)) { SchedY S{G, c, (const char*)p.out, (const char*)p.out + (size_t)M_LAT * 2048 * 2, (const char*)(ws + WS_WTP)}; EpiY2 E{ws};
        pg8::gemm_phase<EpiY2, SchedY, true, false, true>(lds, S, E); }
    SEAM(6);
    if (IN(7)) REP(7) { SchedStd S{G, c, 8, (const char*)(ws + WS_Y), (const char*)(ws + WS_WTP) + (size_t)2 * 2048 * 4096, 0u};
        EpiOut E{p.x, p.out, (const float*)(ws + WS_MOD), (float*)(ws + WS_SSO)};
        pg8::gemm_phase<EpiOut, SchedStd, true, false, false>(lds, S, E); }
    SEAM(7);
    if (IN(8)) phase7(p);
#undef IN
#undef SEAM
}

#ifndef N_LAUNCHES
#define N_LAUNCHES 1
#endif
constexpr int N_PHASES = 9;

extern "C" void kernel_launch(void* const* d_in, const int* in_sizes, int n_in, void* d_out, int out_size, void* d_ws, size_t ws_size, hipStream_t stream) {
    static int grid = 0;
    if (grid == 0) {
        if (n_in != 17 || out_size != M_LAT * D || ws_size < WS_END) { fprintf(stderr, "kernel_launch: unexpected sizes (n_in %d out %d ws %zu need %zu)\n", n_in, out_size, ws_size, (size_t)WS_END); grid = -1; return; }
        int dev = 0, cus = 0, per_cu = 0;
        hipGetDevice(&dev);
        hipDeviceGetAttribute(&cus, hipDeviceAttributeMultiprocessorCount, dev);
        hipFuncSetAttribute((const void*)fwd_megakernel, hipFuncAttributeMaxDynamicSharedMemorySize, LDS_BYTES);
        hipOccupancyMaxActiveBlocksPerMultiprocessor(&per_cu, (const void*)fwd_megakernel, 512, LDS_BYTES);
        if (per_cu < 1) { fprintf(stderr, "kernel_launch: occupancy query reports %d blocks per CU\n", per_cu); grid = -1; return; }
        grid = cus;
    }
    if (grid < 0) return;
    Params p{};
    p.x = (const float*)d_in[0]; p.c = (const float*)d_in[1]; p.ctx = (const float*)d_in[2]; p.c_ctx = (const float*)d_in[3];
    p.w_ada = (const float*)d_in[4]; p.b_ada = (const float*)d_in[5]; p.norm_g = (const float*)d_in[6]; p.w_in = (const float*)d_in[7];
    p.lb_logits = (const float*)d_in[8]; p.gk_w = (const float*)d_in[9]; p.gk_b = (const float*)d_in[10]; p.onorm_a = (const float*)d_in[11];
    p.onorm_b = (const float*)d_in[12]; p.w_pa = (const float*)d_in[13]; p.w_pb = (const float*)d_in[14]; p.w_out = (const float*)d_in[15]; p.final_g = (const float*)d_in[16];
    p.out = (float*)d_out; p.ws = (unsigned char*)d_ws;
    (void)hipMemsetAsync((char*)d_ws + WS_BAR, 0, 16384, stream);
    const int per = (N_PHASES + N_LAUNCHES - 1) / N_LAUNCHES;
    for (int li = 0; li < N_LAUNCHES; ++li) {
        p.ph_lo = li * per; p.ph_hi = (li + 1) * per < N_PHASES ? (li + 1) * per : N_PHASES;
        if (p.ph_lo >= N_PHASES) break;
        void* args[] = {&p};
        hipError_t e = hipLaunchCooperativeKernel((const void*)fwd_megakernel, dim3(grid), dim3(512), args, LDS_BYTES, stream);
        if (e != hipSuccess) { fprintf(stderr, "cooperative launch failed: %s (grid %d)\n", hipGetErrorString(e), grid); break; }
    }
}
```

```cpp
#include <hip/hip_runtime.h>
#include <cstdio>
#include <cstdint>

#define LAS __attribute__((address_space(3)))
typedef unsigned short u16;
typedef short bf16x8 __attribute__((ext_vector_type(8)));
typedef float f32x2 __attribute__((ext_vector_type(2)));
typedef float f32x4 __attribute__((ext_vector_type(4)));
typedef float f32x16 __attribute__((ext_vector_type(16)));
typedef unsigned u32x2 __attribute__((ext_vector_type(2)));
typedef unsigned u32x4 __attribute__((ext_vector_type(4)));
typedef __bf16 bf16x2_t __attribute__((ext_vector_type(2)));
typedef _Float16 f16x2_t __attribute__((ext_vector_type(2)));

constexpr int D = 2048, NB = 2, SEQ = 8192, LCTX = 256;
constexpr int M_LAT = NB * SEQ;
constexpr int M_ALL = M_LAT + NB * LCTX;
constexpr int N_IN = 20512;
constexpr int NCHUNK = M_ALL / 32;
constexpr float EPS = 1e-6f;
constexpr int NSCAN_ROWS = 12544;
constexpr int NGATE_ROWS = 8192;

constexpr size_t WS_BAR = 4096;
constexpr size_t WS_FLG = WS_BAR + 16384;
constexpr size_t WS_MOD = WS_FLG + 64 * 256 * 4 * 4;
constexpr size_t WS_SSO = WS_MOD + 3 * 6144 * 4;
constexpr size_t WS_SSA = WS_SSO + (size_t)M_LAT * 32 * 4;
constexpr size_t WS_SSB = WS_SSA + (size_t)M_LAT * 64 * 4;
constexpr size_t WS_WTG = WS_SSB + (size_t)M_LAT * 64 * 4;
constexpr size_t WS_H   = WS_WTG + (size_t)NGATE_ROWS * D * 2;
constexpr size_t WS_WTS = WS_H + (size_t)M_ALL * D * 2;
constexpr size_t WS_LFB = WS_WTS;
constexpr size_t WS_R   = WS_LFB + (size_t)2 * NCHUNK * 1024 * 32 * 2;
constexpr size_t WS_AQ  = WS_R + (size_t)NCHUNK * 32 * 32 * 4;
constexpr size_t WS_AV  = WS_AQ + (size_t)NCHUNK * 2048 * 32 * 2;
constexpr size_t WS_ALF = WS_AV + (size_t)NCHUNK * 2048 * 32 * 2;
constexpr size_t WS_BQ  = WS_ALF + (size_t)2 * NCHUNK * 2048 * 32 * 2;
constexpr size_t WS_BK  = WS_BQ + (size_t)NCHUNK * 1024 * 32 * 2;
constexpr size_t WS_BV  = WS_BK + (size_t)NCHUNK * 1024 * 32 * 2;
constexpr size_t WS_MGA = WS_BV + (size_t)NCHUNK * 2048 * 32 * 2;
constexpr size_t WS_END = WS_MGA + (size_t)M_LAT * 2048 * 2;
constexpr size_t WS_MGB = WS_AQ;
constexpr size_t WS_Y   = WS_ALF;
constexpr size_t WS_WTP = WS_ALF + (size_t)M_LAT * 2048 * 2;
static_assert(WS_WTS + (size_t)NSCAN_ROWS * D * 2 <= WS_R, "LFB overlay");
static_assert(WS_MGB + (size_t)M_LAT * 2048 * 2 <= WS_AV, "MGB overlay");
static_assert(WS_WTP + (size_t)3 * D * D * 2 <= WS_BQ, "WTP overlay");
static_assert(WS_END <= (size_t)672137216, "workspace");

constexpr int LDS_BYTES = 155648;

struct Params {
    const float *x, *c, *ctx, *c_ctx, *w_ada, *b_ada, *norm_g, *w_in, *lb_logits, *gk_w, *gk_b, *onorm_a, *onorm_b, *w_pa, *w_pb, *w_out, *final_g;
    float* out; unsigned char* ws;
    int ph_lo, ph_hi;
};

__device__ __forceinline__ unsigned pk_bf16(float lo, float hi) { f32x2 v = {lo, hi}; return __builtin_bit_cast(unsigned, __builtin_convertvector(v, bf16x2_t)); }
__device__ __forceinline__ unsigned pk_f16(float lo, float hi) { f32x2 v = {lo, hi}; return __builtin_bit_cast(unsigned, __builtin_convertvector(v, f16x2_t)); }
__device__ __forceinline__ float bf_lo(unsigned w) { return __uint_as_float(w << 16); }
__device__ __forceinline__ float bf_hi(unsigned w) { return __uint_as_float(w & 0xffff0000u); }
__device__ __forceinline__ float bf_sel(unsigned w, int hi) { return hi ? bf_hi(w) : bf_lo(w); }
__device__ __forceinline__ float h_sel(unsigned w, int hi) { return (float)__builtin_bit_cast(_Float16, (u16)(hi ? (w >> 16) : (w & 0xffffu))); }
__device__ __forceinline__ float sigmoidf_(float v) { return __builtin_amdgcn_rcpf(1.0f + __builtin_amdgcn_exp2f(v * -1.4426950408889634f)); }
__device__ __forceinline__ float wave_sum(float v) {
#pragma unroll
    for (int o = 1; o < 64; o <<= 1) v += __shfl_xor(v, o);
    return v;
}
#define LDS_WAIT() asm volatile("s_waitcnt lgkmcnt(0)" ::: "memory")
#define VM_WAIT() asm volatile("s_waitcnt vmcnt(0)" ::: "memory")

namespace pg8 {
constexpr int BM = 256, BK = 64, HALF = 128, HTB = HALF * BK * 2, STAGE_BYTES = 8 * HTB, KD = 2048, NT = KD / BK;
__device__ __forceinline__ int lds_byte(int r, int c) { const int st = (r >> 4) * 2 + (c >> 5), rr = r & 15, cc = c & 31, ob = rr * 64 + cc * 2; return st * 1024 + (ob ^ (((ob >> 9) & 1) << 5)); }
__device__ __forceinline__ void stage_rc(int b, int& R, int& C) { const int st = b / 1024, sb = b % 1024, swz = sb ^ (((sb >> 9) & 1) << 5); R = (st >> 1) * 16 + swz / 64; C = (st & 1) * 32 + (swz % 64) / 2; }
__device__ __forceinline__ int perm32(int rho) { const int n = rho >> 4, i = rho & 15; return 8 * (i >> 2) + 4 * n + (i & 3); }

struct Unit { const char* A; const char* B; unsigned mode; unsigned hstepA; unsigned kstepA; int pm, pn; };
__device__ __forceinline__ unsigned voffA_of(unsigned mode, int R, int C) {
    if (mode == 0u) return (unsigned)(R * KD + C) * 2u;
    if (mode == 1u) return (unsigned)(R * 64 * KD + C) * 2u;
    if (mode == 2u) return (unsigned)((((R >> 5) * 64 + (C >> 5)) * 1024) + (R & 31) * 32 + (C & 31)) * 2u;
    return (unsigned)((((R & 63) * 4 * 64 + (C >> 5)) * 1024) + (R >> 6) * 32 + (C & 31)) * 2u;
}

template <class Epi, class Sched, bool TRANS, bool PERM_A, bool PERM_B>
__device__ __forceinline__ void gemm_phase(LAS unsigned char* lds, const Sched& S, const Epi& E) {
    const int tid = threadIdx.x, wid = __builtin_amdgcn_readfirstlane(tid >> 6), lane = tid & 63, wr = wid >> 2, wc = wid & 3, fr = lane & 15, fq = lane >> 4;
    int RaA[2], CA[2]; unsigned voffB[2];
#pragma unroll
    for (int i = 0; i < 2; ++i) { int R, C; stage_rc(tid * 16 + i * 8192, R, C);
        RaA[i] = PERM_A ? ((R & ~31) + perm32(R & 31)) : R; CA[i] = C; const int Rb = PERM_B ? ((R & ~31) + perm32(R & 31)) : R;
        voffB[i] = (unsigned)(Rb * KD + C) * 2u; }
    constexpr size_t kstep = (size_t)(BK * 2);
    constexpr size_t hstepB = (size_t)HALF * KD * 2;
    const unsigned ldsw = (unsigned)wid * 1024u;
    const int aoff = lds_byte(wr * 64 + fr, fq * 8), boff = lds_byte(wc * 32 + fr, fq * 8);
#define PG8_SA(b, h) (((b) * 2 + (h)) * HTB)
#define PG8_SB(b, h) ((4 + (b) * 2 + (h)) * HTB)
#define PG8_STAGE(bufoff, gbase, voff) do { _Pragma("unroll") for (int _i = 0; _i < 2; ++_i) \
        __builtin_amdgcn_global_load_lds((const unsigned*)((const char*)(gbase) + (voff)[_i]), (LAS unsigned*)(lds + (bufoff) + ldsw + _i * 8192), 16, 0, 0); } while (0)
#define PG8_LDA(dst, b, h) do { _Pragma("unroll") for (int m = 0; m < 4; ++m) _Pragma("unroll") for (int k = 0; k < 2; ++k) dst[m][k] = *(const LAS bf16x8*)(lds + PG8_SA(b, h) + aoff + m * 2048 + k * 1024); } while (0)
#define PG8_LDB(dst, b, h) do { _Pragma("unroll") for (int n = 0; n < 2; ++n) _Pragma("unroll") for (int k = 0; k < 2; ++k) dst[n][k] = *(const LAS bf16x8*)(lds + PG8_SB(b, h) + boff + n * 2048 + k * 1024); } while (0)
#define PG8_MMA(ai, bj, At, Bt) do { __builtin_amdgcn_s_setprio(1); _Pragma("unroll") for (int m = 0; m < 4; ++m) _Pragma("unroll") for (int n = 0; n < 2; ++n) _Pragma("unroll") for (int k = 0; k < 2; ++k) \
        acc[ai][bj][m][n] = TRANS ? __builtin_amdgcn_mfma_f32_16x16x32_bf16(Bt[n][k], At[m][k], acc[ai][bj][m][n], 0, 0, 0) \
                                  : __builtin_amdgcn_mfma_f32_16x16x32_bf16(At[m][k], Bt[n][k], acc[ai][bj][m][n], 0, 0, 0); __builtin_amdgcn_s_setprio(0); } while (0)
#define PG8_WAIT_V(n) asm volatile("s_waitcnt vmcnt(" #n ")" ::: "memory")
#define PG8_WAIT_L(n) asm volatile("s_waitcnt lgkmcnt(" #n ")" ::: "memory")
#define PG8_BAR __builtin_amdgcn_s_barrier()
#define PG8_SCHED __builtin_amdgcn_sched_barrier(0)
    Unit cur, nxt; int ui = 0;
    if (!S.next(0, cur)) return;
    f32x4 acc[2][2][4][2];
#pragma unroll
    for (int a = 0; a < 2; ++a)
#pragma unroll
        for (int b = 0; b < 2; ++b)
#pragma unroll
            for (int m = 0; m < 4; ++m)
#pragma unroll
                for (int n = 0; n < 2; ++n) acc[a][b][m][n] = (f32x4){0.f, 0.f, 0.f, 0.f};
    bf16x8 At[4][2], B0[2][2], B1[2][2];
    const char* cA = cur.A; const char* cB = cur.B;
    unsigned vA[2] = {voffA_of(cur.mode, RaA[0], CA[0]), voffA_of(cur.mode, RaA[1], CA[1])};
    size_t hA = cur.hstepA, kA = cur.kstepA;
    PG8_STAGE(PG8_SB(0, 0), cB, voffB); PG8_STAGE(PG8_SA(0, 0), cA, vA); PG8_STAGE(PG8_SB(0, 1), cB + hstepB, voffB); PG8_STAGE(PG8_SA(0, 1), cA + hA, vA);
    if (wr == 1) PG8_BAR;
    PG8_WAIT_V(4); PG8_BAR;
    PG8_STAGE(PG8_SB(1, 0), cB + kstep, voffB); PG8_STAGE(PG8_SA(1, 0), cA + kA, vA); PG8_STAGE(PG8_SB(1, 1), cB + hstepB + kstep, voffB);
    PG8_WAIT_V(6); PG8_BAR;
    for (;;) {
        const bool has_next = S.next(ui + 1, nxt);
        const char* nA = has_next ? nxt.A : cA; const char* nB = has_next ? nxt.B : cB;
        unsigned vN[2]; size_t hN, kN;
        if (has_next) { vN[0] = voffA_of(nxt.mode, RaA[0], CA[0]); vN[1] = voffA_of(nxt.mode, RaA[1], CA[1]); hN = nxt.hstepA; kN = nxt.kstepA; } else { vN[0] = vA[0]; vN[1] = vA[1]; hN = hA; kN = kA; }
        for (int t = 0; t < NT; t += 2) {
            const bool last = (t == NT - 2);
            const char* a1 = cA + (size_t)(t + 1) * kA;
            const char* a2 = last ? nA : cA + (size_t)(t + 2) * kA; const char* b2 = last ? nB : cB + (size_t)(t + 2) * kstep;
            const char* a3 = a2 + (last ? kN : kA); const char* b3 = b2 + kstep;
            unsigned v2[2] = {last ? vN[0] : vA[0], last ? vN[1] : vA[1]}; const size_t h2 = last ? hN : hA;
            PG8_LDB(B0, 0, 0); PG8_SCHED; PG8_LDA(At, 0, 0); PG8_STAGE(PG8_SA(1, 1), a1 + hA, vA);
            PG8_WAIT_L(8); PG8_BAR; PG8_WAIT_L(0); PG8_MMA(0, 0, At, B0); PG8_BAR; PG8_SCHED;
            PG8_LDB(B1, 0, 1); PG8_STAGE(PG8_SB(0, 0), b2, voffB);
            PG8_BAR; PG8_WAIT_L(0); PG8_MMA(0, 1, At, B1); PG8_BAR;
            PG8_LDA(At, 0, 1); PG8_STAGE(PG8_SA(0, 0), a2, v2);
            PG8_BAR; PG8_WAIT_L(0); PG8_MMA(1, 0, At, B0); PG8_BAR; PG8_SCHED;
            PG8_STAGE(PG8_SB(0, 1), b2 + hstepB, voffB);
            PG8_WAIT_V(6); PG8_BAR; PG8_MMA(1, 1, At, B1); PG8_BAR;
            PG8_LDB(B0, 1, 0); PG8_SCHED; PG8_LDA(At, 1, 0); PG8_STAGE(PG8_SA(0, 1), a2 + h2, v2);
            PG8_WAIT_L(8); PG8_BAR; PG8_WAIT_L(0); PG8_MMA(0, 0, At, B0); PG8_BAR; PG8_SCHED;
            PG8_LDB(B1, 1, 1); PG8_STAGE(PG8_SB(1, 0), b3, voffB);
            PG8_BAR; PG8_WAIT_L(0); PG8_MMA(0, 1, At, B1); PG8_BAR;
            PG8_LDA(At, 1, 1); PG8_STAGE(PG8_SA(1, 0), a3, v2);
            PG8_BAR; PG8_WAIT_L(0); PG8_MMA(1, 0, At, B0); PG8_BAR; PG8_SCHED;
            PG8_STAGE(PG8_SB(1, 1), b3 + hstepB, voffB);
            PG8_WAIT_V(6); PG8_BAR; PG8_MMA(1, 1, At, B1); PG8_BAR;
        }
        E(acc, cur, wr, wc, fr, fq);
        if (!has_next) break;
#pragma unroll
        for (int a = 0; a < 2; ++a)
#pragma unroll
            for (int b = 0; b < 2; ++b)
#pragma unroll
                for (int m = 0; m < 4; ++m)
#pragma unroll
                    for (int n = 0; n < 2; ++n) acc[a][b][m][n] = (f32x4){0.f, 0.f, 0.f, 0.f};
        cur = nxt; cA = nA; cB = nB; vA[0] = vN[0]; vA[1] = vN[1]; hA = hN; kA = kN; ++ui;
    }
    PG8_WAIT_V(0);
    if (wr == 0) PG8_BAR;
    PG8_BAR;
#undef PG8_SA
#undef PG8_SB
#undef PG8_STAGE
#undef PG8_LDA
#undef PG8_LDB
#undef PG8_MMA
#undef PG8_WAIT_V
#undef PG8_WAIT_L
#undef PG8_BAR
#undef PG8_SCHED
}
}

typedef f32x4 AccT[2][2][4][2];

struct SchedScan {
    int G, c; const char* h; const char* wts;
    __device__ __forceinline__ bool next(int i, pg8::Unit& u) const {
        const int L = i * G + c;
        if (L >= 64 * 49 + 2 * 37) return false;
        int pm, pn;
        if (L < 64 * 49) { pm = L & 63; pn = L >> 6; }
        else { const int r = L - 64 * 49; pm = 64 + (r & 1); int q = r >> 1; pn = (q < 24) ? 8 + q : 36 + (q - 24); }
        u.pm = pm; u.pn = pn; u.B = wts + (size_t)pn * 256 * 4096;
        if (pn >= 32 && pm < 64) {
            const int b = pm >> 5, pp = pm & 31;
            u.A = h + (size_t)(b * 8192 + 2 * pp) * 4096; u.mode = 1u; u.hstepA = 4096u; u.kstepA = 128u;
        } else { u.A = h + (size_t)pm * 256 * 4096; u.mode = 0u; u.hstepA = 128u * 4096u; u.kstepA = 128u; }
        return true;
    }
};
struct SchedStd {
    int G, c, nN; const char* A; const char* B; unsigned mode;
    __device__ __forceinline__ bool next(int i, pg8::Unit& u) const {
        const int L = i * G + c;
        if (L >= 64 * nN) return false;
        u.pm = L & 63; u.pn = L >> 6; u.B = B + (size_t)u.pn * 256 * 4096; u.mode = mode;
        if (mode == 0u) { u.A = A + (size_t)u.pm * 256 * 4096; u.hstepA = 128u * 4096u; u.kstepA = 128u; }
        else if (mode == 2u) { u.A = A + (size_t)u.pm * 8 * 64 * 2048; u.hstepA = 4u * 64u * 2048u; u.kstepA = 4096u; }
        else { const int bb = u.pm >> 5, pp = u.pm & 31;
            u.A = A + ((size_t)(bb * 256 + (pp >> 3)) * 64 * 1024 + (size_t)(4 * (pp & 7)) * 32) * 2; u.hstepA = 2u * 32u * 2u; u.kstepA = 4096u; }
        return true;
    }
};

struct EpiScan {
    unsigned char* ws; const float* lbl;
    __device__ __forceinline__ void operator()(const AccT& acc, const pg8::Unit& u, int wr, int wc, int fr, int fq) const {
        const int pn = u.pn;
        int kind, pl, W; size_t base;
        if (pn < 8) { kind = 0; pl = pn; W = 2048; base = WS_AQ; }
        else if (pn < 16) { kind = 0; pl = pn - 8; W = 2048; base = WS_AV; }
        else if (pn < 24) { kind = 1; pl = pn - 16; W = 2048; base = WS_ALF; }
        else if (pn < 32) { kind = 2; pl = pn - 24; W = 2048; base = WS_ALF + (size_t)NCHUNK * 2048 * 32 * 2; }
        else if (pn < 36) { kind = 3; pl = pn - 32; W = 1024; base = WS_BQ; }
        else if (pn < 40) { kind = 0; pl = pn - 36; W = 1024; base = WS_BK; }
        else if (pn < 48) { kind = 0; pl = pn - 40; W = 2048; base = WS_BV; }
        else { kind = 4; pl = 0; W = 32; base = WS_R; }
#pragma unroll
        for (int bj = 0; bj < 2; ++bj)
#pragma unroll
            for (int n = 0; n < 2; ++n) {
                const int ch = pl * 256 + bj * 128 + wc * 32 + n * 16 + fr;
                float lb = 0.f;
                if (kind == 1 || kind == 2) { const int li = (kind == 2 ? 2048 : 0) + ch; lb = sigmoidf_(lbl[li] - lbl[4096 + li]); }
#pragma unroll
                for (int ai = 0; ai < 2; ++ai)
#pragma unroll
                    for (int q = 0; q < 2; ++q) {
                        const int chunk = u.pm * 8 + ai * 4 + wr * 2 + q;
                        f32x4 v0 = acc[ai][bj][2 * q][n], v1 = acc[ai][bj][2 * q + 1][n];
                        if (kind == 4) {
                            if (wc == 0 && bj == 0) { float* dst = (float*)(ws + base) + ((size_t)chunk * 32 + (n * 16 + fr)) * 32 + 8 * fq; *(f32x4*)dst = v0; *(f32x4*)(dst + 4) = v1; }
                        } else {
                            u32x4 w;
                            if (kind == 1 || kind == 2) {
                                float t[8] = {v0[0], v0[1], v0[2], v0[3], v1[0], v1[1], v1[2], v1[3]};
#pragma unroll
                                for (int e = 0; e < 8; ++e) t[e] = __log2f(lb + (1.0f - lb) * sigmoidf_(t[e]));
                                w.x = pk_f16(t[0], t[1]); w.y = pk_f16(t[2], t[3]); w.z = pk_f16(t[4], t[5]); w.w = pk_f16(t[6], t[7]);
                            } else {
                                if (kind == 3) { v0 = v0 * 0.0625f; v1 = v1 * 0.0625f; }
                                w.x = pk_bf16(v0[0], v0[1]); w.y = pk_bf16(v0[2], v0[3]); w.z = pk_bf16(v1[0], v1[1]); w.w = pk_bf16(v1[2], v1[3]);
                            }
                            const int chs = (pn >= 32 && pn < 40) ? ((ch & ~255) | ((ch & 1) << 7) | ((ch & 255) >> 1)) : ch;
                            u16* dst = (u16*)(ws + base) + (((size_t)chunk * 4 + fq) * W + chs) * 8;
                            *(u32x4*)dst = w;
                        }
                    }
            }
    }
};

struct EpiGate {
    unsigned char* ws; u16* OA; u16* OB; const float* gain_a; const float* gain_b; const unsigned* adone;
    __device__ __forceinline__ void operator()(const AccT& acc, const pg8::Unit& u, int wr, int wc, int fr, int fq) const {
        const int pn = u.pn;
        const int row0 = u.pm * 256 + wr * 64 + fr;
        if (pn < 8 || pn >= 24) {
            unsigned spins = 0;
            while (__hip_atomic_load(adone, __ATOMIC_RELAXED, __HIP_MEMORY_SCOPE_AGENT) < 64u) { __builtin_amdgcn_s_sleep(8); if (++spins > (1u << 22)) break; }
            __builtin_amdgcn_fence(__ATOMIC_ACQUIRE, "agent");
        }
        if (pn >= 16) {
            u16* MG = (u16*)(ws + (pn < 24 ? WS_MGA : WS_MGB));
            const int col0 = ((pn - 16) & 7) * 256 + wc * 32 + 8 * fq;
#pragma unroll
            for (int ai = 0; ai < 2; ++ai)
#pragma unroll
                for (int m = 0; m < 4; ++m) { u16* rowp = MG + (size_t)(row0 + ai * 128 + m * 16) * 2048 + col0;
#pragma unroll
                    for (int bj = 0; bj < 2; ++bj) { const f32x4 v0 = acc[ai][bj][m][0], v1 = acc[ai][bj][m][1]; u32x4 w;
                        w.x = pk_bf16(sigmoidf_(v0[0]), sigmoidf_(v0[1])); w.y = pk_bf16(sigmoidf_(v0[2]), sigmoidf_(v0[3]));
                        w.z = pk_bf16(sigmoidf_(v1[0]), sigmoidf_(v1[1])); w.w = pk_bf16(sigmoidf_(v1[2]), sigmoidf_(v1[3]));
                        *(u32x4*)(rowp + bj * 128) = w; } }
        } else {
            const bool isA = pn < 8; const int pl = isA ? pn : pn - 8;
            u16* O = isA ? OA : OB; const float* gain = isA ? gain_a : gain_b;
            const float* SS = (const float*)(ws + (isA ? WS_SSA : WS_SSB));
            const int col0 = pl * 256 + wc * 32 + 8 * fq;
            f32x4 g[2][2];
#pragma unroll
            for (int bj = 0; bj < 2; ++bj) { g[bj][0] = *(const f32x4*)(gain + col0 + bj * 128); g[bj][1] = *(const f32x4*)(gain + col0 + bj * 128 + 4); }
#pragma unroll
            for (int ai = 0; ai < 2; ++ai)
#pragma unroll
                for (int m = 0; m < 4; ++m) {
                    const int row = row0 + ai * 128 + m * 16;
                    float rstd[2];
                    if (isA) {
#pragma unroll
                        for (int bj = 0; bj < 2; ++bj) { const f32x4 s = *(const f32x4*)(SS + (size_t)row * 64 + (pl * 2 + bj) * 4); rstd[bj] = rsqrtf(((s[0] + s[1]) + (s[2] + s[3])) * (1.0f / 128.0f) + EPS); }
                    } else {
                        const float* sp = SS + (size_t)row * 64 + (pl >> 1) * 16; float t = 0.f;
#pragma unroll
                        for (int k = 0; k < 4; ++k) { const f32x4 s = *(const f32x4*)(sp + 4 * k); t += (s[0] + s[1]) + (s[2] + s[3]); }
                        rstd[0] = rstd[1] = rsqrtf(t * (1.0f / 512.0f) + EPS);
                    }
                    size_t tb;
                    if (isA) tb = ((size_t)(row >> 5) * 64) * 1024 + (size_t)(row & 31) * 32;
                    else { const int bb = row >> 13, t = row & 8191, ps = (t & 63) * 128 + (t >> 6); tb = ((size_t)(bb * 256 + (ps >> 5)) * 64) * 1024 + (size_t)(ps & 31) * 32; }
                    u16* rowp = O + tb + (size_t)(col0 >> 5) * 1024 + (col0 & 31);
#pragma unroll
                    for (int bj = 0; bj < 2; ++bj) {
                        const u32x4 ov = *(const u32x4*)(rowp + bj * 4 * 1024);
                        const f32x4 a0 = acc[ai][bj][m][0], a1 = acc[ai][bj][m][1];
                        float o[8] = {bf_lo(ov.x), bf_hi(ov.x), bf_lo(ov.y), bf_hi(ov.y), bf_lo(ov.z), bf_hi(ov.z), bf_lo(ov.w), bf_hi(ov.w)};
                        float gt[8] = {a0[0], a0[1], a0[2], a0[3], a1[0], a1[1], a1[2], a1[3]};
                        float gg[8] = {g[bj][0][0], g[bj][0][1], g[bj][0][2], g[bj][0][3], g[bj][1][0], g[bj][1][1], g[bj][1][2], g[bj][1][3]};
#pragma unroll
                        for (int e = 0; e < 8; ++e) o[e] = (o[e] * rstd[bj] * gg[e]) * (gt[e] * sigmoidf_(gt[e]));
                        u32x4 w; w.x = pk_bf16(o[0], o[1]); w.y = pk_bf16(o[2], o[3]); w.z = pk_bf16(o[4], o[5]); w.w = pk_bf16(o[6], o[7]);
                        *(u32x4*)(rowp + bj * 4 * 1024) = w;
                    }
                }
        }
    }
};
constexpr int NAG_SCAN = 8;
struct SchedHelp {
    int id; int n_first; const char* A; const char* B;
    __device__ __forceinline__ bool next(int i, pg8::Unit& u) const {
        int pm, tile;
        if (i < n_first) { const int L = i * 128 + id; pm = L & 63; tile = 16 + (L >> 6); }
        else { const int L = (i - n_first) * 192 + id; if (L >= 512 + 64 * NAG_SCAN) return false;
            if (L < 512) { pm = L & 63; tile = 24 + (L >> 6); } else { pm = (L - 512) & 63; tile = (L - 512) >> 6; } }
        u.pm = pm; u.pn = tile; u.A = A + (size_t)pm * 256 * 4096; u.B = B + (size_t)tile * 256 * 4096; u.mode = 0u; u.hstepA = 128u * 4096u; u.kstepA = 128u;
        return true;
    }
};
struct SchedTiles {
    int G, c, tile0, nT; const char* A; const char* B;
    __device__ __forceinline__ bool next(int i, pg8::Unit& u) const {
        const int L = i * G + c;
        if (L >= 64 * nT) return false;
        u.pm = L & 63; u.pn = tile0 + (L >> 6); u.A = A + (size_t)u.pm * 256 * 4096; u.B = B + (size_t)u.pn * 256 * 4096; u.mode = 0u; u.hstepA = 128u * 4096u; u.kstepA = 128u;
        return true;
    }
};

template <int SECOND> struct EpiY {
    unsigned char* ws;
    __device__ __forceinline__ void operator()(const AccT& acc, const pg8::Unit& u, int wr, int wc, int fr, int fq) const {
        const u16* MG = (const u16*)(ws + (SECOND ? WS_MGB : WS_MGA)); u16* Y = (u16*)(ws + WS_Y);
        const int row0 = u.pm * 256 + wr * 64 + fr, col0 = u.pn * 256 + wc * 32 + 8 * fq;
#pragma unroll
        for (int ai = 0; ai < 2; ++ai)
#pragma unroll
            for (int m = 0; m < 4; ++m) { const int row = row0 + ai * 128 + m * 16;
#pragma unroll
                for (int bj = 0; bj < 2; ++bj) {
                    const u32x4 mv = *(const u32x4*)(MG + (size_t)row * 2048 + col0 + bj * 128);
                    const f32x4 a0 = acc[ai][bj][m][0], a1 = acc[ai][bj][m][1];
                    float o[8] = {a0[0] * bf_lo(mv.x), a0[1] * bf_hi(mv.x), a0[2] * bf_lo(mv.y), a0[3] * bf_hi(mv.y), a1[0] * bf_lo(mv.z), a1[1] * bf_hi(mv.z), a1[2] * bf_lo(mv.w), a1[3] * bf_hi(mv.w)};
                    u16* yp = Y + (size_t)row * 2048 + col0 + bj * 128;
                    if (SECOND) { const u32x4 yv = *(const u32x4*)yp;
                        o[0] += bf_lo(yv.x); o[1] += bf_hi(yv.x); o[2] += bf_lo(yv.y); o[3] += bf_hi(yv.y); o[4] += bf_lo(yv.z); o[5] += bf_hi(yv.z); o[6] += bf_lo(yv.w); o[7] += bf_hi(yv.w); }
                    u32x4 w; w.x = pk_bf16(o[0], o[1]); w.y = pk_bf16(o[2], o[3]); w.z = pk_bf16(o[4], o[5]); w.w = pk_bf16(o[6], o[7]);
                    *(u32x4*)yp = w;
                } }
    }
};

struct SchedY {
    int G, c; const char* OA; const char* OB; const char* WP;
    __device__ __forceinline__ bool next(int i, pg8::Unit& u) const {
        const int L = (i >> 1) * G + c;
        if (L >= 512) return false;
        const int pm = L & 63, pn = L >> 6; u.pm = pm; u.kstepA = 4096u;
        if ((i & 1) == 0) { u.pn = pn | 0x100; u.mode = 2u; u.A = OA + (size_t)pm * 8 * 64 * 2048; u.hstepA = 4u * 64u * 2048u; u.B = WP + (size_t)pn * 256 * 4096; }
        else { u.pn = pn; u.mode = 3u; const int bb = pm >> 5, pp = pm & 31;
            u.A = OB + ((size_t)(bb * 256 + (pp >> 3)) * 64 * 1024 + (size_t)(4 * (pp & 7)) * 32) * 2; u.hstepA = 2u * 32u * 2u; u.B = WP + (size_t)2048 * 4096 + (size_t)pn * 256 * 4096; }
        return true;
    }
};
struct EpiY2 {
    unsigned char* ws;
    __device__ __forceinline__ void operator()(const AccT& acc, const pg8::Unit& u, int wr, int wc, int fr, int fq) const {
        pg8::Unit v = u; v.pn = u.pn & 0xff;
        if (u.pn & 0x100) { EpiY<0> e{ws}; e(acc, v, wr, wc, fr, fq); } else { EpiY<1> e{ws}; e(acc, v, wr, wc, fr, fq); }
    }
};

struct EpiOut {
    const float* x; float* out; const float* mod; float* sso;
    __device__ __forceinline__ void operator()(const AccT& acc, const pg8::Unit& u, int wr, int wc, int fr, int fq) const {
        const int row0 = u.pm * 256 + wr * 64 + fr, col0 = u.pn * 256 + wc * 32 + 4 * fq;
        const float* gate = mod + (size_t)(u.pm >> 5) * 6144 + 4096;
        f32x4 gv[2][2];
#pragma unroll
        for (int bj = 0; bj < 2; ++bj)
#pragma unroll
            for (int n = 0; n < 2; ++n) gv[bj][n] = *(const f32x4*)(gate + col0 + bj * 128 + n * 16);
#pragma unroll
        for (int ai = 0; ai < 2; ++ai)
#pragma unroll
            for (int mh = 0; mh < 2; ++mh) {
                f32x4 xv[2][2][2];
#pragma unroll
                for (int mm = 0; mm < 2; ++mm) { const size_t off = (size_t)(row0 + ai * 128 + (2 * mh + mm) * 16) * 2048 + col0;
#pragma unroll
                    for (int bj = 0; bj < 2; ++bj)
#pragma unroll
                        for (int n = 0; n < 2; ++n) xv[mm][bj][n] = *(const f32x4*)(x + off + bj * 128 + n * 16); }
#pragma unroll
                for (int mm = 0; mm < 2; ++mm) { const int m = 2 * mh + mm; const int row = row0 + ai * 128 + m * 16; const size_t off = (size_t)row * 2048 + col0; float s = 0.f;
#pragma unroll
                    for (int bj = 0; bj < 2; ++bj)
#pragma unroll
                        for (int n = 0; n < 2; ++n) { const f32x4 o = xv[mm][bj][n] + gv[bj][n] * acc[ai][bj][m][n];
                            *(f32x4*)(out + off + bj * 128 + n * 16) = o; s += (o[0] * o[0] + o[1] * o[1]) + (o[2] * o[2] + o[3] * o[3]); }
                    s += __shfl_xor(s, 16); s += __shfl_xor(s, 32);
                    if (fq == 0) sso[(size_t)row * 32 + u.pn * 4 + wc] = s; }
            }
    }
};

__device__ __forceinline__ void transpose_item(const float* W, int N, int n0, int k0, u16* WTrow0, LAS float* scr, int lane) {
    float tv[32];
#pragma unroll
    for (int i = 0; i < 32; ++i) tv[i] = W[(size_t)(k0 + 2 * i + (lane >> 5)) * N + n0 + (lane & 31)];
#pragma unroll
    for (int i = 0; i < 32; ++i) scr[(2 * i + (lane >> 5)) * 33 + (lane & 31)] = tv[i];
    LDS_WAIT(); asm volatile("" ::: "memory");
    const int c = lane & 7;
#pragma unroll
    for (int j = 0; j < 4; ++j) { const int n = (lane >> 3) + 8 * j; const LAS float* s = scr + (8 * c) * 33 + n;
        u32x4 o; o.x = pk_bf16(s[0 * 33], s[1 * 33]); o.y = pk_bf16(s[2 * 33], s[3 * 33]); o.z = pk_bf16(s[4 * 33], s[5 * 33]); o.w = pk_bf16(s[6 * 33], s[7 * 33]);
        *(u32x4*)(WTrow0 + (size_t)n * 2048 + k0 + 8 * c) = o; }
    LDS_WAIT(); asm volatile("" ::: "memory");
}

__device__ __forceinline__ void phase0(const Params& p, LAS unsigned char* lds) {
    const int tid = threadIdx.x, wid = tid >> 6, lane = tid & 63;
    unsigned char* ws = p.ws;
    if (blockIdx.x < 192) {
        LAS float* sl = (LAS float*)lds;
        LAS float* red = (LAS float*)lds + 6144;
        for (int i = tid; i < 3 * 2048; i += 512) { const int v = i >> 11, d = i & 2047; const float cv = (v < 2) ? p.c[v * 2048 + d] : p.c_ctx[d]; sl[i] = cv * sigmoidf_(cv); }
        __syncthreads();
        const int cg4 = tid & 7, kl = tid >> 3;
        const int col = blockIdx.x * 32 + cg4 * 4;
        f32x4 a0 = {0, 0, 0, 0}, a1 = {0, 0, 0, 0}, a2 = {0, 0, 0, 0};
#pragma unroll 8
        for (int k = kl; k < 2048; k += 64) { const f32x4 w = *(const f32x4*)(p.w_ada + (size_t)k * 6144 + col); a0 += sl[k] * w; a1 += sl[2048 + k] * w; a2 += sl[4096 + k] * w; }
        LAS float* rp = red + tid * 12;
#pragma unroll
        for (int e = 0; e < 4; ++e) { rp[e] = a0[e]; rp[4 + e] = a1[e]; rp[8 + e] = a2[e]; }
        __syncthreads();
        if (tid < 96) { const int v = tid >> 5, cc = tid & 31, g4 = cc >> 2, e = cc & 3; float s = 0.f;
            for (int k = 0; k < 64; ++k) s += red[(k * 8 + g4) * 12 + v * 4 + e];
            ((float*)(ws + WS_MOD))[v * 6144 + blockIdx.x * 32 + cc] = s + p.b_ada[blockIdx.x * 32 + cc]; }
        __syncthreads();
    }
    LAS float* scr = (LAS float*)(lds + 65536 + wid * 8448);
    const int gw = blockIdx.x * 8 + wid, NGW = gridDim.x * 8;
    constexpr int I_IN = 32 * 641;
    u16* WTS = (u16*)(ws + WS_WTS); u16* WTG = (u16*)(ws + WS_WTG);
    for (int it = gw; it < I_IN; it += NGW) {
        const int kb = it / 641, cb = it - kb * 641, n0 = cb * 32;
        u16* dst;
        if (n0 < 8192) dst = WTS + (size_t)n0 * 2048;
        else if (n0 < 10240) dst = WTG + (size_t)(n0 - 8192) * 2048;
        else if (n0 < 14336) dst = WTS + (size_t)(8192 + n0 - 10240) * 2048;
        else if (n0 == 14336) dst = WTS + (size_t)12288 * 2048;
        else if (n0 < 16416) dst = WTG + (size_t)(2048 + n0 - 14368) * 2048;
        else dst = WTG + (size_t)(4096 + n0 - 16416) * 2048;
        transpose_item(p.w_in, N_IN, n0, kb * 64, dst, scr, lane);
    }
    { u32x4* z = (u32x4*)(WTS + (size_t)12320 * 2048); const int nz = 224 * 2048 * 2 / 16;
      for (int i = blockIdx.x * 512 + tid; i < nz; i += gridDim.x * 512) z[i] = (u32x4){0u, 0u, 0u, 0u}; }
}

__device__ __forceinline__ void phase_wtp(const Params& p, LAS unsigned char* lds) {
    const int tid = threadIdx.x, wid = tid >> 6, lane = tid & 63;
    LAS float* scr = (LAS float*)(lds + wid * 8448);
    const int gw = blockIdx.x * 8 + wid, NGW = gridDim.x * 8;
    u16* WTP = (u16*)(p.ws + WS_WTP);
    for (int it = gw; it < 3 * 2048; it += NGW) {
        const int which = it >> 11, r = it & 2047;
        const float* W = which == 0 ? p.w_pa : (which == 1 ? p.w_pb : p.w_out);
        const int kb = r >> 6, cb = r & 63;
        transpose_item(W, 2048, cb * 32, kb * 64, WTP + (size_t)which * 2048 * 2048 + (size_t)(cb * 32) * 2048, scr, lane);
    }
    __syncthreads();
}

__device__ __forceinline__ void phase1(const Params& p) {
    const int tid = threadIdx.x, wid = tid >> 6, lane = tid & 63;
    const float* mod = (const float*)(p.ws + WS_MOD);
    u16* H = (u16*)(p.ws + WS_H);
    for (int i = blockIdx.x * 512 + tid; i < 64 * 256 * 4; i += gridDim.x * 512) ((unsigned*)(p.ws + WS_FLG))[i] = 0u;
    if (blockIdx.x == 0 && tid == 0) *(unsigned*)(p.ws + 256) = 0u;
    for (int m0 = 2 * (blockIdx.x * 8 + wid); m0 < M_ALL; m0 += 2 * gridDim.x * 8) {
        f32x4 xv[2][8]; float ss[2] = {0.f, 0.f};
#pragma unroll
        for (int rr = 0; rr < 2; ++rr) { const int m = m0 + rr;
            const float* src = (m < M_LAT) ? p.x + (size_t)m * D : p.ctx + (size_t)(m - M_LAT) * D;
            const f32x4* s4 = (const f32x4*)src + lane;
#pragma unroll
            for (int j = 0; j < 8; ++j) xv[rr][j] = s4[64 * j]; }
#pragma unroll
        for (int rr = 0; rr < 2; ++rr)
#pragma unroll
            for (int j = 0; j < 8; ++j) ss[rr] += (xv[rr][j][0] * xv[rr][j][0] + xv[rr][j][1] * xv[rr][j][1]) + (xv[rr][j][2] * xv[rr][j][2] + xv[rr][j][3] * xv[rr][j][3]);
#pragma unroll
        for (int rr = 0; rr < 2; ++rr) { const int m = m0 + rr;
            const int v = (m < M_LAT) ? (m >> 13) : 2;
            const float rstd = rsqrtf(wave_sum(ss[rr]) * (1.0f / D) + EPS);
            u32x2* o8 = (u32x2*)(H + (size_t)m * D) + lane;
#pragma unroll
            for (int j = 0; j < 8; ++j) { const int col = 4 * (lane + 64 * j);
                const f32x4 g = *(const f32x4*)(p.norm_g + col), sh = *(const f32x4*)(mod + v * 6144 + col), sc = *(const f32x4*)(mod + v * 6144 + 2048 + col);
                const f32x4 y = (xv[rr][j] * rstd * g) * (sc + 1.0f) + sh;
                o8[64 * j] = (u32x2){pk_bf16(y[0], y[1]), pk_bf16(y[2], y[3])}; } }
    }
}

__device__ __forceinline__ void phase2b(const Params& p, LAS unsigned char* lds) {
    const int tid = threadIdx.x;
    const float* R = (const float*)(p.ws + WS_R);
    u16* LFB = (u16*)(p.ws + WS_LFB);
    LAS float* rs = (LAS float*)lds;
    float w[2][2][16], bias[2][2];
#pragma unroll
    for (int d = 0; d < 2; ++d)
#pragma unroll
        for (int cc = 0; cc < 2; ++cc) { bias[d][cc] = p.gk_b[d * 1024 + cc * 512 + tid];
#pragma unroll
            for (int r = 0; r < 16; ++r) w[d][cc][r] = p.gk_w[(size_t)(d * 16 + r) * 1024 + cc * 512 + tid]; }
    int buf = 0;
    for (int chunk = blockIdx.x; chunk < NCHUNK; chunk += gridDim.x, buf ^= 1) {
        LAS float* rb = rs + buf * 1024;
        { const f32x2 v = *(const f32x2*)(R + (size_t)chunk * 1024 + 2 * tid); *(LAS f32x2*)(rb + 2 * tid) = v; }
        __syncthreads();
#pragma unroll
        for (int d = 0; d < 2; ++d)
#pragma unroll 1
            for (int t8 = 0; t8 < 4; ++t8) {
                float z[2][8];
#pragma unroll
                for (int cc = 0; cc < 2; ++cc)
#pragma unroll
                    for (int e = 0; e < 8; ++e) z[cc][e] = bias[d][cc];
#pragma unroll
                for (int r = 0; r < 16; ++r) {
                    LAS float* ra = rb + (d * 16 + r) * 32 + t8 * 8; asm volatile("" : "+v"(ra));
                    const f32x4 r0 = *(const LAS f32x4*)ra, r1 = *(const LAS f32x4*)(ra + 4);
#pragma unroll
                    for (int cc = 0; cc < 2; ++cc) { const float ww = w[d][cc][r];
#pragma unroll
                        for (int e = 0; e < 4; ++e) { z[cc][e] = __builtin_fmaf(r0[e], ww, z[cc][e]); z[cc][4 + e] = __builtin_fmaf(r1[e], ww, z[cc][4 + e]); } }
                }
#pragma unroll
                for (int cc = 0; cc < 2; ++cc) {
                    float zz[8];
#pragma unroll
                    for (int e = 0; e < 8; ++e) zz[e] = z[cc][e];
#pragma unroll
                    for (int e = 0; e < 8; ++e) { const float a = fabsf(zz[e]); zz[e] = (fminf(zz[e], 0.f) - __logf(1.0f + __expf(-a))) * (0.0625f * 1.4426950408889634f); }
                    u32x4 o; o.x = pk_f16(zz[0], zz[1]); o.y = pk_f16(zz[2], zz[3]); o.z = pk_f16(zz[4], zz[5]); o.w = pk_f16(zz[6], zz[7]);
                    const int ch = cc * 512 + tid, chs = (ch & ~255) | ((ch & 1) << 7) | ((ch & 255) >> 1);
                    *(u32x4*)(LFB + ((((size_t)d * NCHUNK + chunk) * 4 + t8) * 1024 + chs) * 8) = o;
                }
            }
    }
    __syncthreads();
}

__device__ __forceinline__ bf16x8 pack8(const f32x16& x, int s) {
    u32x4 pk; pk.x = pk_bf16(x[8 * s + 0], x[8 * s + 1]); pk.y = pk_bf16(x[8 * s + 2], x[8 * s + 3]); pk.z = pk_bf16(x[8 * s + 4], x[8 * s + 5]); pk.w = pk_bf16(x[8 * s + 6], x[8 * s + 7]);
    return __builtin_bit_cast(bf16x8, pk);
}
__device__ __forceinline__ unsigned rot16(unsigned x) { return (x >> 16) | (x << 16); }
template <int NW> __device__ __forceinline__ void maybe_rev(unsigned (&w)[NW], bool rev) {
    unsigned r[NW];
#pragma unroll
    for (int k = 0; k < NW; ++k) r[k] = rot16(w[NW - 1 - k]);
#pragma unroll
    for (int k = 0; k < NW; ++k) w[k] = rev ? r[k] : w[k];
}
__device__ __forceinline__ void ld16(unsigned (&w)[8], const u16* p) { const u32x4 a = *(const u32x4*)p, b = *(const u32x4*)(p + 8); w[0] = a.x; w[1] = a.y; w[2] = a.z; w[3] = a.w; w[4] = b.x; w[5] = b.y; w[6] = b.z; w[7] = b.w; }
__device__ __forceinline__ void ld16q(unsigned (&w)[8], const u16* p, size_t qstride) { const u32x4 a = *(const u32x4*)p, b = *(const u32x4*)(p + qstride); w[0] = a.x; w[1] = a.y; w[2] = a.z; w[3] = a.w; w[4] = b.x; w[5] = b.y; w[6] = b.z; w[7] = b.w; }
__device__ __forceinline__ void ld32(unsigned (&w)[16], const u16* p) {
#pragma unroll
    for (int k = 0; k < 4; ++k) { const u32x4 a = *(const u32x4*)(p + 8 * k); w[4 * k] = a.x; w[4 * k + 1] = a.y; w[4 * k + 2] = a.z; w[4 * k + 3] = a.w; }
}

#define DSR128(dst, addr, off) asm volatile("ds_read_b128 %0, %1 offset:%2" : "=v"(dst) : "v"(addr), "i"(off))
#define SBAR() do { asm volatile("s_waitcnt lgkmcnt(0)" ::: "memory"); __builtin_amdgcn_s_barrier(); asm volatile("" ::: "memory"); } while (0)
__device__ __forceinline__ f32x2 h2_sel(unsigned w0, unsigned w1, int hi) { return (f32x2){h_sel(w0, hi), h_sel(w1, hi)}; }
__device__ __forceinline__ f32x2 bf2_sel(unsigned w0, unsigned w1, int hi) { return (f32x2){bf_sel(w0, hi), bf_sel(w1, hi)}; }
#define GLD128(dst, ptr) asm volatile("global_load_dwordx4 %0, %1, off" : "=v"(dst) : "v"(ptr) : "memory")
#define GLD128_SC1(dst, ptr, off) asm volatile("global_load_dwordx4 %0, %1, off offset:%2 sc1" : "=v"(dst) : "v"(ptr), "i"(off) : "memory")
__device__ __forceinline__ unsigned wsel(const u32x4 (&v)[2], int w) { return v[w >> 2][w & 3]; }
__device__ __forceinline__ float vmul(float a, float b) { float r; asm("v_mul_f32_e32 %0, %1, %2" : "=v"(r) : "v"(a), "v"(b)); return r; }
__device__ __forceinline__ float vmul_v(float a, float b) { float r; asm volatile("v_mul_f32_e32 %0, %1, %2" : "=v"(r) : "v"(a), "v"(b)); return r; }
__device__ __forceinline__ float vmul_t(float a, float b) { float r; asm("s_nop 1\n\tv_mul_f32_e32 %0, %1, %2" : "=v"(r) : "v"(a), "v"(b)); return r; }
template <int DK, bool IS_A, int DIRC>
__device__ __forceinline__ void producer_loop(const Params& p, LAS unsigned char* lds, int b, int hh, int quarter, int pair, int pw, int ptid, int lane) {
    constexpr int QSTR = DK * 2 + 16, RSTR = 80;
    constexpr int OFF_KS = 32 * QSTR, OFF_KST = 2 * 32 * QSTR, OFF_VT = OFF_KST + DK * RSTR, OFF_DD = OFF_VT + 128 * RSTR, OFF_PD = OFF_DD + DK * 4, BUFB = OFF_PD + 4 * 32 * RSTR;
    constexpr int dir = DIRC;
    constexpr int NS = IS_A ? 6 : 14;
    const int h = lane >> 5, l31 = lane & 31;
    unsigned char* ws = p.ws;
    const u16* Qg = (const u16*)(ws + (IS_A ? WS_AQ : WS_BQ));
    const u16* Kg = (const u16*)(ws + WS_BK);
    const u16* Vg = (const u16*)(ws + (IS_A ? WS_AV : WS_BV));
    const u16* LFg = IS_A ? (const u16*)(ws + WS_ALF) + (size_t)dir * NCHUNK * 2048 * 32 : (const u16*)(ws + WS_LFB) + (size_t)dir * NCHUNK * 1024 * 32;
    unsigned* flg = (unsigned*)(ws + WS_FLG) + pair * 1024;
    const u16* Ogc = (const u16*)p.out + (IS_A ? 0 : (size_t)M_LAT * 2048);
    (void)ptid; (void)Kg;
#define STEP_CHUNK(k, is_ctx_, lc_, cidx_) const bool is_ctx_ = (k) < 8; const int lc_ = is_ctx_ ? (dir ? 7 - (k) : (k)) : (dir ? 263 - (k) : (k) - 8); const int cidx_ = is_ctx_ ? 512 + b * 8 + lc_ : b * 256 + lc_;
#define PD_LOADS(kq_, PD4) do { \
        STEP_CHUNK(kq_, icf, lcf, cidxf); (void)icf; (void)cidxf; \
        const u16* src = Ogc + ((size_t)(b * 256 + lcf) * 64 + (IS_A ? hh * 4 : hh * 16 + quarter * 4) + pw) * 1024 + lane * 8; \
        GLD128_SC1(PD4[0], src, 0); GLD128_SC1(PD4[1], src, 1024); \
    } while (0)
#define PD_ISSUE(kk, PD4) do { const int kq2_ = ((kk) >= 136 && (kk) < 264) ? (kk) : 136; PD_LOADS(kq2_, PD4); } while (0)
#define PD_FIRST(kk, PD4) do { if ((kk) == 136) { \
        STEP_CHUNK(136, icg, lcg, cidxg); (void)icg; (void)cidxg; unsigned spins = 0; \
        while (__hip_atomic_load(flg + lcg * 4 + pw, __ATOMIC_RELAXED, __HIP_MEMORY_SCOPE_AGENT) == 0u) { __builtin_amdgcn_s_sleep(2); if (++spins > (1u << 22)) break; } \
        PD_LOADS(136, PD4); \
        asm volatile("s_waitcnt vmcnt(0)" : "+v"(PD4[0]), "+v"(PD4[1])); } } while (0)
#define PD_STORE(PD4) do { _Pragma("unroll") for (int j_ = 0; j_ < 2; ++j_) *(LAS u32x4*)(buf + OFF_PD + (pw * 32 + 16 * j_ + (lane >> 2)) * RSTR + (lane & 3) * 16) = PD4[j_]; } while (0)
#define BUF_PTRS(kk) LAS unsigned char* buf = lds + ((kk) & 1) * BUFB; LAS unsigned char* QS = buf; LAS unsigned char* KS = buf + OFF_KS; LAS unsigned char* KST = buf + OFF_KST; LAS unsigned char* VT = buf + OFF_VT; LAS float* DD = (LAS float*)(buf + OFF_DD);
#define WAITV(n, ...) asm volatile("s_waitcnt vmcnt(" #n ")" : __VA_ARGS__)
    if (IS_A) {
        const int c = 32 * pw + l31, th = h;
#define LOAD_A(LF, QW, VW, kk) do { const int kl_ = (kk) < 264 ? (kk) : 263; STEP_CHUNK(kl_, ic, lc, cidx); (void)lc; (void)ic; \
            const size_t eo = (((size_t)cidx * 4 + 2 * th) * 2048 + hh * 128 + c) * 8; \
            GLD128(LF[0], LFg + eo); GLD128(LF[1], LFg + eo + 2048 * 8); GLD128(QW[0], Qg + eo); GLD128(QW[1], Qg + eo + 2048 * 8); GLD128(VW[0], Vg + eo); GLD128(VW[1], Vg + eo + 2048 * 8); } while (0)
#define PROC_A(LF, QW, VW, kk, PC, PN) do { \
            BUF_PTRS(kk) \
            PD_FIRST(kk, PC); \
            PD_ISSUE((kk) + 1, PN); \
            asm volatile("s_waitcnt vmcnt(10)" : "+v"(LF[0]), "+v"(LF[1]), "+v"(QW[0]), "+v"(QW[1]), "+v"(VW[0]), "+v"(VW[1]));     \
            float E[16], kk_[16]; float run = 1.f; \
            _Pragma("unroll") for (int it_ = 0; it_ < 16; ++it_) { const int it = dir ? 15 - it_ : it_; const float f = __builtin_amdgcn_exp2f(h_sel(wsel(LF, it >> 1), it & 1)); run = vmul_t(run, f); E[it] = run; kk_[it] = 1.0f - f; } \
            const float other = __shfl_xor(run, 32); \
            const float pre = (dir ? (th == 0) : (th == 1)) ? other : 1.0f; \
            unsigned kst[8]; \
            _Pragma("unroll") for (int it = 0; it < 16; it += 2) { \
                float ks2[2]; \
                _Pragma("unroll") for (int e = 0; e < 2; ++e) { const int i2 = it + e; const float ev = vmul(E[i2], pre); const float qs = vmul(bf_sel(wsel(QW, i2 >> 1), i2 & 1), ev); ks2[e] = vmul_t(kk_[i2], __builtin_amdgcn_rcpf(fmaxf(ev, 1e-30f))); \
                    const int i = 16 * th + i2; \
                    *(LAS u16*)(QS + i * QSTR + c * 2) = (u16)(pk_bf16(qs, 0.f) & 0xffffu); \
                    *(LAS u16*)(KS + i * QSTR + c * 2) = (u16)(pk_bf16(ks2[e], 0.f) & 0xffffu); } \
                kst[it >> 1] = pk_bf16(ks2[0], ks2[1]); \
            } \
            if (dir ? (th == 0) : (th == 1)) DD[c] = vmul(dir ? E[0] : E[15], pre); \
            *(LAS u32x4*)(KST + c * RSTR + th * 32) = (u32x4){kst[0], kst[1], kst[2], kst[3]}; \
            *(LAS u32x4*)(KST + c * RSTR + th * 32 + 16) = (u32x4){kst[4], kst[5], kst[6], kst[7]}; \
            *(LAS u32x4*)(VT + c * RSTR + th * 32) = VW[0]; \
            *(LAS u32x4*)(VT + c * RSTR + th * 32 + 16) = VW[1]; \
            asm volatile("s_waitcnt vmcnt(8)" : "+v"(PC[0]), "+v"(PC[1]));     \
            PD_STORE(PC); \
        } while (0)
        static_assert(NS == 6 || !IS_A, "wait counts");
        u32x4 lf0[2], q0_[2], v0_[2], lf1[2], q1_[2], v1_[2]; u32x4 pe[2], po[2];
        LOAD_A(lf0, q0_, v0_, 0); PD_ISSUE(0, pe); LOAD_A(lf1, q1_, v1_, 1);
#pragma unroll 1
        for (int k = 0; k < 264; k += 2) {
            PROC_A(lf0, q0_, v0_, k, pe, po); LOAD_A(lf0, q0_, v0_, k + 2); SBAR();
            PROC_A(lf1, q1_, v1_, k + 1, po, pe); LOAD_A(lf1, q1_, v1_, k + 3); SBAR();
        }
        asm volatile("s_waitcnt vmcnt(0)" ::: "memory");
#undef LOAD_A
#undef PROC_A
    } else {
        const int cp = 32 * pw + l31, th = h;
        const int col = ptid & 127, thv = ptid >> 7;
#define LOAD_B(LF, QW, KW, VW, kk) do { const int kl_ = (kk) < 264 ? (kk) : 263; STEP_CHUNK(kl_, ic, lc, cidx); (void)lc; (void)ic; \
            const size_t eo = (((size_t)cidx * 4 + 2 * th) * 1024 + hh * 256 + cp) * 8; const size_t evv = (((size_t)cidx * 4 + 2 * thv) * 2048 + hh * 512 + quarter * 128 + col) * 8; \
            GLD128(LF[0][0], LFg + eo); GLD128(LF[0][1], LFg + eo + 1024 * 8); GLD128(LF[1][0], LFg + eo + 128 * 8); GLD128(LF[1][1], LFg + eo + 128 * 8 + 1024 * 8); \
            GLD128(KW[0][0], Kg + eo); GLD128(KW[0][1], Kg + eo + 1024 * 8); GLD128(KW[1][0], Kg + eo + 128 * 8); GLD128(KW[1][1], Kg + eo + 128 * 8 + 1024 * 8); \
            GLD128(QW[0][0], Qg + eo); GLD128(QW[0][1], Qg + eo + 1024 * 8); GLD128(QW[1][0], Qg + eo + 128 * 8); GLD128(QW[1][1], Qg + eo + 128 * 8 + 1024 * 8); \
            GLD128(VW[0], Vg + evv); GLD128(VW[1], Vg + evv + 2048 * 8); } while (0)
#define PROC_B(LF, QW, KW, VW, kk, PC, PN) do { \
            BUF_PTRS(kk) \
            PD_FIRST(kk, PC); \
            PD_ISSUE((kk) + 1, PN); \
            asm volatile("s_waitcnt vmcnt(18)" : "+v"(LF[0][0]), "+v"(LF[0][1]), "+v"(LF[1][0]), "+v"(LF[1][1]), "+v"(KW[0][0]), "+v"(KW[0][1]), "+v"(KW[1][0]), "+v"(KW[1][1]), \
                         "+v"(QW[0][0]), "+v"(QW[0][1]), "+v"(QW[1][0]), "+v"(QW[1][1]), "+v"(VW[0]), "+v"(VW[1]));     \
            float E0[16], E1[16]; float r0 = 1.f, r1 = 1.f; \
            _Pragma("unroll") for (int it_ = 0; it_ < 16; ++it_) { const int it = dir ? 15 - it_ : it_; \
                const float f0 = __builtin_amdgcn_exp2f(h_sel(wsel(LF[0], it >> 1), it & 1)), f1 = __builtin_amdgcn_exp2f(h_sel(wsel(LF[1], it >> 1), it & 1)); \
                r0 = vmul_t(r0, f0); r1 = vmul_t(r1, f1); E0[it] = r0; E1[it] = r1; } \
            const float o0 = __shfl_xor(r0, 32), o1 = __shfl_xor(r1, 32); \
            const bool tail = dir ? (th == 0) : (th == 1); \
            const float pre0 = tail ? o0 : 1.f, pre1 = tail ? o1 : 1.f; \
            unsigned kst0[8], kst1[8]; \
            _Pragma("unroll") for (int it = 0; it < 16; it += 2) { \
                float ka[2], kb[2]; \
                _Pragma("unroll") for (int e = 0; e < 2; ++e) { const int i2 = it + e; const float ev0 = vmul(E0[i2], pre0), ev1 = vmul(E1[i2], pre1); \
                    const float qs0 = vmul(bf_sel(wsel(QW[0], i2 >> 1), i2 & 1), ev0), qs1 = vmul(bf_sel(wsel(QW[1], i2 >> 1), i2 & 1), ev1); \
                    ka[e] = vmul_t(bf_sel(wsel(KW[0], i2 >> 1), i2 & 1), __builtin_amdgcn_rcpf(ev0)); kb[e] = vmul_t(bf_sel(wsel(KW[1], i2 >> 1), i2 & 1), __builtin_amdgcn_rcpf(ev1)); \
                    const int i = 16 * th + i2; \
                    *(LAS unsigned*)(QS + i * QSTR + cp * 4) = pk_bf16(qs0, qs1); \
                    *(LAS unsigned*)(KS + i * QSTR + cp * 4) = pk_bf16(ka[e], kb[e]); } \
                kst0[it >> 1] = pk_bf16(ka[0], ka[1]); kst1[it >> 1] = pk_bf16(kb[0], kb[1]); \
            } \
            if (tail) { *(LAS f32x2*)(DD + 2 * cp) = (f32x2){vmul(dir ? E0[0] : E0[15], pre0), vmul(dir ? E1[0] : E1[15], pre1)}; } \
            *(LAS u32x4*)(KST + (2 * cp) * RSTR + th * 32) = (u32x4){kst0[0], kst0[1], kst0[2], kst0[3]}; \
            *(LAS u32x4*)(KST + (2 * cp) * RSTR + th * 32 + 16) = (u32x4){kst0[4], kst0[5], kst0[6], kst0[7]}; \
            *(LAS u32x4*)(KST + (2 * cp + 1) * RSTR + th * 32) = (u32x4){kst1[0], kst1[1], kst1[2], kst1[3]}; \
            *(LAS u32x4*)(KST + (2 * cp + 1) * RSTR + th * 32 + 16) = (u32x4){kst1[4], kst1[5], kst1[6], kst1[7]}; \
            *(LAS u32x4*)(VT + col * RSTR + thv * 32) = VW[0]; \
            *(LAS u32x4*)(VT + col * RSTR + thv * 32 + 16) = VW[1]; \
            asm volatile("s_waitcnt vmcnt(16)" : "+v"(PC[0]), "+v"(PC[1]));     \
            PD_STORE(PC); \
        } while (0)
        static_assert(NS == 14 || IS_A, "wait counts");
        u32x4 lf0[2][2], q0_[2][2], k0_[2][2], v0_[2], lf1[2][2], q1_[2][2], k1_[2][2], v1_[2]; u32x4 pe[2], po[2];
        LOAD_B(lf0, q0_, k0_, v0_, 0); PD_ISSUE(0, pe); LOAD_B(lf1, q1_, k1_, v1_, 1);
#pragma unroll 1
        for (int k = 0; k < 264; k += 2) {
            PROC_B(lf0, q0_, k0_, v0_, k, pe, po); LOAD_B(lf0, q0_, k0_, v0_, k + 2); SBAR();
            PROC_B(lf1, q1_, k1_, v1_, k + 1, po, pe); LOAD_B(lf1, q1_, k1_, v1_, k + 3); SBAR();
        }
        asm volatile("s_waitcnt vmcnt(0)" ::: "memory");
#undef LOAD_B
#undef PROC_B
    }
#undef WAITV
#undef PD_LOADS
#undef PD_FIRST
#undef PD_ISSUE
#undef PD_STORE
#undef BUF_PTRS
#undef STEP_CHUNK
}

template <int DK, bool IS_A>
__device__ __forceinline__ void scan_unit(const Params& p, LAS unsigned char* lds, int b, int hh, int quarter, int dir, int pair) {
    constexpr int NT = DK / 32;
    constexpr int QSTR = DK * 2 + 16;
    constexpr int RSTR = 80;
    constexpr int OFF_KS = 32 * QSTR, OFF_KST = 2 * 32 * QSTR, OFF_VT = OFF_KST + DK * RSTR, OFF_DD = OFF_VT + 128 * RSTR, OFF_PD = OFF_DD + DK * 4, BUFB = OFF_PD + 4 * 32 * RSTR;
    static_assert(2 * BUFB <= LDS_BYTES, "scan LDS");
    const int tid = threadIdx.x, wid = __builtin_amdgcn_readfirstlane(tid >> 6), lane = tid & 63;
    const int h = lane >> 5, l31 = lane & 31;
    unsigned char* ws = p.ws;
    const u16* Qg = (const u16*)(ws + (IS_A ? WS_AQ : WS_BQ));
    const u16* Kg = (const u16*)(ws + WS_BK);
    const u16* Vg = (const u16*)(ws + (IS_A ? WS_AV : WS_BV));
    const u16* LFg = IS_A ? (const u16*)(ws + WS_ALF) + (size_t)dir * NCHUNK * 2048 * 32 : (const u16*)(ws + WS_LFB) + (size_t)dir * NCHUNK * 1024 * 32;
    unsigned* flg = (unsigned*)(ws + WS_FLG) + pair * 1024;
    const u16* Ogc = (const u16*)p.out + (IS_A ? 0 : (size_t)M_LAT * 2048);
#define STEP_CHUNK(k, is_ctx_, lc_, cidx_) const bool is_ctx_ = (k) < 8; const int lc_ = is_ctx_ ? (dir ? 7 - (k) : (k)) : (dir ? 263 - (k) : (k) - 8); const int cidx_ = is_ctx_ ? 512 + b * 8 + lc_ : b * 256 + lc_;
    if (wid >= 4) {
        const int pw = wid - 4, ptid = tid - 256;
        if (dir) producer_loop<DK, IS_A, 1>(p, lds, b, hh, quarter, pair, pw, ptid, lane);
        else producer_loop<DK, IS_A, 0>(p, lds, b, hh, quarter, pair, pw, ptid, lane);
        SBAR();
    } else {
        const int w = wid;
        u16* Og = (u16*)p.out + (IS_A ? 0 : (size_t)M_LAT * 2048);
        float* SSg = (float*)(ws + (IS_A ? WS_SSA : WS_SSB));
        const int ocol0 = IS_A ? hh * 128 + 32 * w : hh * 512 + quarter * 128 + 32 * w;
        const int sspart = IS_A ? hh * 4 + w : hh * 16 + quarter * 4 + w;
        const int prow = (l31 & 3) + 8 * ((l31 >> 2) & 1) + 4 * ((l31 >> 3) & 1) + 16 * (l31 >> 4);
        f32x16 S[NT];
#pragma unroll
        for (int t = 0; t < NT; ++t)
#pragma unroll
            for (int r = 0; r < 16; ++r) S[t][r] = 0.f;
        unsigned mk[2][4];
#pragma unroll
        for (int s2 = 0; s2 < 2; ++s2)
#pragma unroll
            for (int q = 0; q < 4; ++q) { const int r0 = 8 * s2 + 2 * q; const int j0 = (r0 & 3) + 8 * (r0 >> 2) + 4 * h, j1 = j0 + 1;
                const bool k0 = dir ? (j0 >= l31) : (j0 <= l31), k1 = dir ? (j1 >= l31) : (j1 <= l31);
                mk[s2][q] = (k0 ? 0xffffu : 0u) | (k1 ? 0xffff0000u : 0u); }
        SBAR();
#pragma unroll 1
        for (int k = 0; k < 264; ++k) {
            STEP_CHUNK(k, is_ctx, lc, cidx); (void)cidx;
            LAS unsigned char* buf = lds + (k & 1) * BUFB;
            LAS unsigned char* QS = buf; LAS unsigned char* KS = buf + OFF_KS; LAS unsigned char* KST = buf + OFF_KST; LAS unsigned char* VT = buf + OFF_VT; LAS float* DD = (LAS float*)(buf + OFF_DD);
            const bool fin = k >= 136;
            int row = 0;
            if (!is_ctx) { if (IS_A) row = b * SEQ + 32 * lc + l31; else { const int pp = 32 * lc + l31; row = b * SEQ + (pp & 127) * 64 + (pp >> 7); } }
            u16* otile = Og + ((size_t)(b * 256 + lc) * 64 + (IS_A ? hh * 4 : hh * 16 + quarter * 4) + w) * 1024;
            LAS unsigned char* orow = buf + OFF_PD + (w * 32 + l31) * RSTR + 8 * h;
            bf16x8 vk[2];
            f32x16 OT;
#pragma unroll
            for (int r = 0; r < 16; ++r) OT[r] = 0.f;
            if (!is_ctx) {
                f32x16 PT;
#pragma unroll
                for (int r = 0; r < 16; ++r) PT[r] = 0.f;
                {
                    LAS unsigned char* qa = QS + l31 * QSTR + 16 * h;
                    u32x4 fq[2][2], fk[2][2];
                    DSR128(fq[0][0], qa, 0); DSR128(fk[0][0], qa, OFF_KS); DSR128(fq[0][1], qa, 32); DSR128(fk[0][1], qa, OFF_KS + 32);
#define FSTEP(pp) if constexpr (NT > (pp)) { constexpr int s_ = (pp) & 1; \
                        if constexpr ((pp) + 1 < NT) { DSR128(fq[s_ ^ 1][0], qa, 64 * ((pp) + 1)); DSR128(fk[s_ ^ 1][0], qa, OFF_KS + 64 * ((pp) + 1)); \
                            DSR128(fq[s_ ^ 1][1], qa, 64 * ((pp) + 1) + 32); DSR128(fk[s_ ^ 1][1], qa, OFF_KS + 64 * ((pp) + 1) + 32); \
                            asm volatile("s_waitcnt lgkmcnt(4)" : "+v"(fq[s_][0]), "+v"(fk[s_][0]), "+v"(fq[s_][1]), "+v"(fk[s_][1])); } \
                        else asm volatile("s_waitcnt lgkmcnt(0)" : "+v"(fq[s_][0]), "+v"(fk[s_][0]), "+v"(fq[s_][1]), "+v"(fk[s_][1])); \
                        PT = __builtin_amdgcn_mfma_f32_32x32x16_bf16(__builtin_bit_cast(bf16x8, fk[s_][0]), __builtin_bit_cast(bf16x8, fq[s_][0]), PT, 0, 0, 0); \
                        OT = __builtin_amdgcn_mfma_f32_32x32x16_bf16(pack8(S[pp], 0), __builtin_bit_cast(bf16x8, fq[s_][0]), OT, 0, 0, 0); \
                        PT = __builtin_amdgcn_mfma_f32_32x32x16_bf16(__builtin_bit_cast(bf16x8, fk[s_][1]), __builtin_bit_cast(bf16x8, fq[s_][1]), PT, 0, 0, 0); \
                        OT = __builtin_amdgcn_mfma_f32_32x32x16_bf16(pack8(S[pp], 1), __builtin_bit_cast(bf16x8, fq[s_][1]), OT, 0, 0, 0); \
                        __builtin_amdgcn_sched_barrier(0); }
                    FSTEP(0) FSTEP(1) FSTEP(2) FSTEP(3) FSTEP(4) FSTEP(5) FSTEP(6) FSTEP(7)
#undef FSTEP
                }
#pragma unroll
                for (int s2 = 0; s2 < 2; ++s2) {
                    const u32x2 lo = *(const LAS u32x2*)(VT + (32 * w + l31) * RSTR + (16 * s2 + 4 * h) * 2);
                    const u32x2 hi = *(const LAS u32x2*)(VT + (32 * w + l31) * RSTR + (16 * s2 + 8 + 4 * h) * 2);
                    vk[s2] = __builtin_bit_cast(bf16x8, (u32x4){lo.x, lo.y, hi.x, hi.y});
                    u32x4 pw4 = __builtin_bit_cast(u32x4, pack8(PT, s2));
                    pw4.x &= mk[s2][0]; pw4.y &= mk[s2][1]; pw4.z &= mk[s2][2]; pw4.w &= mk[s2][3];
                    OT = __builtin_amdgcn_mfma_f32_32x32x16_bf16(vk[s2], __builtin_bit_cast(bf16x8, pw4), OT, 0, 0, 0);
                }
                float ss = 0.f;
#pragma unroll
                for (int g = 0; g < 4; ++g) {
                    float o0 = OT[4 * g], o1 = OT[4 * g + 1], o2 = OT[4 * g + 2], o3 = OT[4 * g + 3];
                    if (fin) {
                        const u32x2 pvv = *(const LAS u32x2*)(orow + 16 * g); const unsigned lo = pvv.x, hi = pvv.y;
                        o0 += bf_lo(lo); o1 += bf_hi(lo); o2 += bf_lo(hi); o3 += bf_hi(hi);
                        ss += (o0 * o0 + o1 * o1) + (o2 * o2 + o3 * o3);
                    }
                    *(LAS u32x2*)(orow + 16 * g) = (u32x2){pk_bf16(o0, o1), pk_bf16(o2, o3)};
                }
                asm volatile("s_waitcnt lgkmcnt(0)" ::: "memory");
#pragma unroll
                for (int j = 0; j < 2; ++j) {
                    const u32x4 tv = *(const LAS u32x4*)(buf + OFF_PD + (w * 32 + 16 * j + (lane >> 2)) * RSTR + (lane & 3) * 16);
                    u16* dst = otile + j * 512 + lane * 8;
                    if (fin) *(u32x4*)dst = tv;
                    else asm volatile("global_store_dwordx4 %0, %1, off sc1\n\ts_nop 1" :: "v"(dst), "v"(tv) : "memory");
                }
                if (fin) { ss += __shfl_xor(ss, 32); if (h == 0) SSg[(size_t)row * 64 + sspart] = ss; }
            }
            {
                bf16x8 vf[2];
#pragma unroll
                for (int s2 = 0; s2 < 2; ++s2) vf[s2] = *(const LAS bf16x8*)(VT + (32 * w + l31) * RSTR + (16 * s2 + 8 * h) * 2);
                LAS unsigned char* ka = KST + prow * RSTR + 16 * h;
                LAS unsigned char* da = (LAS unsigned char*)(DD + 8 * h);
                u32x4 kf[2][2];
                DSR128(kf[0][0], ka, 0); DSR128(kf[0][1], ka, 32);
#define USTEP(t) if constexpr (NT > (t)) { constexpr int s_ = (t) & 1; \
                    if constexpr ((t) + 1 < NT) { DSR128(kf[s_ ^ 1][0], ka, 32 * RSTR * ((t) + 1)); DSR128(kf[s_ ^ 1][1], ka, 32 * RSTR * ((t) + 1) + 32); \
                        asm volatile("s_waitcnt lgkmcnt(2)" : "+v"(kf[s_][0]), "+v"(kf[s_][1])); } \
                    else asm volatile("s_waitcnt lgkmcnt(0)" : "+v"(kf[s_][0]), "+v"(kf[s_][1])); \
                    S[t] = __builtin_amdgcn_mfma_f32_32x32x16_bf16(__builtin_bit_cast(bf16x8, kf[s_][0]), vf[0], S[t], 0, 0, 0); \
                    S[t] = __builtin_amdgcn_mfma_f32_32x32x16_bf16(__builtin_bit_cast(bf16x8, kf[s_][1]), vf[1], S[t], 0, 0, 0); \
                    __builtin_amdgcn_sched_barrier(0); }
                USTEP(0) USTEP(1) USTEP(2) USTEP(3) USTEP(4) USTEP(5) USTEP(6) USTEP(7)
#undef USTEP
                f32x4 dd[2][4];
                asm volatile("s_nop 15\n\ts_nop 15" ::: "memory");
                DSR128(dd[0][0], da, 0); DSR128(dd[0][1], da, 16); DSR128(dd[0][2], da, 64); DSR128(dd[0][3], da, 80);
#define DSTEP(t) if constexpr (NT > (t)) { constexpr int s_ = (t) & 1; \
                    if constexpr ((t) + 1 < NT) { DSR128(dd[s_ ^ 1][0], da, 128 * ((t) + 1)); DSR128(dd[s_ ^ 1][1], da, 128 * ((t) + 1) + 16); DSR128(dd[s_ ^ 1][2], da, 128 * ((t) + 1) + 64); DSR128(dd[s_ ^ 1][3], da, 128 * ((t) + 1) + 80); \
                        asm volatile("s_waitcnt lgkmcnt(4)" : "+v"(dd[s_][0]), "+v"(dd[s_][1]), "+v"(dd[s_][2]), "+v"(dd[s_][3])); } \
                    else asm volatile("s_waitcnt lgkmcnt(0)" : "+v"(dd[s_][0]), "+v"(dd[s_][1]), "+v"(dd[s_][2]), "+v"(dd[s_][3])); \
                    _Pragma("unroll") for (int r = 0; r < 4; ++r) { S[t][r] = vmul_v(S[t][r], dd[s_][0][r]); S[t][4 + r] = vmul_v(S[t][4 + r], dd[s_][1][r]); S[t][8 + r] = vmul_v(S[t][8 + r], dd[s_][2][r]); S[t][12 + r] = vmul_v(S[t][12 + r], dd[s_][3][r]); } \
                    asm volatile("" : "+v"(S[t])); __builtin_amdgcn_sched_barrier(0); }
                DSTEP(0) DSTEP(1) DSTEP(2) DSTEP(3) DSTEP(4) DSTEP(5) DSTEP(6) DSTEP(7)
#undef DSTEP
            }
            constexpr int FLAG_LAG = 8;
            if (k >= 8 + FLAG_LAG && k < 135) {
                asm volatile("s_waitcnt vmcnt(24)" ::: "memory"); static_assert(FLAG_LAG * 3 == 24, "vmcnt literal");
                const int kp = k - FLAG_LAG; const int lcp = dir ? 263 - kp : kp - 8;
                if (lane == 0) __hip_atomic_store(flg + lcp * 4 + w, 1u, __ATOMIC_RELAXED, __HIP_MEMORY_SCOPE_AGENT);
            } else if (k == 135) {
                VM_WAIT();
                if (lane == 0) {
#pragma unroll
                    for (int q = 0; q <= FLAG_LAG; ++q) { const int kp = 135 - q; const int lcp = dir ? 263 - kp : kp - 8; __hip_atomic_store(flg + lcp * 4 + w, 1u, __ATOMIC_RELAXED, __HIP_MEMORY_SCOPE_AGENT); }
                }
            }
            SBAR();
        }
    }
#undef STEP_CHUNK
}

__device__ __forceinline__ void phase7(const Params& p) {
    const int tid = threadIdx.x, wid = tid >> 6, lane = tid & 63;
    const float* sso = (const float*)(p.ws + WS_SSO);
    for (int m0 = 2 * (blockIdx.x * 8 + wid); m0 < M_LAT; m0 += 2 * gridDim.x * 8) {
        f32x4 ov[2][8]; float sv[2];
#pragma unroll
        for (int rr = 0; rr < 2; ++rr) { const int m = m0 + rr; sv[rr] = (lane < 32) ? sso[(size_t)m * 32 + lane] : 0.f;
            const f32x4* o4 = (const f32x4*)(p.out + (size_t)m * D) + lane;
#pragma unroll
            for (int j = 0; j < 8; ++j) ov[rr][j] = o4[64 * j]; }
#pragma unroll
        for (int rr = 0; rr < 2; ++rr) { const int m = m0 + rr;
            const float rstd = rsqrtf(wave_sum(sv[rr]) * (1.0f / D) + EPS);
            f32x4* o4 = (f32x4*)(p.out + (size_t)m * D) + lane;
#pragma unroll
            for (int j = 0; j < 8; ++j) { const f32x4 g = *(const f32x4*)(p.final_g + 4 * (lane + 64 * j)); o4[64 * j] = ov[rr][j] * rstd * g; } }
    }
}


#define XB_TMO      128
#define XB_XCNT(j)  (256  + 64 * (j))
#define XB_XSUB(j)  (1280 + 64 * (j))
#define XB_XGEN(j)  (2304 + 64 * (j))
#define XB_TOP      3328
#define XB_TOPGEN   3392
#define XCD_BAR_WORDS 3456
#define XB_SPIN_CAP (1u << 18)
__device__ __forceinline__ unsigned xb_ld(unsigned* p)              { return __hip_atomic_load(p, __ATOMIC_RELAXED, __HIP_MEMORY_SCOPE_AGENT); }
__device__ __forceinline__ unsigned xb_add(unsigned* p, unsigned v) { return __hip_atomic_fetch_add(p, v, __ATOMIC_RELAXED, __HIP_MEMORY_SCOPE_AGENT); }
__device__ __forceinline__ unsigned xb_xcc_id() { return (unsigned)__builtin_amdgcn_s_getreg((3 << 11) | 20) & 0xFu; }
#define XB_SPIN(cond, bar) do { unsigned _sp = 0; while (cond) { __builtin_amdgcn_s_sleep(1); \
    if ((++_sp & 255u) == 0u) { if (xb_ld(&(bar)[XB_TMO])) break; if (_sp > XB_SPIN_CAP) { atomicAdd(&(bar)[XB_TMO], 1u); break; } } } } while (0)
struct XcdBarrier { unsigned* bar; unsigned x; volatile LAS unsigned* st; };
__device__ __forceinline__ XcdBarrier xcd_barrier_post(unsigned* bar, volatile LAS unsigned* st) {
    XcdBarrier b; b.bar = bar; b.x = xb_xcc_id(); b.st = st;
    if (threadIdx.x == 0) (void)xb_add(&bar[XB_XCNT(b.x)], 1u);
    return b;
}
__device__ __forceinline__ void xcd_barrier_complete(unsigned* bar, unsigned x, unsigned& nloc, unsigned& nx) {
    const unsigned G = gridDim.x * gridDim.y * gridDim.z;
    unsigned sum, cnt, mine, sp = 0u;
    for (;;) {
        sum = 0u; cnt = 0u; mine = 0u;
#pragma unroll
        for (unsigned j = 0; j < 16; ++j) { const unsigned c = xb_ld(&bar[XB_XCNT(j)]); sum += c; cnt += (c > 0u) ? 1u : 0u; mine = (j == x) ? c : mine; }
        if (sum == G) break;
        __builtin_amdgcn_s_sleep(1);
        if ((++sp & 255u) == 0u) { if (xb_ld(&bar[XB_TMO])) break; if (sp > XB_SPIN_CAP) { atomicAdd(&bar[XB_TMO], 1u); break; } }
    }
    nloc = mine > 0u ? mine : 1u; nx = cnt > 0u ? cnt : 1u;
}
__device__ __forceinline__ void xcd_barrier(const XcdBarrier& b) {
    asm volatile("s_waitcnt vmcnt(0)" ::: "memory");
    __syncthreads();
    if (threadIdx.x == 0) {
        unsigned* bar = b.bar;
        __builtin_amdgcn_s_waitcnt(0);
        unsigned nloc = b.st[0], nx = b.st[1];
        if (nloc == 0u) { xcd_barrier_complete(bar, b.x, nloc, nx); b.st[0] = nloc; b.st[1] = nx; }
        const unsigned old = xb_add(&bar[XB_XSUB(b.x)], 1u);
        const unsigned gen = old / nloc;
        if (old + 1u == (gen + 1u) * nloc) {
            __builtin_amdgcn_fence(__ATOMIC_RELEASE, "agent");
            asm volatile("s_waitcnt vmcnt(0)" ::: "memory");
            const unsigned og = xb_add(&bar[XB_TOP], 1u);
            const unsigned tg = og / nx;
            if (og + 1u == (tg + 1u) * nx) xb_add(&bar[XB_TOPGEN], 1u);
            else XB_SPIN(xb_ld(&bar[XB_TOPGEN]) == tg, bar);
            __builtin_amdgcn_fence(__ATOMIC_ACQUIRE, "agent");
            xb_add(&bar[XB_XGEN(b.x)], 1u);
            asm volatile("s_waitcnt vmcnt(0)" ::: "memory");
        } else {
            XB_SPIN(xb_ld(&bar[XB_XGEN(b.x)]) == gen, bar);
            __builtin_amdgcn_fence(__ATOMIC_ACQUIRE, "agent");
            asm volatile("s_waitcnt vmcnt(0)" ::: "memory");
        }
    }
    __syncthreads();
}

__global__ void __launch_bounds__(512, 2) fwd_megakernel(Params p) {
    extern __shared__ __attribute__((aligned(16))) unsigned char lds_raw[];
    LAS unsigned char* lds = (LAS unsigned char*)lds_raw;
    volatile LAS unsigned* bst = (volatile LAS unsigned*)(lds + LDS_BYTES - 16);
    if (threadIdx.x < 4) bst[threadIdx.x] = 0u;
    __syncthreads();
    const XcdBarrier xbar = xcd_barrier_post((unsigned*)(p.ws + WS_BAR), bst);
    const int lo = p.ph_lo, hi = p.ph_hi;
    const int G = gridDim.x, c = blockIdx.x;
    unsigned char* ws = p.ws;
#ifdef ONLY_PHASE
#define IN(k) ((k) == ONLY_PHASE && lo <= (k) && (k) < hi)
#else
#define IN(k) (lo <= (k) && (k) < hi)
#endif
#define SEAM(k) do { if (IN(k) && IN((k) + 1)) xcd_barrier(xbar); } while (0)
#ifndef DUP_PHASE
#define DUP_PHASE -1
#endif
#define REP(k) for (int rep_ = 0; rep_ < ((k) == DUP_PHASE ? 2 : 1); ++rep_)
    if (IN(0)) REP(0) phase0(p, lds);
    SEAM(0);
    if (IN(1)) REP(1) phase1(p);
    SEAM(1);
    if (IN(2)) REP(2) { SchedScan S{G, c, (const char*)(ws + WS_H), (const char*)(ws + WS_WTS)}; EpiScan E{ws, p.lb_logits};
        pg8::gemm_phase<EpiScan, SchedScan, false, true, false>(lds, S, E); }
    SEAM(2);
    if (IN(3)) REP(3) phase2b(p, lds);
    SEAM(3);
    if (IN(4)) {
        unsigned* adone = (unsigned*)(ws + 256);
        EpiGate E{ws, (u16*)p.out, (u16*)p.out + (size_t)M_LAT * 2048, p.onorm_a, p.onorm_b, adone};
        if (c < 64) {
            scan_unit<128, true>(p, lds, c >> 5, (c >> 1) & 15, 0, c & 1, c >> 1);
            VM_WAIT(); __syncthreads();
            if (threadIdx.x == 0) { __builtin_amdgcn_fence(__ATOMIC_RELEASE, "agent"); VM_WAIT(); __hip_atomic_fetch_add(adone, 1u, __ATOMIC_RELAXED, __HIP_MEMORY_SCOPE_AGENT); }
            __syncthreads();
            SchedHelp S{128 + c, 0, (const char*)(ws + WS_H), (const char*)(ws + WS_WTG)};
            pg8::gemm_phase<EpiGate, SchedHelp, true, false, true>(lds, S, E);
        } else if (c < 128) { const int u = c - 64; scan_unit<256, false>(p, lds, u >> 5, (u >> 3) & 3, (u >> 1) & 3, u & 1, 32 + (u >> 1)); }
        else { SchedHelp S{c - 128, 4, (const char*)(ws + WS_H), (const char*)(ws + WS_WTG)};
            pg8::gemm_phase<EpiGate, SchedHelp, true, false, true>(lds, S, E); }
    }
    SEAM(4);
    if (IN(5)) { phase_wtp(p, lds);
        SchedTiles S{G, c, NAG_SCAN, 16 - NAG_SCAN, (const char*)(ws + WS_H), (const char*)(ws + WS_WTG)};
        EpiGate E{ws, (u16*)p.out, (u16*)p.out + (size_t)M_LAT * 2048, p.onorm_a, p.onorm_b, (const unsigned*)(ws + 256)};
        pg8::gemm_phase<EpiGate, SchedTiles, true, false, true>(lds, S, E); }
    SEAM(5);
    if (IN(6)) { SchedY S{G, c, (const char*)p.out, (const char*)p.out + (size_t)M_LAT * 2048 * 2, (const char*)(ws + WS_WTP)}; EpiY2 E{ws};
        pg8::gemm_phase<EpiY2, SchedY, true, false, true>(lds, S, E); }
    SEAM(6);
    if (IN(7)) REP(7) { SchedStd S{G, c, 8, (const char*)(ws + WS_Y), (const char*)(ws + WS_WTP) + (size_t)2 * 2048 * 4096, 0u};
        EpiOut E{p.x, p.out, (const float*)(ws + WS_MOD), (float*)(ws + WS_SSO)};
        pg8::gemm_phase<EpiOut, SchedStd, true, false, false>(lds, S, E); }
    SEAM(7);
    if (IN(8)) phase7(p);
#undef IN
#undef SEAM
}

#ifndef N_LAUNCHES
#define N_LAUNCHES 1
#endif
constexpr int N_PHASES = 9;

extern "C" void kernel_launch(void* const* d_in, const int* in_sizes, int n_in, void* d_out, int out_size, void* d_ws, size_t ws_size, hipStream_t stream) {
    static int grid = 0;
    if (grid == 0) {
        if (n_in != 17 || out_size != M_LAT * D || ws_size < WS_END) { fprintf(stderr, "kernel_launch: unexpected sizes (n_in %d out %d ws %zu need %zu)\n", n_in, out_size, ws_size, (size_t)WS_END); grid = -1; return; }
        int dev = 0, cus = 0, per_cu = 0;
        hipGetDevice(&dev);
        hipDeviceGetAttribute(&cus, hipDeviceAttributeMultiprocessorCount, dev);
        hipFuncSetAttribute((const void*)fwd_megakernel, hipFuncAttributeMaxDynamicSharedMemorySize, LDS_BYTES);
        hipOccupancyMaxActiveBlocksPerMultiprocessor(&per_cu, (const void*)fwd_megakernel, 512, LDS_BYTES);
        if (per_cu < 1) { fprintf(stderr, "kernel_launch: occupancy query reports %d blocks per CU\n", per_cu); grid = -1; return; }
        grid = cus;
    }
    if (grid < 0) return;
    Params p{};
    p.x = (const float*)d_in[0]; p.c = (const float*)d_in[1]; p.ctx = (const float*)d_in[2]; p.c_ctx = (const float*)d_in[3];
    p.w_ada = (const float*)d_in[4]; p.b_ada = (const float*)d_in[5]; p.norm_g = (const float*)d_in[6]; p.w_in = (const float*)d_in[7];
    p.lb_logits = (const float*)d_in[8]; p.gk_w = (const float*)d_in[9]; p.gk_b = (const float*)d_in[10]; p.onorm_a = (const float*)d_in[11];
    p.onorm_b = (const float*)d_in[12]; p.w_pa = (const float*)d_in[13]; p.w_pb = (const float*)d_in[14]; p.w_out = (const float*)d_in[15]; p.final_g = (const float*)d_in[16];
    p.out = (float*)d_out; p.ws = (unsigned char*)d_ws;
    (void)hipMemsetAsync((char*)d_ws + WS_BAR, 0, 16384, stream);
    const int per = (N_PHASES + N_LAUNCHES - 1) / N_LAUNCHES;
    for (int li = 0; li < N_LAUNCHES; ++li) {
        p.ph_lo = li * per; p.ph_hi = (li + 1) * per < N_PHASES ? (li + 1) * per : N_PHASES;
        if (p.ph_lo >= N_PHASES) break;
        void* args[] = {&p};
        hipError_t e = hipLaunchCooperativeKernel((const void*)fwd_megakernel, dim3(grid), dim3(512), args, LDS_BYTES, stream);
        if (e != hipSuccess) { fprintf(stderr, "cooperative launch failed: %s (grid %d)\n", hipGetErrorString(e), grid); break; }
    }
}
```

```cpp
#include <hip/hip_runtime.h>
#include <cstdio>
#include <cstdint>

#define LAS __attribute__((address_space(3)))
typedef unsigned short u16;
typedef short bf16x8 __attribute__((ext_vector_type(8)));
typedef float f32x2 __attribute__((ext_vector_type(2)));
typedef float f32x4 __attribute__((ext_vector_type(4)));
typedef float f32x16 __attribute__((ext_vector_type(16)));
typedef unsigned u32x2 __attribute__((ext_vector_type(2)));
typedef unsigned u32x4 __attribute__((ext_vector_type(4)));
typedef __bf16 bf16x2_t __attribute__((ext_vector_type(2)));
typedef _Float16 f16x2_t __attribute__((ext_vector_type(2)));

constexpr int D = 2048, NB = 2, SEQ = 8192, LCTX = 256;
constexpr int M_LAT = NB * SEQ;
constexpr int M_ALL = M_LAT + NB * LCTX;
constexpr int N_IN = 20512;
constexpr int NCHUNK = M_ALL / 32;
constexpr float EPS = 1e-6f;
constexpr int NSCAN_ROWS = 12544;
constexpr int NGATE_ROWS = 8192;

constexpr size_t WS_PDONE = 1024;
constexpr size_t WS_BAR = 4096;
constexpr size_t WS_FLG = WS_BAR + 16384;
constexpr size_t WS_MOD = WS_FLG + 64 * 256 * 4 * 4;
constexpr size_t WS_SSO = WS_MOD + 3 * 6144 * 4;
constexpr size_t WS_SSA = WS_SSO + (size_t)M_LAT * 32 * 4;
constexpr size_t WS_SSB = WS_SSA + (size_t)M_LAT * 64 * 4;
constexpr size_t WS_WTG = WS_SSB + (size_t)M_LAT * 64 * 4;
constexpr size_t WS_H   = WS_WTG + (size_t)NGATE_ROWS * D * 2;
constexpr size_t WS_WTS = WS_H + (size_t)M_ALL * D * 2;
constexpr size_t WS_LFB = WS_WTS;
constexpr size_t WS_R   = WS_LFB + (size_t)2 * NCHUNK * 1024 * 32 * 2;
constexpr size_t WS_AQ  = WS_R + (size_t)NCHUNK * 32 * 32 * 4;
constexpr size_t WS_AV  = WS_AQ + (size_t)NCHUNK * 2048 * 32 * 2;
constexpr size_t WS_ALF = WS_AV + (size_t)NCHUNK * 2048 * 32 * 2;
constexpr size_t WS_BQ  = WS_ALF + (size_t)2 * NCHUNK * 2048 * 32 * 2;
constexpr size_t WS_BK  = WS_BQ + (size_t)NCHUNK * 1024 * 32 * 2;
constexpr size_t WS_BV  = WS_BK + (size_t)NCHUNK * 1024 * 32 * 2;
constexpr size_t WS_MGA = WS_BV + (size_t)NCHUNK * 2048 * 32 * 2;
constexpr size_t WS_END = WS_MGA + (size_t)M_LAT * 2048 * 2;
constexpr size_t WS_MGB = WS_AQ;
constexpr size_t WS_Y   = WS_ALF;
constexpr size_t WS_WTP = WS_ALF + (size_t)M_LAT * 2048 * 2;
static_assert(WS_WTS + (size_t)NSCAN_ROWS * D * 2 <= WS_R, "LFB overlay");
static_assert(WS_MGB + (size_t)M_LAT * 2048 * 2 <= WS_AV, "MGB overlay");
static_assert(WS_WTP + (size_t)3 * D * D * 2 <= WS_BQ, "WTP overlay");
static_assert(WS_END <= (size_t)672137216, "workspace");

constexpr int LDS_BYTES = 155648;

struct Params {
    const float *x, *c, *ctx, *c_ctx, *w_ada, *b_ada, *norm_g, *w_in, *lb_logits, *gk_w, *gk_b, *onorm_a, *onorm_b, *w_pa, *w_pb, *w_out, *final_g;
    float* out; unsigned char* ws;
    int ph_lo, ph_hi;
};

__device__ __forceinline__ unsigned pk_bf16(float lo, float hi) { f32x2 v = {lo, hi}; return __builtin_bit_cast(unsigned, __builtin_convertvector(v, bf16x2_t)); }
__device__ __forceinline__ unsigned pk_f16(float lo, float hi) { f32x2 v = {lo, hi}; return __builtin_bit_cast(unsigned, __builtin_convertvector(v, f16x2_t)); }
__device__ __forceinline__ float bf_lo(unsigned w) { return __uint_as_float(w << 16); }
__device__ __forceinline__ float bf_hi(unsigned w) { return __uint_as_float(w & 0xffff0000u); }
__device__ __forceinline__ float bf_sel(unsigned w, int hi) { return hi ? bf_hi(w) : bf_lo(w); }
__device__ __forceinline__ float h_sel(unsigned w, int hi) { return (float)__builtin_bit_cast(_Float16, (u16)(hi ? (w >> 16) : (w & 0xffffu))); }
__device__ __forceinline__ float sigmoidf_(float v) { return __builtin_amdgcn_rcpf(1.0f + __builtin_amdgcn_exp2f(v * -1.4426950408889634f)); }
__device__ __forceinline__ float wave_sum(float v) {
#pragma unroll
    for (int o = 1; o < 64; o <<= 1) v += __shfl_xor(v, o);
    return v;
}
#define LDS_WAIT() asm volatile("s_waitcnt lgkmcnt(0)" ::: "memory")
#define VM_WAIT() asm volatile("s_waitcnt vmcnt(0)" ::: "memory")

namespace pg8 {
constexpr int BM = 256, BK = 64, HALF = 128, HTB = HALF * BK * 2, STAGE_BYTES = 8 * HTB, KD = 2048, NT = KD / BK;
__device__ __forceinline__ int lds_byte(int r, int c) { const int st = (r >> 4) * 2 + (c >> 5), rr = r & 15, cc = c & 31, ob = rr * 64 + cc * 2; return st * 1024 + (ob ^ (((ob >> 9) & 1) << 5)); }
__device__ __forceinline__ void stage_rc(int b, int& R, int& C) { const int st = b / 1024, sb = b % 1024, swz = sb ^ (((sb >> 9) & 1) << 5); R = (st >> 1) * 16 + swz / 64; C = (st & 1) * 32 + (swz % 64) / 2; }
__device__ __forceinline__ int perm32(int rho) { const int n = rho >> 4, i = rho & 15; return 8 * (i >> 2) + 4 * n + (i & 3); }

struct Unit { const char* A; const char* B; unsigned mode; unsigned hstepA; unsigned kstepA; int pm, pn; };
__device__ __forceinline__ unsigned voffA_of(unsigned mode, int R, int C) {
    if (mode == 0u) return (unsigned)(R * KD + C) * 2u;
    if (mode == 1u) return (unsigned)(R * 64 * KD + C) * 2u;
    if (mode == 2u) return (unsigned)((((R >> 5) * 64 + (C >> 5)) * 1024) + (R & 31) * 32 + (C & 31)) * 2u;
    return (unsigned)((((R & 63) * 4 * 64 + (C >> 5)) * 1024) + (R >> 6) * 32 + (C & 31)) * 2u;
}

template <class Epi, class Sched, bool TRANS, bool PERM_A, bool PERM_B>
__device__ __forceinline__ void gemm_phase(LAS unsigned char* lds, const Sched& S, const Epi& E) {
    const int tid = threadIdx.x, wid = __builtin_amdgcn_readfirstlane(tid >> 6), lane = tid & 63, wr = wid >> 2, wc = wid & 3, fr = lane & 15, fq = lane >> 4;
    int RaA[2], CA[2]; unsigned voffB[2];
#pragma unroll
    for (int i = 0; i < 2; ++i) { int R, C; stage_rc(tid * 16 + i * 8192, R, C);
        RaA[i] = PERM_A ? ((R & ~31) + perm32(R & 31)) : R; CA[i] = C; const int Rb = PERM_B ? ((R & ~31) + perm32(R & 31)) : R;
        voffB[i] = (unsigned)(Rb * KD + C) * 2u; }
    constexpr size_t kstep = (size_t)(BK * 2);
    constexpr size_t hstepB = (size_t)HALF * KD * 2;
    const unsigned ldsw = (unsigned)wid * 1024u;
    const int aoff = lds_byte(wr * 64 + fr, fq * 8), boff = lds_byte(wc * 32 + fr, fq * 8);
#define PG8_SA(b, h) (((b) * 2 + (h)) * HTB)
#define PG8_SB(b, h) ((4 + (b) * 2 + (h)) * HTB)
#define PG8_STAGE(bufoff, gbase, voff) do { _Pragma("unroll") for (int _i = 0; _i < 2; ++_i) \
        __builtin_amdgcn_global_load_lds((const unsigned*)((const char*)(gbase) + (voff)[_i]), (LAS unsigned*)(lds + (bufoff) + ldsw + _i * 8192), 16, 0, 0); } while (0)
#define PG8_LDA(dst, b, h) do { _Pragma("unroll") for (int m = 0; m < 4; ++m) _Pragma("unroll") for (int k = 0; k < 2; ++k) dst[m][k] = *(const LAS bf16x8*)(lds + PG8_SA(b, h) + aoff + m * 2048 + k * 1024); } while (0)
#define PG8_LDB(dst, b, h) do { _Pragma("unroll") for (int n = 0; n < 2; ++n) _Pragma("unroll") for (int k = 0; k < 2; ++k) dst[n][k] = *(const LAS bf16x8*)(lds + PG8_SB(b, h) + boff + n * 2048 + k * 1024); } while (0)
#define PG8_MMA(ai, bj, At, Bt) do { __builtin_amdgcn_s_setprio(1); _Pragma("unroll") for (int m = 0; m < 4; ++m) _Pragma("unroll") for (int n = 0; n < 2; ++n) _Pragma("unroll") for (int k = 0; k < 2; ++k) \
        acc[ai][bj][m][n] = TRANS ? __builtin_amdgcn_mfma_f32_16x16x32_bf16(Bt[n][k], At[m][k], acc[ai][bj][m][n], 0, 0, 0) \
                                  : __builtin_amdgcn_mfma_f32_16x16x32_bf16(At[m][k], Bt[n][k], acc[ai][bj][m][n], 0, 0, 0); __builtin_amdgcn_s_setprio(0); } while (0)
#define PG8_WAIT_V(n) asm volatile("s_waitcnt vmcnt(" #n ")" ::: "memory")
#define PG8_WAIT_L(n) asm volatile("s_waitcnt lgkmcnt(" #n ")" ::: "memory")
#define PG8_BAR __builtin_amdgcn_s_barrier()
#define PG8_SCHED __builtin_amdgcn_sched_barrier(0)
    Unit cur, nxt; int ui = 0;
    if (!S.next(0, cur)) return;
    f32x4 acc[2][2][4][2];
#pragma unroll
    for (int a = 0; a < 2; ++a)
#pragma unroll
        for (int b = 0; b < 2; ++b)
#pragma unroll
            for (int m = 0; m < 4; ++m)
#pragma unroll
                for (int n = 0; n < 2; ++n) acc[a][b][m][n] = (f32x4){0.f, 0.f, 0.f, 0.f};
    bf16x8 At[4][2], B0[2][2], B1[2][2];
    const char* cA = cur.A; const char* cB = cur.B;
    unsigned vA[2] = {voffA_of(cur.mode, RaA[0], CA[0]), voffA_of(cur.mode, RaA[1], CA[1])};
    size_t hA = cur.hstepA, kA = cur.kstepA;
    PG8_STAGE(PG8_SB(0, 0), cB, voffB); PG8_STAGE(PG8_SA(0, 0), cA, vA); PG8_STAGE(PG8_SB(0, 1), cB + hstepB, voffB); PG8_STAGE(PG8_SA(0, 1), cA + hA, vA);
    if (wr == 1) PG8_BAR;
    PG8_WAIT_V(4); PG8_BAR;
    PG8_STAGE(PG8_SB(1, 0), cB + kstep, voffB); PG8_STAGE(PG8_SA(1, 0), cA + kA, vA); PG8_STAGE(PG8_SB(1, 1), cB + hstepB + kstep, voffB);
    PG8_WAIT_V(6); PG8_BAR;
    for (;;) {
        const bool has_next = S.next(ui + 1, nxt);
        const char* nA = has_next ? nxt.A : cA; const char* nB = has_next ? nxt.B : cB;
        unsigned vN[2]; size_t hN, kN;
        if (has_next) { vN[0] = voffA_of(nxt.mode, RaA[0], CA[0]); vN[1] = voffA_of(nxt.mode, RaA[1], CA[1]); hN = nxt.hstepA; kN = nxt.kstepA; } else { vN[0] = vA[0]; vN[1] = vA[1]; hN = hA; kN = kA; }
        for (int t = 0; t < NT; t += 2) {
            const bool last = (t == NT - 2);
            const char* a1 = cA + (size_t)(t + 1) * kA;
            const char* a2 = last ? nA : cA + (size_t)(t + 2) * kA; const char* b2 = last ? nB : cB + (size_t)(t + 2) * kstep;
            const char* a3 = a2 + (last ? kN : kA); const char* b3 = b2 + kstep;
            unsigned v2[2] = {last ? vN[0] : vA[0], last ? vN[1] : vA[1]}; const size_t h2 = last ? hN : hA;
            PG8_LDB(B0, 0, 0); PG8_SCHED; PG8_LDA(At, 0, 0); PG8_STAGE(PG8_SA(1, 1), a1 + hA, vA);
            PG8_WAIT_L(8); PG8_BAR; PG8_WAIT_L(0); PG8_MMA(0, 0, At, B0); PG8_BAR; PG8_SCHED;
            PG8_LDB(B1, 0, 1); PG8_STAGE(PG8_SB(0, 0), b2, voffB);
            PG8_BAR; PG8_WAIT_L(0); PG8_MMA(0, 1, At, B1); PG8_BAR;
            PG8_LDA(At, 0, 1); PG8_STAGE(PG8_SA(0, 0), a2, v2);
            PG8_BAR; PG8_WAIT_L(0); PG8_MMA(1, 0, At, B0); PG8_BAR; PG8_SCHED;
            PG8_STAGE(PG8_SB(0, 1), b2 + hstepB, voffB);
            PG8_WAIT_V(6); PG8_BAR; PG8_MMA(1, 1, At, B1); PG8_BAR;
            PG8_LDB(B0, 1, 0); PG8_SCHED; PG8_LDA(At, 1, 0); PG8_STAGE(PG8_SA(0, 1), a2 + h2, v2);
            PG8_WAIT_L(8); PG8_BAR; PG8_WAIT_L(0); PG8_MMA(0, 0, At, B0); PG8_BAR; PG8_SCHED;
            PG8_LDB(B1, 1, 1); PG8_STAGE(PG8_SB(1, 0), b3, voffB);
            PG8_BAR; PG8_WAIT_L(0); PG8_MMA(0, 1, At, B1); PG8_BAR;
            PG8_LDA(At, 1, 1); PG8_STAGE(PG8_SA(1, 0), a3, v2);
            PG8_BAR; PG8_WAIT_L(0); PG8_MMA(1, 0, At, B0); PG8_BAR; PG8_SCHED;
            PG8_STAGE(PG8_SB(1, 1), b3 + hstepB, voffB);
            PG8_WAIT_V(6); PG8_BAR; PG8_MMA(1, 1, At, B1); PG8_BAR;
        }
        E(acc, cur, wr, wc, fr, fq);
        if (!has_next) break;
#pragma unroll
        for (int a = 0; a < 2; ++a)
#pragma unroll
            for (int b = 0; b < 2; ++b)
#pragma unroll
                for (int m = 0; m < 4; ++m)
#pragma unroll
                    for (int n = 0; n < 2; ++n) acc[a][b][m][n] = (f32x4){0.f, 0.f, 0.f, 0.f};
        cur = nxt; cA = nA; cB = nB; vA[0] = vN[0]; vA[1] = vN[1]; hA = hN; kA = kN; ++ui;
    }
    PG8_WAIT_V(0);
    if (wr == 0) PG8_BAR;
    PG8_BAR;
#undef PG8_SA
#undef PG8_SB
#undef PG8_STAGE
#undef PG8_LDA
#undef PG8_LDB
#undef PG8_MMA
#undef PG8_WAIT_V
#undef PG8_WAIT_L
#undef PG8_BAR
#undef PG8_SCHED
}
}

typedef f32x4 AccT[2][2][4][2];

struct SchedScan {
    int G, c; const char* h; const char* wts;
    __device__ __forceinline__ bool next(int i, pg8::Unit& u) const {
        const int L = i * G + c;
        if (L >= 64 * 49 + 2 * 37) return false;
        int pm, pn;
        if (L < 64 * 49) { pm = L & 63; pn = L >> 6; }
        else { const int r = L - 64 * 49; pm = 64 + (r & 1); int q = r >> 1; pn = (q < 24) ? 8 + q : 36 + (q - 24); }
        u.pm = pm; u.pn = pn; u.B = wts + (size_t)pn * 256 * 4096;
        if (pn >= 32 && pm < 64) {
            const int b = pm >> 5, pp = pm & 31;
            u.A = h + (size_t)(b * 8192 + 2 * pp) * 4096; u.mode = 1u; u.hstepA = 4096u; u.kstepA = 128u;
        } else { u.A = h + (size_t)pm * 256 * 4096; u.mode = 0u; u.hstepA = 128u * 4096u; u.kstepA = 128u; }
        return true;
    }
};
struct SchedStd {
    int G, c, nN; const char* A; const char* B; unsigned mode;
    __device__ __forceinline__ bool next(int i, pg8::Unit& u) const {
        const int L = i * G + c;
        if (L >= 64 * nN) return false;
        u.pm = L & 63; u.pn = L >> 6; u.B = B + (size_t)u.pn * 256 * 4096; u.mode = mode;
        if (mode == 0u) { u.A = A + (size_t)u.pm * 256 * 4096; u.hstepA = 128u * 4096u; u.kstepA = 128u; }
        else if (mode == 2u) { u.A = A + (size_t)u.pm * 8 * 64 * 2048; u.hstepA = 4u * 64u * 2048u; u.kstepA = 4096u; }
        else { const int bb = u.pm >> 5, pp = u.pm & 31;
            u.A = A + ((size_t)(bb * 256 + (pp >> 3)) * 64 * 1024 + (size_t)(4 * (pp & 7)) * 32) * 2; u.hstepA = 2u * 32u * 2u; u.kstepA = 4096u; }
        return true;
    }
};

struct EpiScan {
    unsigned char* ws; const float* lbl;
    __device__ __forceinline__ void operator()(const AccT& acc, const pg8::Unit& u, int wr, int wc, int fr, int fq) const {
        const int pn = u.pn;
        int kind, pl, W; size_t base;
        if (pn < 8) { kind = 0; pl = pn; W = 2048; base = WS_AQ; }
        else if (pn < 16) { kind = 0; pl = pn - 8; W = 2048; base = WS_AV; }
        else if (pn < 24) { kind = 1; pl = pn - 16; W = 2048; base = WS_ALF; }
        else if (pn < 32) { kind = 2; pl = pn - 24; W = 2048; base = WS_ALF + (size_t)NCHUNK * 2048 * 32 * 2; }
        else if (pn < 36) { kind = 3; pl = pn - 32; W = 1024; base = WS_BQ; }
        else if (pn < 40) { kind = 0; pl = pn - 36; W = 1024; base = WS_BK; }
        else if (pn < 48) { kind = 0; pl = pn - 40; W = 2048; base = WS_BV; }
        else { kind = 4; pl = 0; W = 32; base = WS_R; }
#pragma unroll
        for (int bj = 0; bj < 2; ++bj)
#pragma unroll
            for (int n = 0; n < 2; ++n) {
                const int ch = pl * 256 + bj * 128 + wc * 32 + n * 16 + fr;
                float lb = 0.f;
                if (kind == 1 || kind == 2) { const int li = (kind == 2 ? 2048 : 0) + ch; lb = sigmoidf_(lbl[li] - lbl[4096 + li]); }
#pragma unroll
                for (int ai = 0; ai < 2; ++ai)
#pragma unroll
                    for (int q = 0; q < 2; ++q) {
                        const int chunk = u.pm * 8 + ai * 4 + wr * 2 + q;
                        f32x4 v0 = acc[ai][bj][2 * q][n], v1 = acc[ai][bj][2 * q + 1][n];
                        if (kind == 4) {
                            if (wc == 0 && bj == 0) { float* dst = (float*)(ws + base) + ((size_t)chunk * 32 + (n * 16 + fr)) * 32 + 8 * fq; *(f32x4*)dst = v0; *(f32x4*)(dst + 4) = v1; }
                        } else {
                            u32x4 w;
                            if (kind == 1 || kind == 2) {
                                float t[8] = {v0[0], v0[1], v0[2], v0[3], v1[0], v1[1], v1[2], v1[3]};
#pragma unroll
                                for (int e = 0; e < 8; ++e) t[e] = __log2f(lb + (1.0f - lb) * sigmoidf_(t[e]));
                                w.x = pk_f16(t[0], t[1]); w.y = pk_f16(t[2], t[3]); w.z = pk_f16(t[4], t[5]); w.w = pk_f16(t[6], t[7]);
                            } else {
                                if (kind == 3) { v0 = v0 * 0.0625f; v1 = v1 * 0.0625f; }
                                w.x = pk_bf16(v0[0], v0[1]); w.y = pk_bf16(v0[2], v0[3]); w.z = pk_bf16(v1[0], v1[1]); w.w = pk_bf16(v1[2], v1[3]);
                            }
                            const int chs = (pn >= 32 && pn < 40) ? ((ch & ~255) | ((ch & 1) << 7) | ((ch & 255) >> 1)) : ch;
                            u16* dst = (u16*)(ws + base) + (((size_t)chunk * 4 + fq) * W + chs) * 8;
                            *(u32x4*)dst = w;
                        }
                    }
            }
    }
};

struct EpiGate {
    unsigned char* ws; u16* OA; u16* OB; const float* gain_a; const float* gain_b; const unsigned* pdone;
    __device__ __forceinline__ void operator()(const AccT& acc, const pg8::Unit& u, int wr, int wc, int fr, int fq) const {
        const int pn = u.pn;
        const int row0 = u.pm * 256 + wr * 64 + fr;
        if (pn < 8 || pn >= 24) {
            unsigned spins = 0;
            while (__hip_atomic_load(pdone + u.pm * 4, __ATOMIC_RELAXED, __HIP_MEMORY_SCOPE_AGENT) < 64u) { __builtin_amdgcn_s_sleep(8); if (++spins > (1u << 22)) break; }
            __builtin_amdgcn_fence(__ATOMIC_ACQUIRE, "agent");
        }
        if (pn >= 16) {
            u16* MG = (u16*)(ws + (pn < 24 ? WS_MGA : WS_MGB));
            const int col0 = ((pn - 16) & 7) * 256 + wc * 32 + 8 * fq;
#pragma unroll
            for (int ai = 0; ai < 2; ++ai)
#pragma unroll
                for (int m = 0; m < 4; ++m) { u16* rowp = MG + (size_t)(row0 + ai * 128 + m * 16) * 2048 + col0;
#pragma unroll
                    for (int bj = 0; bj < 2; ++bj) { const f32x4 v0 = acc[ai][bj][m][0], v1 = acc[ai][bj][m][1]; u32x4 w;
                        w.x = pk_bf16(sigmoidf_(v0[0]), sigmoidf_(v0[1])); w.y = pk_bf16(sigmoidf_(v0[2]), sigmoidf_(v0[3]));
                        w.z = pk_bf16(sigmoidf_(v1[0]), sigmoidf_(v1[1])); w.w = pk_bf16(sigmoidf_(v1[2]), sigmoidf_(v1[3]));
                        *(u32x4*)(rowp + bj * 128) = w; } }
        } else {
            const bool isA = pn < 8; const int pl = isA ? pn : pn - 8;
            u16* O = isA ? OA : OB; const float* gain = isA ? gain_a : gain_b;
            const float* SS = (const float*)(ws + (isA ? WS_SSA : WS_SSB));
            const int col0 = pl * 256 + wc * 32 + 8 * fq;
            f32x4 g[2][2];
#pragma unroll
            for (int bj = 0; bj < 2; ++bj) { g[bj][0] = *(const f32x4*)(gain + col0 + bj * 128); g[bj][1] = *(const f32x4*)(gain + col0 + bj * 128 + 4); }
#pragma unroll
            for (int ai = 0; ai < 2; ++ai)
#pragma unroll
                for (int m = 0; m < 4; ++m) {
                    const int row = row0 + ai * 128 + m * 16;
                    float rstd[2];
                    if (isA) {
#pragma unroll
                        for (int bj = 0; bj < 2; ++bj) { const f32x4 s = *(const f32x4*)(SS + (size_t)row * 64 + (pl * 2 + bj) * 4); rstd[bj] = rsqrtf(((s[0] + s[1]) + (s[2] + s[3])) * (1.0f / 128.0f) + EPS); }
                    } else {
                        const float* sp = SS + (size_t)row * 64 + (pl >> 1) * 16; float t = 0.f;
#pragma unroll
                        for (int k = 0; k < 4; ++k) { const f32x4 s = *(const f32x4*)(sp + 4 * k); t += (s[0] + s[1]) + (s[2] + s[3]); }
                        rstd[0] = rstd[1] = rsqrtf(t * (1.0f / 512.0f) + EPS);
                    }
                    size_t tb;
                    if (isA) tb = ((size_t)(row >> 5) * 64) * 1024 + (size_t)(row & 31) * 32;
                    else { const int bb = row >> 13, t = row & 8191, ps = (t & 63) * 128 + (t >> 6); tb = ((size_t)(bb * 256 + (ps >> 5)) * 64) * 1024 + (size_t)(ps & 31) * 32; }
                    u16* rowp = O + tb + (size_t)(col0 >> 5) * 1024 + (col0 & 31);
#pragma unroll
                    for (int bj = 0; bj < 2; ++bj) {
                        const u32x4 ov = *(const u32x4*)(rowp + bj * 4 * 1024);
                        const f32x4 a0 = acc[ai][bj][m][0], a1 = acc[ai][bj][m][1];
                        float o[8] = {bf_lo(ov.x), bf_hi(ov.x), bf_lo(ov.y), bf_hi(ov.y), bf_lo(ov.z), bf_hi(ov.z), bf_lo(ov.w), bf_hi(ov.w)};
                        float gt[8] = {a0[0], a0[1], a0[2], a0[3], a1[0], a1[1], a1[2], a1[3]};
                        float gg[8] = {g[bj][0][0], g[bj][0][1], g[bj][0][2], g[bj][0][3], g[bj][1][0], g[bj][1][1], g[bj][1][2], g[bj][1][3]};
#pragma unroll
                        for (int e = 0; e < 8; ++e) o[e] = (o[e] * rstd[bj] * gg[e]) * (gt[e] * sigmoidf_(gt[e]));
                        u32x4 w; w.x = pk_bf16(o[0], o[1]); w.y = pk_bf16(o[2], o[3]); w.z = pk_bf16(o[4], o[5]); w.w = pk_bf16(o[6], o[7]);
                        *(u32x4*)(rowp + bj * 4 * 1024) = w;
                    }
                }
        }
    }
};
constexpr int NAG_SCAN = 8;
constexpr int NH_SHARED = 7;
struct SchedHelp {
    int id; int n_first; const char* A; const char* B;
    __device__ __forceinline__ bool next(int i, pg8::Unit& u) const {
        int pm, tile;
        if (i < n_first) { const int L = i * 128 + id; pm = L & 63; tile = 16 + (L >> 6); }
        else { int L;
            if (id < 128) { if (i - n_first >= NH_SHARED) return false; L = (i - n_first) * 128 + id; }
            else { L = 128 * NH_SHARED + i * 64 + (id - 128); if (L >= 1024) return false; }
            const int r = L >> 6, q = L & 63, ti = q >> 2, bb = q & 1, side = (q >> 1) & 1;
            pm = bb * 32 + (side ? 16 + r : 15 - r); tile = ti < 8 ? ti : 24 + (ti - 8); }
        u.pm = pm; u.pn = tile; u.A = A + (size_t)pm * 256 * 4096; u.B = B + (size_t)tile * 256 * 4096; u.mode = 0u; u.hstepA = 128u * 4096u; u.kstepA = 128u;
        return true;
    }
};
struct SchedTiles {
    int G, c, tile0, nT; const char* A; const char* B;
    __device__ __forceinline__ bool next(int i, pg8::Unit& u) const {
        const int L = i * G + c;
        if (L >= 64 * nT) return false;
        u.pm = L & 63; u.pn = tile0 + (L >> 6); u.A = A + (size_t)u.pm * 256 * 4096; u.B = B + (size_t)u.pn * 256 * 4096; u.mode = 0u; u.hstepA = 128u * 4096u; u.kstepA = 128u;
        return true;
    }
};

template <int SECOND> struct EpiY {
    unsigned char* ws;
    __device__ __forceinline__ void operator()(const AccT& acc, const pg8::Unit& u, int wr, int wc, int fr, int fq) const {
        const u16* MG = (const u16*)(ws + (SECOND ? WS_MGB : WS_MGA)); u16* Y = (u16*)(ws + WS_Y);
        const int row0 = u.pm * 256 + wr * 64 + fr, col0 = u.pn * 256 + wc * 32 + 8 * fq;
#pragma unroll
        for (int ai = 0; ai < 2; ++ai)
#pragma unroll
            for (int m = 0; m < 4; ++m) { const int row = row0 + ai * 128 + m * 16;
#pragma unroll
                for (int bj = 0; bj < 2; ++bj) {
                    const u32x4 mv = *(const u32x4*)(MG + (size_t)row * 2048 + col0 + bj * 128);
                    const f32x4 a0 = acc[ai][bj][m][0], a1 = acc[ai][bj][m][1];
                    float o[8] = {a0[0] * bf_lo(mv.x), a0[1] * bf_hi(mv.x), a0[2] * bf_lo(mv.y), a0[3] * bf_hi(mv.y), a1[0] * bf_lo(mv.z), a1[1] * bf_hi(mv.z), a1[2] * bf_lo(mv.w), a1[3] * bf_hi(mv.w)};
                    u16* yp = Y + (size_t)row * 2048 + col0 + bj * 128;
                    if (SECOND) { const u32x4 yv = *(const u32x4*)yp;
                        o[0] += bf_lo(yv.x); o[1] += bf_hi(yv.x); o[2] += bf_lo(yv.y); o[3] += bf_hi(yv.y); o[4] += bf_lo(yv.z); o[5] += bf_hi(yv.z); o[6] += bf_lo(yv.w); o[7] += bf_hi(yv.w); }
                    u32x4 w; w.x = pk_bf16(o[0], o[1]); w.y = pk_bf16(o[2], o[3]); w.z = pk_bf16(o[4], o[5]); w.w = pk_bf16(o[6], o[7]);
                    *(u32x4*)yp = w;
                } }
    }
};

struct SchedY {
    int G, c; const char* OA; const char* OB; const char* WP;
    __device__ __forceinline__ bool next(int i, pg8::Unit& u) const {
        const int L = (i >> 1) * G + c;
        if (L >= 512) return false;
        const int pm = L & 63, pn = L >> 6; u.pm = pm; u.kstepA = 4096u;
        if ((i & 1) == 0) { u.pn = pn | 0x100; u.mode = 2u; u.A = OA + (size_t)pm * 8 * 64 * 2048; u.hstepA = 4u * 64u * 2048u; u.B = WP + (size_t)pn * 256 * 4096; }
        else { u.pn = pn; u.mode = 3u; const int bb = pm >> 5, pp = pm & 31;
            u.A = OB + ((size_t)(bb * 256 + (pp >> 3)) * 64 * 1024 + (size_t)(4 * (pp & 7)) * 32) * 2; u.hstepA = 2u * 32u * 2u; u.B = WP + (size_t)2048 * 4096 + (size_t)pn * 256 * 4096; }
        return true;
    }
};
struct EpiY2 {
    unsigned char* ws;
    __device__ __forceinline__ void operator()(const AccT& acc, const pg8::Unit& u, int wr, int wc, int fr, int fq) const {
        pg8::Unit v = u; v.pn = u.pn & 0xff;
        if (u.pn & 0x100) { EpiY<0> e{ws}; e(acc, v, wr, wc, fr, fq); } else { EpiY<1> e{ws}; e(acc, v, wr, wc, fr, fq); }
    }
};

struct EpiOut {
    const float* x; float* out; const float* mod; float* sso;
    __device__ __forceinline__ void operator()(const AccT& acc, const pg8::Unit& u, int wr, int wc, int fr, int fq) const {
        const int row0 = u.pm * 256 + wr * 64 + fr, col0 = u.pn * 256 + wc * 32 + 4 * fq;
        const float* gate = mod + (size_t)(u.pm >> 5) * 6144 + 4096;
        f32x4 gv[2][2];
#pragma unroll
        for (int bj = 0; bj < 2; ++bj)
#pragma unroll
            for (int n = 0; n < 2; ++n) gv[bj][n] = *(const f32x4*)(gate + col0 + bj * 128 + n * 16);
#pragma unroll
        for (int ai = 0; ai < 2; ++ai)
#pragma unroll
            for (int mh = 0; mh < 2; ++mh) {
                f32x4 xv[2][2][2];
#pragma unroll
                for (int mm = 0; mm < 2; ++mm) { const size_t off = (size_t)(row0 + ai * 128 + (2 * mh + mm) * 16) * 2048 + col0;
#pragma unroll
                    for (int bj = 0; bj < 2; ++bj)
#pragma unroll
                        for (int n = 0; n < 2; ++n) xv[mm][bj][n] = *(const f32x4*)(x + off + bj * 128 + n * 16); }
#pragma unroll
                for (int mm = 0; mm < 2; ++mm) { const int m = 2 * mh + mm; const int row = row0 + ai * 128 + m * 16; const size_t off = (size_t)row * 2048 + col0; float s = 0.f;
#pragma unroll
                    for (int bj = 0; bj < 2; ++bj)
#pragma unroll
                        for (int n = 0; n < 2; ++n) { const f32x4 o = xv[mm][bj][n] + gv[bj][n] * acc[ai][bj][m][n];
                            *(f32x4*)(out + off + bj * 128 + n * 16) = o; s += (o[0] * o[0] + o[1] * o[1]) + (o[2] * o[2] + o[3] * o[3]); }
                    s += __shfl_xor(s, 16); s += __shfl_xor(s, 32);
                    if (fq == 0) sso[(size_t)row * 32 + u.pn * 4 + wc] = s; }
            }
    }
};

__device__ __forceinline__ void transpose_item(const float* W, int N, int n0, int k0, u16* WTrow0, LAS float* scr, int lane) {
    float tv[32];
#pragma unroll
    for (int i = 0; i < 32; ++i) tv[i] = W[(size_t)(k0 + 2 * i + (lane >> 5)) * N + n0 + (lane & 31)];
#pragma unroll
    for (int i = 0; i < 32; ++i) scr[(2 * i + (lane >> 5)) * 33 + (lane & 31)] = tv[i];
    LDS_WAIT(); asm volatile("" ::: "memory");
    const int c = lane & 7;
#pragma unroll
    for (int j = 0; j < 4; ++j) { const int n = (lane >> 3) + 8 * j; const LAS float* s = scr + (8 * c) * 33 + n;
        u32x4 o; o.x = pk_bf16(s[0 * 33], s[1 * 33]); o.y = pk_bf16(s[2 * 33], s[3 * 33]); o.z = pk_bf16(s[4 * 33], s[5 * 33]); o.w = pk_bf16(s[6 * 33], s[7 * 33]);
        *(u32x4*)(WTrow0 + (size_t)n * 2048 + k0 + 8 * c) = o; }
    LDS_WAIT(); asm volatile("" ::: "memory");
}

__device__ __forceinline__ void phase0(const Params& p, LAS unsigned char* lds) {
    const int tid = threadIdx.x, wid = tid >> 6, lane = tid & 63;
    unsigned char* ws = p.ws;
    if (blockIdx.x < 192) {
        LAS float* sl = (LAS float*)lds;
        LAS float* red = (LAS float*)lds + 6144;
        for (int i = tid; i < 3 * 2048; i += 512) { const int v = i >> 11, d = i & 2047; const float cv = (v < 2) ? p.c[v * 2048 + d] : p.c_ctx[d]; sl[i] = cv * sigmoidf_(cv); }
        __syncthreads();
        const int cg4 = tid & 7, kl = tid >> 3;
        const int col = blockIdx.x * 32 + cg4 * 4;
        f32x4 a0 = {0, 0, 0, 0}, a1 = {0, 0, 0, 0}, a2 = {0, 0, 0, 0};
#pragma unroll 8
        for (int k = kl; k < 2048; k += 64) { const f32x4 w = *(const f32x4*)(p.w_ada + (size_t)k * 6144 + col); a0 += sl[k] * w; a1 += sl[2048 + k] * w; a2 += sl[4096 + k] * w; }
        LAS float* rp = red + tid * 12;
#pragma unroll
        for (int e = 0; e < 4; ++e) { rp[e] = a0[e]; rp[4 + e] = a1[e]; rp[8 + e] = a2[e]; }
        __syncthreads();
        if (tid < 96) { const int v = tid >> 5, cc = tid & 31, g4 = cc >> 2, e = cc & 3; float s = 0.f;
            for (int k = 0; k < 64; ++k) s += red[(k * 8 + g4) * 12 + v * 4 + e];
            ((float*)(ws + WS_MOD))[v * 6144 + blockIdx.x * 32 + cc] = s + p.b_ada[blockIdx.x * 32 + cc]; }
        __syncthreads();
    }
    LAS float* scr = (LAS float*)(lds + 65536 + wid * 8448);
    const int gw = blockIdx.x * 8 + wid, NGW = gridDim.x * 8;
    constexpr int I_IN = 32 * 641;
    u16* WTS = (u16*)(ws + WS_WTS); u16* WTG = (u16*)(ws + WS_WTG);
    for (int it = gw; it < I_IN; it += NGW) {
        const int kb = it / 641, cb = it - kb * 641, n0 = cb * 32;
        u16* dst;
        if (n0 < 8192) dst = WTS + (size_t)n0 * 2048;
        else if (n0 < 10240) dst = WTG + (size_t)(n0 - 8192) * 2048;
        else if (n0 < 14336) dst = WTS + (size_t)(8192 + n0 - 10240) * 2048;
        else if (n0 == 14336) dst = WTS + (size_t)12288 * 2048;
        else if (n0 < 16416) dst = WTG + (size_t)(2048 + n0 - 14368) * 2048;
        else dst = WTG + (size_t)(4096 + n0 - 16416) * 2048;
        transpose_item(p.w_in, N_IN, n0, kb * 64, dst, scr, lane);
    }
    { u32x4* z = (u32x4*)(WTS + (size_t)12320 * 2048); const int nz = 224 * 2048 * 2 / 16;
      for (int i = blockIdx.x * 512 + tid; i < nz; i += gridDim.x * 512) z[i] = (u32x4){0u, 0u, 0u, 0u}; }
}

__device__ __forceinline__ void phase_wtp(const Params& p, LAS unsigned char* lds) {
    const int tid = threadIdx.x, wid = tid >> 6, lane = tid & 63;
    LAS float* scr = (LAS float*)(lds + wid * 8448);
    const int gw = blockIdx.x * 8 + wid, NGW = gridDim.x * 8;
    u16* WTP = (u16*)(p.ws + WS_WTP);
    for (int it = gw; it < 3 * 2048; it += NGW) {
        const int which = it >> 11, r = it & 2047;
        const float* W = which == 0 ? p.w_pa : (which == 1 ? p.w_pb : p.w_out);
        const int kb = r >> 6, cb = r & 63;
        transpose_item(W, 2048, cb * 32, kb * 64, WTP + (size_t)which * 2048 * 2048 + (size_t)(cb * 32) * 2048, scr, lane);
    }
    __syncthreads();
}

__device__ __forceinline__ void phase1(const Params& p) {
    const int tid = threadIdx.x, wid = tid >> 6, lane = tid & 63;
    const float* mod = (const float*)(p.ws + WS_MOD);
    u16* H = (u16*)(p.ws + WS_H);
    for (int i = blockIdx.x * 512 + tid; i < 64 * 256 * 4; i += gridDim.x * 512) ((unsigned*)(p.ws + WS_FLG))[i] = 0u;
    if (blockIdx.x == 0 && tid < 64) ((unsigned*)(p.ws + WS_PDONE))[tid * 4] = 0u;
    for (int m0 = 2 * (blockIdx.x * 8 + wid); m0 < M_ALL; m0 += 2 * gridDim.x * 8) {
        f32x4 xv[2][8]; float ss[2] = {0.f, 0.f};
#pragma unroll
        for (int rr = 0; rr < 2; ++rr) { const int m = m0 + rr;
            const float* src = (m < M_LAT) ? p.x + (size_t)m * D : p.ctx + (size_t)(m - M_LAT) * D;
            const f32x4* s4 = (const f32x4*)src + lane;
#pragma unroll
            for (int j = 0; j < 8; ++j) xv[rr][j] = s4[64 * j]; }
#pragma unroll
        for (int rr = 0; rr < 2; ++rr)
#pragma unroll
            for (int j = 0; j < 8; ++j) ss[rr] += (xv[rr][j][0] * xv[rr][j][0] + xv[rr][j][1] * xv[rr][j][1]) + (xv[rr][j][2] * xv[rr][j][2] + xv[rr][j][3] * xv[rr][j][3]);
#pragma unroll
        for (int rr = 0; rr < 2; ++rr) { const int m = m0 + rr;
            const int v = (m < M_LAT) ? (m >> 13) : 2;
            const float rstd = rsqrtf(wave_sum(ss[rr]) * (1.0f / D) + EPS);
            u32x2* o8 = (u32x2*)(H + (size_t)m * D) + lane;
#pragma unroll
            for (int j = 0; j < 8; ++j) { const int col = 4 * (lane + 64 * j);
                const f32x4 g = *(const f32x4*)(p.norm_g + col), sh = *(const f32x4*)(mod + v * 6144 + col), sc = *(const f32x4*)(mod + v * 6144 + 2048 + col);
                const f32x4 y = (xv[rr][j] * rstd * g) * (sc + 1.0f) + sh;
                o8[64 * j] = (u32x2){pk_bf16(y[0], y[1]), pk_bf16(y[2], y[3])}; } }
    }
}

__device__ __forceinline__ void phase2b(const Params& p, LAS unsigned char* lds) {
    const int tid = threadIdx.x;
    const float* R = (const float*)(p.ws + WS_R);
    u16* LFB = (u16*)(p.ws + WS_LFB);
    LAS float* rs = (LAS float*)lds;
    float w[2][2][16], bias[2][2];
#pragma unroll
    for (int d = 0; d < 2; ++d)
#pragma unroll
        for (int cc = 0; cc < 2; ++cc) { bias[d][cc] = p.gk_b[d * 1024 + cc * 512 + tid];
#pragma unroll
            for (int r = 0; r < 16; ++r) w[d][cc][r] = p.gk_w[(size_t)(d * 16 + r) * 1024 + cc * 512 + tid]; }
    int buf = 0;
    for (int chunk = blockIdx.x; chunk < NCHUNK; chunk += gridDim.x, buf ^= 1) {
        LAS float* rb = rs + buf * 1024;
        { const f32x2 v = *(const f32x2*)(R + (size_t)chunk * 1024 + 2 * tid); *(LAS f32x2*)(rb + 2 * tid) = v; }
        __syncthreads();
#pragma unroll
        for (int d = 0; d < 2; ++d)
        {
            float run[2] = {0.f, 0.f};
#pragma unroll 1
            for (int t8i = 0; t8i < 4; ++t8i) {
                const int t8 = d ? 3 - t8i : t8i;
                float z[2][8];
#pragma unroll
                for (int cc = 0; cc < 2; ++cc)
#pragma unroll
                    for (int e = 0; e < 8; ++e) z[cc][e] = bias[d][cc];
#pragma unroll
                for (int r = 0; r < 16; ++r) {
                    LAS float* ra = rb + (d * 16 + r) * 32 + t8 * 8; asm volatile("" : "+v"(ra));
                    const f32x4 r0 = *(const LAS f32x4*)ra, r1 = *(const LAS f32x4*)(ra + 4);
#pragma unroll
                    for (int cc = 0; cc < 2; ++cc) { const float ww = w[d][cc][r];
#pragma unroll
                        for (int e = 0; e < 4; ++e) { z[cc][e] = __builtin_fmaf(r0[e], ww, z[cc][e]); z[cc][4 + e] = __builtin_fmaf(r1[e], ww, z[cc][4 + e]); } }
                }
#pragma unroll
                for (int cc = 0; cc < 2; ++cc) {
                    float zz[8];
#pragma unroll
                    for (int e = 0; e < 8; ++e) zz[e] = z[cc][e];
#pragma unroll
                    for (int e = 0; e < 8; ++e) { const float a = fabsf(zz[e]); zz[e] = (fminf(zz[e], 0.f) - __logf(1.0f + __expf(-a))) * (0.0625f * 1.4426950408889634f); }
#pragma unroll
                    for (int e_ = 0; e_ < 8; ++e_) { const int e = d ? 7 - e_ : e_; run[cc] += zz[e]; zz[e] = run[cc]; }
                    u32x4 o; o.x = pk_f16(zz[0], zz[1]); o.y = pk_f16(zz[2], zz[3]); o.z = pk_f16(zz[4], zz[5]); o.w = pk_f16(zz[6], zz[7]);
                    const int ch = cc * 512 + tid, chs = (ch & ~255) | ((ch & 1) << 7) | ((ch & 255) >> 1);
                    *(u32x4*)(LFB + ((((size_t)d * NCHUNK + chunk) * 4 + t8) * 1024 + chs) * 8) = o;
                }
            }
        }
    }
    __syncthreads();
}

__device__ __forceinline__ bf16x8 pack8(const f32x16& x, int s) {
    u32x4 pk; pk.x = pk_bf16(x[8 * s + 0], x[8 * s + 1]); pk.y = pk_bf16(x[8 * s + 2], x[8 * s + 3]); pk.z = pk_bf16(x[8 * s + 4], x[8 * s + 5]); pk.w = pk_bf16(x[8 * s + 6], x[8 * s + 7]);
    return __builtin_bit_cast(bf16x8, pk);
}
__device__ __forceinline__ unsigned rot16(unsigned x) { return (x >> 16) | (x << 16); }
template <int NW> __device__ __forceinline__ void maybe_rev(unsigned (&w)[NW], bool rev) {
    unsigned r[NW];
#pragma unroll
    for (int k = 0; k < NW; ++k) r[k] = rot16(w[NW - 1 - k]);
#pragma unroll
    for (int k = 0; k < NW; ++k) w[k] = rev ? r[k] : w[k];
}
__device__ __forceinline__ void ld16(unsigned (&w)[8], const u16* p) { const u32x4 a = *(const u32x4*)p, b = *(const u32x4*)(p + 8); w[0] = a.x; w[1] = a.y; w[2] = a.z; w[3] = a.w; w[4] = b.x; w[5] = b.y; w[6] = b.z; w[7] = b.w; }
__device__ __forceinline__ void ld16q(unsigned (&w)[8], const u16* p, size_t qstride) { const u32x4 a = *(const u32x4*)p, b = *(const u32x4*)(p + qstride); w[0] = a.x; w[1] = a.y; w[2] = a.z; w[3] = a.w; w[4] = b.x; w[5] = b.y; w[6] = b.z; w[7] = b.w; }
__device__ __forceinline__ void ld32(unsigned (&w)[16], const u16* p) {
#pragma unroll
    for (int k = 0; k < 4; ++k) { const u32x4 a = *(const u32x4*)(p + 8 * k); w[4 * k] = a.x; w[4 * k + 1] = a.y; w[4 * k + 2] = a.z; w[4 * k + 3] = a.w; }
}

#define DSR128(dst, addr, off) asm volatile("ds_read_b128 %0, %1 offset:%2" : "=v"(dst) : "v"(addr), "i"(off))
#define SBAR() do { asm volatile("s_waitcnt lgkmcnt(0)" ::: "memory"); __builtin_amdgcn_s_barrier(); asm volatile("" ::: "memory"); } while (0)
__device__ __forceinline__ f32x2 h2_sel(unsigned w0, unsigned w1, int hi) { return (f32x2){h_sel(w0, hi), h_sel(w1, hi)}; }
__device__ __forceinline__ f32x2 bf2_sel(unsigned w0, unsigned w1, int hi) { return (f32x2){bf_sel(w0, hi), bf_sel(w1, hi)}; }
#define GLD128(dst, ptr) asm volatile("global_load_dwordx4 %0, %1, off" : "=v"(dst) : "v"(ptr) : "memory")
#define GLD128_SC1(dst, ptr, off) asm volatile("global_load_dwordx4 %0, %1, off offset:%2 sc1" : "=v"(dst) : "v"(ptr), "i"(off) : "memory")
__device__ __forceinline__ unsigned wsel(const u32x4 (&v)[2], int w) { return v[w >> 2][w & 3]; }
__device__ __forceinline__ float vmul(float a, float b) { float r; asm("v_mul_f32_e32 %0, %1, %2" : "=v"(r) : "v"(a), "v"(b)); return r; }
__device__ __forceinline__ float vmul_v(float a, float b) { float r; asm volatile("v_mul_f32_e32 %0, %1, %2" : "=v"(r) : "v"(a), "v"(b)); return r; }
#define VEXP(dst, src) asm volatile("v_exp_f32_e32 %0, %1" : "=v"(dst) : "v"(src))
#define VEXPN(dst, src) asm volatile("v_exp_f32_e64 %0, -%1" : "=v"(dst) : "v"(src))
__device__ __forceinline__ float vmul_t(float a, float b) { float r; asm("s_nop 1\n\tv_mul_f32_e32 %0, %1, %2" : "=v"(r) : "v"(a), "v"(b)); return r; }
template <int DK, bool IS_A, int DIRC>
__device__ __forceinline__ void producer_loop(const Params& p, LAS unsigned char* lds, int b, int hh, int quarter, int pair, int pw, int ptid, int lane) {
    constexpr int QSTR = DK * 2 + 16, RSTR = 80;
    constexpr int OFF_KS = 32 * QSTR, OFF_KST = 2 * 32 * QSTR, OFF_VT = OFF_KST + DK * RSTR, OFF_DD = OFF_VT + 128 * RSTR, OFF_PD = OFF_DD + DK * 4, BUFB = OFF_PD + 4 * 32 * RSTR;
    constexpr int dir = DIRC;
    constexpr int NS = IS_A ? 6 : 14;
    const int h = lane >> 5, l31 = lane & 31;
    unsigned char* ws = p.ws;
    const u16* Qg = (const u16*)(ws + (IS_A ? WS_AQ : WS_BQ));
    const u16* Kg = (const u16*)(ws + WS_BK);
    const u16* Vg = (const u16*)(ws + (IS_A ? WS_AV : WS_BV));
    const u16* LFg = IS_A ? (const u16*)(ws + WS_ALF) + (size_t)dir * NCHUNK * 2048 * 32 : (const u16*)(ws + WS_LFB) + (size_t)dir * NCHUNK * 1024 * 32;
    unsigned* flg = (unsigned*)(ws + WS_FLG) + pair * 1024;
    const u16* Ogc = (const u16*)p.out + (IS_A ? 0 : (size_t)M_LAT * 2048);
    (void)ptid; (void)Kg;
#define STEP_CHUNK(k, is_ctx_, lc_, cidx_) const bool is_ctx_ = (k) < 8; const int lc_ = is_ctx_ ? (dir ? 7 - (k) : (k)) : (dir ? 263 - (k) : (k) - 8); const int cidx_ = is_ctx_ ? 512 + b * 8 + lc_ : b * 256 + lc_;
#define PD_LOADS(kq_, PD4) do { \
        STEP_CHUNK(kq_, icf, lcf, cidxf); (void)icf; (void)cidxf; \
        const u16* src = Ogc + ((size_t)(b * 256 + lcf) * 64 + (IS_A ? hh * 4 : hh * 16 + quarter * 4) + pw) * 1024 + lane * 8; \
        GLD128_SC1(PD4[0], src, 0); GLD128_SC1(PD4[1], src, 1024); \
    } while (0)
#define PD_ISSUE(kk, PD4) do { const int kq2_ = ((kk) >= 136 && (kk) < 264) ? (kk) : 136; PD_LOADS(kq2_, PD4); } while (0)
#define PD_FIRST(kk, PD4) do { if ((kk) == 136) { \
        STEP_CHUNK(136, icg, lcg, cidxg); (void)icg; (void)cidxg; unsigned spins = 0; \
        while (__hip_atomic_load(flg + lcg * 4 + pw, __ATOMIC_RELAXED, __HIP_MEMORY_SCOPE_AGENT) == 0u) { __builtin_amdgcn_s_sleep(2); if (++spins > (1u << 22)) break; } \
        PD_LOADS(136, PD4); \
        asm volatile("s_waitcnt vmcnt(0)" : "+v"(PD4[0]), "+v"(PD4[1])); } } while (0)
#define PD_STORE(PD4) do { _Pragma("unroll") for (int j_ = 0; j_ < 2; ++j_) *(LAS u32x4*)(buf + OFF_PD + (pw * 32 + 16 * j_ + (lane >> 2)) * RSTR + (lane & 3) * 16) = PD4[j_]; } while (0)
#define BUF_PTRS(kk) LAS unsigned char* buf = lds + ((kk) & 1) * BUFB; LAS unsigned char* QS = buf; LAS unsigned char* KS = buf + OFF_KS; LAS unsigned char* KST = buf + OFF_KST; LAS unsigned char* VT = buf + OFF_VT; LAS float* DD = (LAS float*)(buf + OFF_DD);
#define WAITV(n, ...) asm volatile("s_waitcnt vmcnt(" #n ")" : __VA_ARGS__)
    if (IS_A) {
        const int c = 32 * pw + l31, th = h;
#define LOAD_A(LF, QW, VW, kk) do { const int kl_ = (kk) < 264 ? (kk) : 263; STEP_CHUNK(kl_, ic, lc, cidx); (void)lc; (void)ic; \
            const size_t eo = (((size_t)cidx * 4 + 2 * th) * 2048 + hh * 128 + c) * 8; \
            GLD128(LF[0], LFg + eo); GLD128(LF[1], LFg + eo + 2048 * 8); GLD128(QW[0], Qg + eo); GLD128(QW[1], Qg + eo + 2048 * 8); GLD128(VW[0], Vg + eo); GLD128(VW[1], Vg + eo + 2048 * 8); } while (0)
#define PROC_A(LF, QW, VW, kk, PC, PN) do { \
            BUF_PTRS(kk) \
            PD_FIRST(kk, PC); \
            PD_ISSUE((kk) + 1, PN); \
            asm volatile("s_waitcnt vmcnt(10)" : "+v"(LF[0]), "+v"(LF[1]), "+v"(QW[0]), "+v"(QW[1]), "+v"(VW[0]), "+v"(VW[1]));     \
            float E[16], kk_[16]; float run = 1.f; \
            _Pragma("unroll") for (int it_ = 0; it_ < 16; ++it_) { const int it = dir ? 15 - it_ : it_; const float f = __builtin_amdgcn_exp2f(h_sel(wsel(LF, it >> 1), it & 1)); run = vmul_t(run, f); E[it] = run; kk_[it] = 1.0f - f; } \
            const float other = __shfl_xor(run, 32); \
            const float pre = (dir ? (th == 0) : (th == 1)) ? other : 1.0f; \
            unsigned kst[8]; \
            _Pragma("unroll") for (int it = 0; it < 16; it += 2) { \
                float ks2[2]; \
                _Pragma("unroll") for (int e = 0; e < 2; ++e) { const int i2 = it + e; const float ev = vmul(E[i2], pre); const float qs = vmul(bf_sel(wsel(QW, i2 >> 1), i2 & 1), ev); ks2[e] = vmul_t(kk_[i2], __builtin_amdgcn_rcpf(fmaxf(ev, 1e-30f))); \
                    const int i = 16 * th + i2; \
                    *(LAS u16*)(QS + i * QSTR + c * 2) = (u16)(pk_bf16(qs, 0.f) & 0xffffu); \
                    *(LAS u16*)(KS + i * QSTR + c * 2) = (u16)(pk_bf16(ks2[e], 0.f) & 0xffffu); } \
                kst[it >> 1] = pk_bf16(ks2[0], ks2[1]); \
            } \
            if (dir ? (th == 0) : (th == 1)) DD[c] = vmul(dir ? E[0] : E[15], pre); \
            *(LAS u32x4*)(KST + c * RSTR + th * 32) = (u32x4){kst[0], kst[1], kst[2], kst[3]}; \
            *(LAS u32x4*)(KST + c * RSTR + th * 32 + 16) = (u32x4){kst[4], kst[5], kst[6], kst[7]}; \
            *(LAS u32x4*)(VT + c * RSTR + th * 32) = VW[0]; \
            *(LAS u32x4*)(VT + c * RSTR + th * 32 + 16) = VW[1]; \
            asm volatile("s_waitcnt vmcnt(8)" : "+v"(PC[0]), "+v"(PC[1]));     \
            PD_STORE(PC); \
        } while (0)
        static_assert(NS == 6 || !IS_A, "wait counts");
        u32x4 lf0[2], q0_[2], v0_[2], lf1[2], q1_[2], v1_[2]; u32x4 pe[2], po[2];
        LOAD_A(lf0, q0_, v0_, 0); PD_ISSUE(0, pe); LOAD_A(lf1, q1_, v1_, 1);
#pragma unroll 1
        for (int k = 0; k < 264; k += 2) {
            PROC_A(lf0, q0_, v0_, k, pe, po); LOAD_A(lf0, q0_, v0_, k + 2); SBAR();
            PROC_A(lf1, q1_, v1_, k + 1, po, pe); LOAD_A(lf1, q1_, v1_, k + 3); SBAR();
        }
        asm volatile("s_waitcnt vmcnt(0)" ::: "memory");
#undef LOAD_A
#undef PROC_A
    } else {
        const int cp = 32 * pw + l31, th = h;
        const int col = ptid & 127, thv = ptid >> 7;
#define LOAD_B(LF, QW, KW, VW, kk) do { const int kl_ = (kk) < 264 ? (kk) : 263; STEP_CHUNK(kl_, ic, lc, cidx); (void)lc; (void)ic; \
            const size_t eo = (((size_t)cidx * 4 + 2 * th) * 1024 + hh * 256 + cp) * 8; const size_t evv = (((size_t)cidx * 4 + 2 * thv) * 2048 + hh * 512 + quarter * 128 + col) * 8; \
            GLD128(LF[0][0], LFg + eo); GLD128(LF[0][1], LFg + eo + 1024 * 8); GLD128(LF[1][0], LFg + eo + 128 * 8); GLD128(LF[1][1], LFg + eo + 128 * 8 + 1024 * 8); \
            GLD128(KW[0][0], Kg + eo); GLD128(KW[0][1], Kg + eo + 1024 * 8); GLD128(KW[1][0], Kg + eo + 128 * 8); GLD128(KW[1][1], Kg + eo + 128 * 8 + 1024 * 8); \
            GLD128(QW[0][0], Qg + eo); GLD128(QW[0][1], Qg + eo + 1024 * 8); GLD128(QW[1][0], Qg + eo + 128 * 8); GLD128(QW[1][1], Qg + eo + 128 * 8 + 1024 * 8); \
            GLD128(VW[0], Vg + evv); GLD128(VW[1], Vg + evv + 2048 * 8); } while (0)
#define PROC_B(LF, QW, KW, VW, kk, PC, PN) do { \
            BUF_PTRS(kk) \
            PD_FIRST(kk, PC); \
            PD_ISSUE((kk) + 1, PN); \
            asm volatile("s_waitcnt vmcnt(18)" : "+v"(LF[0][0]), "+v"(LF[0][1]), "+v"(LF[1][0]), "+v"(LF[1][1]), "+v"(KW[0][0]), "+v"(KW[0][1]), "+v"(KW[1][0]), "+v"(KW[1][1]), \
                         "+v"(QW[0][0]), "+v"(QW[0][1]), "+v"(QW[1][0]), "+v"(QW[1][1]), "+v"(VW[0]), "+v"(VW[1]));     \
            const bool tail = dir ? (th == 0) : (th == 1); \
            unsigned kst0[8], kst1[8]; float dd0 = 0.f, dd1 = 0.f; \
            float en0, in0, en1, in1;     \
            { const float c0 = h_sel(wsel(LF[0], 0), 0), c1 = h_sel(wsel(LF[1], 0), 0); VEXP(en0, c0); VEXPN(in0, c0); VEXP(en1, c1); VEXPN(in1, c1); } \
            float kap = 0.f, kbp = 0.f; \
            _Pragma("unroll") for (int it = 0; it < 16; ++it) { \
                const float e0 = en0, i0 = in0, e1 = en1, i1 = in1; \
                if (it < 15) { const float c0 = h_sel(wsel(LF[0], (it + 1) >> 1), (it + 1) & 1), c1 = h_sel(wsel(LF[1], (it + 1) >> 1), (it + 1) & 1); VEXP(en0, c0); VEXPN(in0, c0); VEXP(en1, c1); VEXPN(in1, c1); } \
                if (it == (dir ? 0 : 15)) { dd0 = e0; dd1 = e1; } \
                const float qs0 = vmul_v(bf_sel(wsel(QW[0], it >> 1), it & 1), e0), qs1 = vmul_v(bf_sel(wsel(QW[1], it >> 1), it & 1), e1); \
                const float ka = vmul_v(bf_sel(wsel(KW[0], it >> 1), it & 1), i0), kb = vmul_v(bf_sel(wsel(KW[1], it >> 1), it & 1), i1); \
                const int i = 16 * th + it; \
                *(LAS unsigned*)(QS + i * QSTR + cp * 4) = pk_bf16(qs0, qs1); \
                *(LAS unsigned*)(KS + i * QSTR + cp * 4) = pk_bf16(ka, kb); \
                if (it & 1) { kst0[it >> 1] = pk_bf16(kap, ka); kst1[it >> 1] = pk_bf16(kbp, kb); } \
                kap = ka; kbp = kb; \
            } \
            if (tail) { *(LAS f32x2*)(DD + 2 * cp) = (f32x2){dd0, dd1}; } \
            *(LAS u32x4*)(KST + (2 * cp) * RSTR + th * 32) = (u32x4){kst0[0], kst0[1], kst0[2], kst0[3]}; \
            *(LAS u32x4*)(KST + (2 * cp) * RSTR + th * 32 + 16) = (u32x4){kst0[4], kst0[5], kst0[6], kst0[7]}; \
            *(LAS u32x4*)(KST + (2 * cp + 1) * RSTR + th * 32) = (u32x4){kst1[0], kst1[1], kst1[2], kst1[3]}; \
            *(LAS u32x4*)(KST + (2 * cp + 1) * RSTR + th * 32 + 16) = (u32x4){kst1[4], kst1[5], kst1[6], kst1[7]}; \
            *(LAS u32x4*)(VT + col * RSTR + thv * 32) = VW[0]; \
            *(LAS u32x4*)(VT + col * RSTR + thv * 32 + 16) = VW[1]; \
            asm volatile("s_waitcnt vmcnt(16)" : "+v"(PC[0]), "+v"(PC[1]));     \
            PD_STORE(PC); \
        } while (0)
        static_assert(NS == 14 || IS_A, "wait counts");
        u32x4 lf0[2][2], q0_[2][2], k0_[2][2], v0_[2], lf1[2][2], q1_[2][2], k1_[2][2], v1_[2]; u32x4 pe[2], po[2];
        LOAD_B(lf0, q0_, k0_, v0_, 0); PD_ISSUE(0, pe); LOAD_B(lf1, q1_, k1_, v1_, 1);
#pragma unroll 1
        for (int k = 0; k < 264; k += 2) {
            PROC_B(lf0, q0_, k0_, v0_, k, pe, po); LOAD_B(lf0, q0_, k0_, v0_, k + 2); SBAR();
            PROC_B(lf1, q1_, k1_, v1_, k + 1, po, pe); LOAD_B(lf1, q1_, k1_, v1_, k + 3); SBAR();
        }
        asm volatile("s_waitcnt vmcnt(0)" ::: "memory");
#undef LOAD_B
#undef PROC_B
    }
#undef WAITV
#undef PD_LOADS
#undef PD_FIRST
#undef PD_ISSUE
#undef PD_STORE
#undef BUF_PTRS
#undef STEP_CHUNK
}

template <int DK, bool IS_A>
__device__ __forceinline__ void scan_unit(const Params& p, LAS unsigned char* lds, int b, int hh, int quarter, int dir, int pair) {
    constexpr int NT = DK / 32;
    constexpr int QSTR = DK * 2 + 16;
    constexpr int RSTR = 80;
    constexpr int OFF_KS = 32 * QSTR, OFF_KST = 2 * 32 * QSTR, OFF_VT = OFF_KST + DK * RSTR, OFF_DD = OFF_VT + 128 * RSTR, OFF_PD = OFF_DD + DK * 4, BUFB = OFF_PD + 4 * 32 * RSTR;
    static_assert(2 * BUFB <= LDS_BYTES, "scan LDS");
    const int tid = threadIdx.x, wid = __builtin_amdgcn_readfirstlane(tid >> 6), lane = tid & 63;
    const int h = lane >> 5, l31 = lane & 31;
    unsigned char* ws = p.ws;
    const u16* Qg = (const u16*)(ws + (IS_A ? WS_AQ : WS_BQ));
    const u16* Kg = (const u16*)(ws + WS_BK);
    const u16* Vg = (const u16*)(ws + (IS_A ? WS_AV : WS_BV));
    const u16* LFg = IS_A ? (const u16*)(ws + WS_ALF) + (size_t)dir * NCHUNK * 2048 * 32 : (const u16*)(ws + WS_LFB) + (size_t)dir * NCHUNK * 1024 * 32;
    unsigned* flg = (unsigned*)(ws + WS_FLG) + pair * 1024;
    const u16* Ogc = (const u16*)p.out + (IS_A ? 0 : (size_t)M_LAT * 2048);
#define STEP_CHUNK(k, is_ctx_, lc_, cidx_) const bool is_ctx_ = (k) < 8; const int lc_ = is_ctx_ ? (dir ? 7 - (k) : (k)) : (dir ? 263 - (k) : (k) - 8); const int cidx_ = is_ctx_ ? 512 + b * 8 + lc_ : b * 256 + lc_;
    if (wid >= 4) {
        const int pw = wid - 4, ptid = tid - 256;
        if (dir) producer_loop<DK, IS_A, 1>(p, lds, b, hh, quarter, pair, pw, ptid, lane);
        else producer_loop<DK, IS_A, 0>(p, lds, b, hh, quarter, pair, pw, ptid, lane);
        SBAR();
    } else {
        const int w = wid;
        u16* Og = (u16*)p.out + (IS_A ? 0 : (size_t)M_LAT * 2048);
        float* SSg = (float*)(ws + (IS_A ? WS_SSA : WS_SSB));
        unsigned* pdone = (unsigned*)(ws + WS_PDONE); (void)pdone; constexpr int PANEL_LAG = 4;
        const int ocol0 = IS_A ? hh * 128 + 32 * w : hh * 512 + quarter * 128 + 32 * w;
        const int sspart = IS_A ? hh * 4 + w : hh * 16 + quarter * 4 + w;
        const int prow = (l31 & 3) + 8 * ((l31 >> 2) & 1) + 4 * ((l31 >> 3) & 1) + 16 * (l31 >> 4);
        f32x16 S[NT];
#pragma unroll
        for (int t = 0; t < NT; ++t)
#pragma unroll
            for (int r = 0; r < 16; ++r) S[t][r] = 0.f;
        unsigned mk[2][4];
#pragma unroll
        for (int s2 = 0; s2 < 2; ++s2)
#pragma unroll
            for (int q = 0; q < 4; ++q) { const int r0 = 8 * s2 + 2 * q; const int j0 = (r0 & 3) + 8 * (r0 >> 2) + 4 * h, j1 = j0 + 1;
                const bool k0 = dir ? (j0 >= l31) : (j0 <= l31), k1 = dir ? (j1 >= l31) : (j1 <= l31);
                mk[s2][q] = (k0 ? 0xffffu : 0u) | (k1 ? 0xffff0000u : 0u); }
        SBAR();
#pragma unroll 1
        for (int k = 0; k < 264; ++k) {
            STEP_CHUNK(k, is_ctx, lc, cidx); (void)cidx;
            LAS unsigned char* buf = lds + (k & 1) * BUFB;
            LAS unsigned char* QS = buf; LAS unsigned char* KS = buf + OFF_KS; LAS unsigned char* KST = buf + OFF_KST; LAS unsigned char* VT = buf + OFF_VT; LAS float* DD = (LAS float*)(buf + OFF_DD);
            const bool fin = k >= 136;
            int row = 0;
            if (!is_ctx) { if (IS_A) row = b * SEQ + 32 * lc + l31; else { const int pp = 32 * lc + l31; row = b * SEQ + (pp & 127) * 64 + (pp >> 7); } }
            u16* otile = Og + ((size_t)(b * 256 + lc) * 64 + (IS_A ? hh * 4 : hh * 16 + quarter * 4) + w) * 1024;
            LAS unsigned char* orow = buf + OFF_PD + (w * 32 + l31) * RSTR + 8 * h;
            bf16x8 vk[2];
            f32x16 OT;
#pragma unroll
            for (int r = 0; r < 16; ++r) OT[r] = 0.f;
            if (!is_ctx) {
                f32x16 PT;
#pragma unroll
                for (int r = 0; r < 16; ++r) PT[r] = 0.f;
                {
                    LAS unsigned char* qa = QS + l31 * QSTR + 16 * h;
                    u32x4 fq[2][2], fk[2][2];
                    DSR128(fq[0][0], qa, 0); DSR128(fk[0][0], qa, OFF_KS); DSR128(fq[0][1], qa, 32); DSR128(fk[0][1], qa, OFF_KS + 32);
#define FSTEP(pp) if constexpr (NT > (pp)) { constexpr int s_ = (pp) & 1; \
                        if constexpr ((pp) + 1 < NT) { DSR128(fq[s_ ^ 1][0], qa, 64 * ((pp) + 1)); DSR128(fk[s_ ^ 1][0], qa, OFF_KS + 64 * ((pp) + 1)); \
                            DSR128(fq[s_ ^ 1][1], qa, 64 * ((pp) + 1) + 32); DSR128(fk[s_ ^ 1][1], qa, OFF_KS + 64 * ((pp) + 1) + 32); \
                            asm volatile("s_waitcnt lgkmcnt(4)" : "+v"(fq[s_][0]), "+v"(fk[s_][0]), "+v"(fq[s_][1]), "+v"(fk[s_][1])); } \
                        else asm volatile("s_waitcnt lgkmcnt(0)" : "+v"(fq[s_][0]), "+v"(fk[s_][0]), "+v"(fq[s_][1]), "+v"(fk[s_][1])); \
                        PT = __builtin_amdgcn_mfma_f32_32x32x16_bf16(__builtin_bit_cast(bf16x8, fk[s_][0]), __builtin_bit_cast(bf16x8, fq[s_][0]), PT, 0, 0, 0); \
                        OT = __builtin_amdgcn_mfma_f32_32x32x16_bf16(pack8(S[pp], 0), __builtin_bit_cast(bf16x8, fq[s_][0]), OT, 0, 0, 0); \
                        PT = __builtin_amdgcn_mfma_f32_32x32x16_bf16(__builtin_bit_cast(bf16x8, fk[s_][1]), __builtin_bit_cast(bf16x8, fq[s_][1]), PT, 0, 0, 0); \
                        OT = __builtin_amdgcn_mfma_f32_32x32x16_bf16(pack8(S[pp], 1), __builtin_bit_cast(bf16x8, fq[s_][1]), OT, 0, 0, 0); \
                        __builtin_amdgcn_sched_barrier(0); }
                    FSTEP(0) FSTEP(1) FSTEP(2) FSTEP(3) FSTEP(4) FSTEP(5) FSTEP(6) FSTEP(7)
#undef FSTEP
                }
#pragma unroll
                for (int s2 = 0; s2 < 2; ++s2) {
                    const u32x2 lo = *(const LAS u32x2*)(VT + (32 * w + l31) * RSTR + (16 * s2 + 4 * h) * 2);
                    const u32x2 hi = *(const LAS u32x2*)(VT + (32 * w + l31) * RSTR + (16 * s2 + 8 + 4 * h) * 2);
                    vk[s2] = __builtin_bit_cast(bf16x8, (u32x4){lo.x, lo.y, hi.x, hi.y});
                    u32x4 pw4 = __builtin_bit_cast(u32x4, pack8(PT, s2));
                    pw4.x &= mk[s2][0]; pw4.y &= mk[s2][1]; pw4.z &= mk[s2][2]; pw4.w &= mk[s2][3];
                    OT = __builtin_amdgcn_mfma_f32_32x32x16_bf16(vk[s2], __builtin_bit_cast(bf16x8, pw4), OT, 0, 0, 0);
                }
                float ss = 0.f;
#pragma unroll
                for (int g = 0; g < 4; ++g) {
                    float o0 = OT[4 * g], o1 = OT[4 * g + 1], o2 = OT[4 * g + 2], o3 = OT[4 * g + 3];
                    if (fin) {
                        const u32x2 pvv = *(const LAS u32x2*)(orow + 16 * g); const unsigned lo = pvv.x, hi = pvv.y;
                        o0 += bf_lo(lo); o1 += bf_hi(lo); o2 += bf_lo(hi); o3 += bf_hi(hi);
                        ss += (o0 * o0 + o1 * o1) + (o2 * o2 + o3 * o3);
                    }
                    *(LAS u32x2*)(orow + 16 * g) = (u32x2){pk_bf16(o0, o1), pk_bf16(o2, o3)};
                }
                asm volatile("s_waitcnt lgkmcnt(0)" ::: "memory");
#pragma unroll
                for (int j = 0; j < 2; ++j) {
                    const u32x4 tv = *(const LAS u32x4*)(buf + OFF_PD + (w * 32 + 16 * j + (lane >> 2)) * RSTR + (lane & 3) * 16);
                    u16* dst = otile + j * 512 + lane * 8;
                    if (fin && !IS_A) *(u32x4*)dst = tv;
                    else asm volatile("global_store_dwordx4 %0, %1, off sc1\n\ts_nop 1" :: "v"(dst), "v"(tv) : "memory");
                }
                if (fin) { ss += __shfl_xor(ss, 32);
                    if (h == 0) { float* sp = SSg + (size_t)row * 64 + sspart; if (IS_A) asm volatile("global_store_dword %0, %1, off sc1" :: "v"(sp), "v"(ss) : "memory"); else *sp = ss; } }
            }
            {
                bf16x8 vf[2];
#pragma unroll
                for (int s2 = 0; s2 < 2; ++s2) vf[s2] = *(const LAS bf16x8*)(VT + (32 * w + l31) * RSTR + (16 * s2 + 8 * h) * 2);
                LAS unsigned char* ka = KST + prow * RSTR + 16 * h;
                LAS unsigned char* da = (LAS unsigned char*)(DD + 8 * h);
                u32x4 kf[2][2];
                DSR128(kf[0][0], ka, 0); DSR128(kf[0][1], ka, 32);
#define USTEP(t) if constexpr (NT > (t)) { constexpr int s_ = (t) & 1; \
                    if constexpr ((t) + 1 < NT) { DSR128(kf[s_ ^ 1][0], ka, 32 * RSTR * ((t) + 1)); DSR128(kf[s_ ^ 1][1], ka, 32 * RSTR * ((t) + 1) + 32); \
                        asm volatile("s_waitcnt lgkmcnt(2)" : "+v"(kf[s_][0]), "+v"(kf[s_][1])); } \
                    else asm volatile("s_waitcnt lgkmcnt(0)" : "+v"(kf[s_][0]), "+v"(kf[s_][1])); \
                    S[t] = __builtin_amdgcn_mfma_f32_32x32x16_bf16(__builtin_bit_cast(bf16x8, kf[s_][0]), vf[0], S[t], 0, 0, 0); \
                    S[t] = __builtin_amdgcn_mfma_f32_32x32x16_bf16(__builtin_bit_cast(bf16x8, kf[s_][1]), vf[1], S[t], 0, 0, 0); \
                    __builtin_amdgcn_sched_barrier(0); }
                USTEP(0) USTEP(1) USTEP(2) USTEP(3) USTEP(4) USTEP(5) USTEP(6) USTEP(7)
#undef USTEP
                f32x4 dd[2][4];
                asm volatile("s_nop 15\n\ts_nop 15" ::: "memory");
                DSR128(dd[0][0], da, 0); DSR128(dd[0][1], da, 16); DSR128(dd[0][2], da, 64); DSR128(dd[0][3], da, 80);
#define DSTEP(t) if constexpr (NT > (t)) { constexpr int s_ = (t) & 1; \
                    if constexpr ((t) + 1 < NT) { DSR128(dd[s_ ^ 1][0], da, 128 * ((t) + 1)); DSR128(dd[s_ ^ 1][1], da, 128 * ((t) + 1) + 16); DSR128(dd[s_ ^ 1][2], da, 128 * ((t) + 1) + 64); DSR128(dd[s_ ^ 1][3], da, 128 * ((t) + 1) + 80); \
                        asm volatile("s_waitcnt lgkmcnt(4)" : "+v"(dd[s_][0]), "+v"(dd[s_][1]), "+v"(dd[s_][2]), "+v"(dd[s_][3])); } \
                    else asm volatile("s_waitcnt lgkmcnt(0)" : "+v"(dd[s_][0]), "+v"(dd[s_][1]), "+v"(dd[s_][2]), "+v"(dd[s_][3])); \
                    _Pragma("unroll") for (int r = 0; r < 4; ++r) { S[t][r] = vmul_v(S[t][r], dd[s_][0][r]); S[t][4 + r] = vmul_v(S[t][4 + r], dd[s_][1][r]); S[t][8 + r] = vmul_v(S[t][8 + r], dd[s_][2][r]); S[t][12 + r] = vmul_v(S[t][12 + r], dd[s_][3][r]); } \
                    asm volatile("" : "+v"(S[t])); __builtin_amdgcn_sched_barrier(0); }
                DSTEP(0) DSTEP(1) DSTEP(2) DSTEP(3) DSTEP(4) DSTEP(5) DSTEP(6) DSTEP(7)
#undef DSTEP
            }
            constexpr int FLAG_LAG = 8;
            if (k >= 8 + FLAG_LAG && k < 135) {
                asm volatile("s_waitcnt vmcnt(24)" ::: "memory"); static_assert(FLAG_LAG * 3 == 24, "vmcnt literal");
                const int kp = k - FLAG_LAG; const int lcp = dir ? 263 - kp : kp - 8;
                if (lane == 0) __hip_atomic_store(flg + lcp * 4 + w, 1u, __ATOMIC_RELAXED, __HIP_MEMORY_SCOPE_AGENT);
            } else if (k == 135) {
                VM_WAIT();
                if (lane == 0) {
#pragma unroll
                    for (int q = 0; q <= FLAG_LAG; ++q) { const int kp = 135 - q; const int lcp = dir ? 263 - kp : kp - 8; __hip_atomic_store(flg + lcp * 4 + w, 1u, __ATOMIC_RELAXED, __HIP_MEMORY_SCOPE_AGENT); }
                }
            }
            if (IS_A && k >= 136 + PANEL_LAG) {
                const int kd = k - PANEL_LAG; const int lcd = dir ? 263 - kd : kd - 8;
                if ((lcd & 7) == (dir ? 0 : 7)) {
                    asm volatile("s_waitcnt vmcnt(12)" ::: "memory"); static_assert(PANEL_LAG * 3 == 12, "vmcnt literal");
                    if (lane == 0) __hip_atomic_fetch_add(pdone + (b * 32 + (lcd >> 3)) * 4, 1u, __ATOMIC_RELAXED, __HIP_MEMORY_SCOPE_AGENT);
                }
            }
            SBAR();
        }
        if (IS_A) { VM_WAIT(); if (lane == 0) __hip_atomic_fetch_add(pdone + (b * 32 + (dir ? 0 : 31)) * 4, 1u, __ATOMIC_RELAXED, __HIP_MEMORY_SCOPE_AGENT); }
    }
#undef STEP_CHUNK
}

__device__ __forceinline__ void phase7(const Params& p) {
    const int tid = threadIdx.x, wid = tid >> 6, lane = tid & 63;
    const float* sso = (const float*)(p.ws + WS_SSO);
    for (int m0 = 2 * (blockIdx.x * 8 + wid); m0 < M_LAT; m0 += 2 * gridDim.x * 8) {
        f32x4 ov[2][8]; float sv[2];
#pragma unroll
        for (int rr = 0; rr < 2; ++rr) { const int m = m0 + rr; sv[rr] = (lane < 32) ? sso[(size_t)m * 32 + lane] : 0.f;
            const f32x4* o4 = (const f32x4*)(p.out + (size_t)m * D) + lane;
#pragma unroll
            for (int j = 0; j < 8; ++j) ov[rr][j] = o4[64 * j]; }
#pragma unroll
        for (int rr = 0; rr < 2; ++rr) { const int m = m0 + rr;
            const float rstd = rsqrtf(wave_sum(sv[rr]) * (1.0f / D) + EPS);
            f32x4* o4 = (f32x4*)(p.out + (size_t)m * D) + lane;
#pragma unroll
            for (int j = 0; j < 8; ++j) { const f32x4 g = *(const f32x4*)(p.final_g + 4 * (lane + 64 * j)); o4[64 * j] = ov[rr][j] * rstd * g; } }
    }
}


#define XB_TMO      128
#define XB_XCNT(j)  (256  + 64 * (j))
#define XB_XSUB(j)  (1280 + 64 * (j))
#define XB_XGEN(j)  (2304 + 64 * (j))
#define XB_TOP      3328
#define XB_TOPGEN   3392
#define XCD_BAR_WORDS 3456
#define XB_SPIN_CAP (1u << 18)
__device__ __forceinline__ unsigned xb_ld(unsigned* p)              { return __hip_atomic_load(p, __ATOMIC_RELAXED, __HIP_MEMORY_SCOPE_AGENT); }
__device__ __forceinline__ unsigned xb_add(unsigned* p, unsigned v) { return __hip_atomic_fetch_add(p, v, __ATOMIC_RELAXED, __HIP_MEMORY_SCOPE_AGENT); }
__device__ __forceinline__ unsigned xb_xcc_id() { return (unsigned)__builtin_amdgcn_s_getreg((3 << 11) | 20) & 0xFu; }
#define XB_SPIN(cond, bar) do { unsigned _sp = 0; while (cond) { __builtin_amdgcn_s_sleep(1); \
    if ((++_sp & 255u) == 0u) { if (xb_ld(&(bar)[XB_TMO])) break; if (_sp > XB_SPIN_CAP) { atomicAdd(&(bar)[XB_TMO], 1u); break; } } } } while (0)
struct XcdBarrier { unsigned* bar; unsigned x; volatile LAS unsigned* st; };
__device__ __forceinline__ XcdBarrier xcd_barrier_post(unsigned* bar, volatile LAS unsigned* st) {
    XcdBarrier b; b.bar = bar; b.x = xb_xcc_id(); b.st = st;
    if (threadIdx.x == 0) (void)xb_add(&bar[XB_XCNT(b.x)], 1u);
    return b;
}
__device__ __forceinline__ void xcd_barrier_complete(unsigned* bar, unsigned x, unsigned& nloc, unsigned& nx) {
    const unsigned G = gridDim.x * gridDim.y * gridDim.z;
    unsigned sum, cnt, mine, sp = 0u;
    for (;;) {
        sum = 0u; cnt = 0u; mine = 0u;
#pragma unroll
        for (unsigned j = 0; j < 16; ++j) { const unsigned c = xb_ld(&bar[XB_XCNT(j)]); sum += c; cnt += (c > 0u) ? 1u : 0u; mine = (j == x) ? c : mine; }
        if (sum == G) break;
        __builtin_amdgcn_s_sleep(1);
        if ((++sp & 255u) == 0u) { if (xb_ld(&bar[XB_TMO])) break; if (sp > XB_SPIN_CAP) { atomicAdd(&bar[XB_TMO], 1u); break; } }
    }
    nloc = mine > 0u ? mine : 1u; nx = cnt > 0u ? cnt : 1u;
}
__device__ __forceinline__ void xcd_barrier(const XcdBarrier& b) {
    asm volatile("s_waitcnt vmcnt(0)" ::: "memory");
    __syncthreads();
    if (threadIdx.x == 0) {
        unsigned* bar = b.bar;
        __builtin_amdgcn_s_waitcnt(0);
        unsigned nloc = b.st[0], nx = b.st[1];
        if (nloc == 0u) { xcd_barrier_complete(bar, b.x, nloc, nx); b.st[0] = nloc; b.st[1] = nx; }
        const unsigned old = xb_add(&bar[XB_XSUB(b.x)], 1u);
        const unsigned gen = old / nloc;
        if (old + 1u == (gen + 1u) * nloc) {
            __builtin_amdgcn_fence(__ATOMIC_RELEASE, "agent");
            asm volatile("s_waitcnt vmcnt(0)" ::: "memory");
            const unsigned og = xb_add(&bar[XB_TOP], 1u);
            const unsigned tg = og / nx;
            if (og + 1u == (tg + 1u) * nx) xb_add(&bar[XB_TOPGEN], 1u);
            else XB_SPIN(xb_ld(&bar[XB_TOPGEN]) == tg, bar);
            __builtin_amdgcn_fence(__ATOMIC_ACQUIRE, "agent");
            xb_add(&bar[XB_XGEN(b.x)], 1u);
            asm volatile("s_waitcnt vmcnt(0)" ::: "memory");
        } else {
            XB_SPIN(xb_ld(&bar[XB_XGEN(b.x)]) == gen, bar);
            __builtin_amdgcn_fence(__ATOMIC_ACQUIRE, "agent");
            asm volatile("s_waitcnt vmcnt(0)" ::: "memory");
        }
    }
    __syncthreads();
}

__global__ void __launch_bounds__(512, 2) fwd_megakernel(Params p) {
    extern __shared__ __attribute__((aligned(16))) unsigned char lds_raw[];
    LAS unsigned char* lds = (LAS unsigned char*)lds_raw;
    volatile LAS unsigned* bst = (volatile LAS unsigned*)(lds + LDS_BYTES - 16);
    if (threadIdx.x < 4) bst[threadIdx.x] = 0u;
    __syncthreads();
    const XcdBarrier xbar = xcd_barrier_post((unsigned*)(p.ws + WS_BAR), bst);
    const int lo = p.ph_lo, hi = p.ph_hi;
    const int G = gridDim.x, c = blockIdx.x;
    unsigned char* ws = p.ws;
#ifdef ONLY_PHASE
#define IN(k) ((k) == ONLY_PHASE && lo <= (k) && (k) < hi)
#else
#define IN(k) (lo <= (k) && (k) < hi)
#endif
#define SEAM(k) do { if (IN(k) && IN((k) + 1)) xcd_barrier(xbar); } while (0)
#ifndef DUP_PHASE
#define DUP_PHASE -1
#endif
#define REP(k) for (int rep_ = 0; rep_ < ((k) == DUP_PHASE ? 2 : 1); ++rep_)
    if (IN(0)) REP(0) phase0(p, lds);
    SEAM(0);
    if (IN(1)) REP(1) phase1(p);
    SEAM(1);
    if (IN(2)) REP(2) { SchedScan S{G, c, (const char*)(ws + WS_H), (const char*)(ws + WS_WTS)}; EpiScan E{ws, p.lb_logits};
        pg8::gemm_phase<EpiScan, SchedScan, false, true, false>(lds, S, E); }
    SEAM(2);
    if (IN(3)) REP(3) phase2b(p, lds);
    SEAM(3);
    if (IN(4)) {
        EpiGate E{ws, (u16*)p.out, (u16*)p.out + (size_t)M_LAT * 2048, p.onorm_a, p.onorm_b, (const unsigned*)(ws + WS_PDONE)};
        if (c < 64) {
            scan_unit<128, true>(p, lds, c >> 5, (c >> 1) & 15, 0, c & 1, c >> 1);
            __syncthreads();
            SchedHelp S{128 + c, 0, (const char*)(ws + WS_H), (const char*)(ws + WS_WTG)};
            pg8::gemm_phase<EpiGate, SchedHelp, true, false, true>(lds, S, E);
        } else if (c < 128) { const int u = c - 64; scan_unit<256, false>(p, lds, u >> 5, (u >> 3) & 3, (u >> 1) & 3, u & 1, 32 + (u >> 1)); }
        else { SchedHelp S{c - 128, 4, (const char*)(ws + WS_H), (const char*)(ws + WS_WTG)};
            pg8::gemm_phase<EpiGate, SchedHelp, true, false, true>(lds, S, E); }
    }
    SEAM(4);
    if (IN(5)) { phase_wtp(p, lds);
        SchedTiles S{G, c, NAG_SCAN, 16 - NAG_SCAN, (const char*)(ws + WS_H), (const char*)(ws + WS_WTG)};
        EpiGate E{ws, (u16*)p.out, (u16*)p.out + (size_t)M_LAT * 2048, p.onorm_a, p.onorm_b, (const unsigned*)(ws + WS_PDONE)};
        pg8::gemm_phase<EpiGate, SchedTiles, true, false, true>(lds, S, E); }
    SEAM(5);
    if (IN(6)) { SchedY S{G, c, (const char*)p.out, (const char*)p.out + (size_t)M_LAT * 2048 * 2, (const char*)(ws + WS_WTP)}; EpiY2 E{ws};
        pg8::gemm_phase<EpiY2, SchedY, true, false, true>(lds, S, E); }
    SEAM(6);
    if (IN(7)) REP(7) { SchedStd S{G, c, 8, (const char*)(ws + WS_Y), (const char*)(ws + WS_WTP) + (size_t)2 * 2048 * 4096, 0u};
        EpiOut E{p.x, p.out, (const float*)(ws + WS_MOD), (float*)(ws + WS_SSO)};
        pg8::gemm_phase<EpiOut, SchedStd, true, false, false>(lds, S, E); }
    SEAM(7);
    if (IN(8)) phase7(p);
#undef IN
#undef SEAM
}

#ifndef N_LAUNCHES
#define N_LAUNCHES 1
#endif
constexpr int N_PHASES = 9;

extern "C" void kernel_launch(void* const* d_in, const int* in_sizes, int n_in, void* d_out, int out_size, void* d_ws, size_t ws_size, hipStream_t stream) {
    static int grid = 0;
    if (grid == 0) {
        if (n_in != 17 || out_size != M_LAT * D || ws_size < WS_END) { fprintf(stderr, "kernel_launch: unexpected sizes (n_in %d out %d ws %zu need %zu)\n", n_in, out_size, ws_size, (size_t)WS_END); grid = -1; return; }
        int dev = 0, cus = 0, per_cu = 0;
        hipGetDevice(&dev);
        hipDeviceGetAttribute(&cus, hipDeviceAttributeMultiprocessorCount, dev);
        hipFuncSetAttribute((const void*)fwd_megakernel, hipFuncAttributeMaxDynamicSharedMemorySize, LDS_BYTES);
        hipOccupancyMaxActiveBlocksPerMultiprocessor(&per_cu, (const void*)fwd_megakernel, 512, LDS_BYTES);
        if (per_cu < 1) { fprintf(stderr, "kernel_launch: occupancy query reports %d blocks per CU\n", per_cu); grid = -1; return; }
        grid = cus;
    }
    if (grid < 0) return;
    Params p{};
    p.x = (const float*)d_in[0]; p.c = (const float*)d_in[1]; p.ctx = (const float*)d_in[2]; p.c_ctx = (const float*)d_in[3];
    p.w_ada = (const float*)d_in[4]; p.b_ada = (const float*)d_in[5]; p.norm_g = (const float*)d_in[6]; p.w_in = (const float*)d_in[7];
    p.lb_logits = (const float*)d_in[8]; p.gk_w = (const float*)d_in[9]; p.gk_b = (const float*)d_in[10]; p.onorm_a = (const float*)d_in[11];
    p.onorm_b = (const float*)d_in[12]; p.w_pa = (const float*)d_in[13]; p.w_pb = (const float*)d_in[14]; p.w_out = (const float*)d_in[15]; p.final_g = (const float*)d_in[16];
    p.out = (float*)d_out; p.ws = (unsigned char*)d_ws;
    (void)hipMemsetAsync((char*)d_ws + WS_BAR, 0, 16384, stream);
    const int per = (N_PHASES + N_LAUNCHES - 1) / N_LAUNCHES;
    for (int li = 0; li < N_LAUNCHES; ++li) {
        p.ph_lo = li * per; p.ph_hi = (li + 1) * per < N_PHASES ? (li + 1) * per : N_PHASES;
        if (p.ph_lo >= N_PHASES) break;
        void* args[] = {&p};
        hipError_t e = hipLaunchCooperativeKernel((const void*)fwd_megakernel, dim3(grid), dim3(512), args, LDS_BYTES, stream);
        if (e != hipSuccess) { fprintf(stderr, "cooperative launch failed: %s (grid %d)\n", hipGetErrorString(e), grid); break; }
    }
}
```

```cpp
#include <hip/hip_runtime.h>
#include <cstdio>
#include <cstdint>

#define LAS __attribute__((address_space(3)))
typedef unsigned short u16;
typedef short bf16x8 __attribute__((ext_vector_type(8)));
typedef float f32x2 __attribute__((ext_vector_type(2)));
typedef float f32x4 __attribute__((ext_vector_type(4)));
typedef float f32x16 __attribute__((ext_vector_type(16)));
typedef unsigned u32x2 __attribute__((ext_vector_type(2)));
typedef unsigned u32x4 __attribute__((ext_vector_type(4)));
typedef __bf16 bf16x2_t __attribute__((ext_vector_type(2)));
typedef _Float16 f16x2_t __attribute__((ext_vector_type(2)));

constexpr int D = 2048, NB = 2, SEQ = 8192, LCTX = 256;
constexpr int M_LAT = NB * SEQ;
constexpr int M_ALL = M_LAT + NB * LCTX;
constexpr int N_IN = 20512;
constexpr int NCHUNK = M_ALL / 32;
constexpr float EPS = 1e-6f;
constexpr int NSCAN_ROWS = 12544;
constexpr int NGATE_ROWS = 8192;

constexpr size_t WS_PDONE = 1024;
constexpr size_t WS_BAR = 4096;
constexpr size_t WS_FLG = WS_BAR + 16384;
constexpr size_t WS_MOD = WS_FLG + 64 * 256 * 4 * 4;
constexpr size_t WS_SSO = WS_MOD + 3 * 6144 * 4;
constexpr size_t WS_SSA = WS_SSO + (size_t)M_LAT * 32 * 4;
constexpr size_t WS_SSB = WS_SSA + (size_t)M_LAT * 64 * 4;
constexpr size_t WS_WTG = WS_SSB + (size_t)M_LAT * 64 * 4;
constexpr size_t WS_H   = WS_WTG + (size_t)NGATE_ROWS * D * 2;
constexpr size_t WS_WTS = WS_H + (size_t)M_ALL * D * 2;
constexpr size_t WS_LFB = WS_WTS;
constexpr size_t WS_R   = WS_LFB + (size_t)2 * NCHUNK * 1024 * 32 * 2;
constexpr size_t WS_AQ  = WS_R + (size_t)NCHUNK * 32 * 32 * 4;
constexpr size_t WS_AV  = WS_AQ + (size_t)NCHUNK * 2048 * 32 * 2;
constexpr size_t WS_ALF = WS_AV + (size_t)NCHUNK * 2048 * 32 * 2;
constexpr size_t WS_BQ  = WS_ALF + (size_t)2 * NCHUNK * 2048 * 32 * 2;
constexpr size_t WS_BK  = WS_BQ + (size_t)NCHUNK * 1024 * 32 * 2;
constexpr size_t WS_BV  = WS_BK + (size_t)NCHUNK * 1024 * 32 * 2;
constexpr size_t WS_MGA = WS_BV + (size_t)NCHUNK * 2048 * 32 * 2;
constexpr size_t WS_END = WS_MGA + (size_t)M_LAT * 2048 * 2;
constexpr size_t WS_MGB = WS_AQ;
constexpr size_t WS_Y   = WS_ALF;
constexpr size_t WS_WTP = WS_ALF + (size_t)M_LAT * 2048 * 2;
static_assert(WS_WTS + (size_t)NSCAN_ROWS * D * 2 <= WS_R, "LFB overlay");
static_assert(WS_MGB + (size_t)M_LAT * 2048 * 2 <= WS_AV, "MGB overlay");
static_assert(WS_WTP + (size_t)3 * D * D * 2 <= WS_BQ, "WTP overlay");
static_assert(WS_END <= (size_t)672137216, "workspace");

constexpr int LDS_BYTES = 155648;

struct Params {
    const float *x, *c, *ctx, *c_ctx, *w_ada, *b_ada, *norm_g, *w_in, *lb_logits, *gk_w, *gk_b, *onorm_a, *onorm_b, *w_pa, *w_pb, *w_out, *final_g;
    float* out; unsigned char* ws;
    int ph_lo, ph_hi;
};

__device__ __forceinline__ unsigned pk_bf16(float lo, float hi) { f32x2 v = {lo, hi}; return __builtin_bit_cast(unsigned, __builtin_convertvector(v, bf16x2_t)); }
__device__ __forceinline__ unsigned pk_f16(float lo, float hi) { f32x2 v = {lo, hi}; return __builtin_bit_cast(unsigned, __builtin_convertvector(v, f16x2_t)); }
__device__ __forceinline__ float bf_lo(unsigned w) { return __uint_as_float(w << 16); }
__device__ __forceinline__ float bf_hi(unsigned w) { return __uint_as_float(w & 0xffff0000u); }
__device__ __forceinline__ float bf_sel(unsigned w, int hi) { return hi ? bf_hi(w) : bf_lo(w); }
__device__ __forceinline__ float h_sel(unsigned w, int hi) { return (float)__builtin_bit_cast(_Float16, (u16)(hi ? (w >> 16) : (w & 0xffffu))); }
__device__ __forceinline__ float sigmoidf_(float v) { return __builtin_amdgcn_rcpf(1.0f + __builtin_amdgcn_exp2f(v * -1.4426950408889634f)); }
__device__ __forceinline__ float wave_sum(float v) {
#pragma unroll
    for (int o = 1; o < 64; o <<= 1) v += __shfl_xor(v, o);
    return v;
}
#define LDS_WAIT() asm volatile("s_waitcnt lgkmcnt(0)" ::: "memory")
#define VM_WAIT() asm volatile("s_waitcnt vmcnt(0)" ::: "memory")

namespace pg8 {
constexpr int BM = 256, BK = 64, HALF = 128, HTB = HALF * BK * 2, STAGE_BYTES = 8 * HTB, KD = 2048, NT = KD / BK;
__device__ __forceinline__ int lds_byte(int r, int c) { const int st = (r >> 4) * 2 + (c >> 5), rr = r & 15, cc = c & 31, ob = rr * 64 + cc * 2; return st * 1024 + (ob ^ (((ob >> 9) & 1) << 5)); }
__device__ __forceinline__ void stage_rc(int b, int& R, int& C) { const int st = b / 1024, sb = b % 1024, swz = sb ^ (((sb >> 9) & 1) << 5); R = (st >> 1) * 16 + swz / 64; C = (st & 1) * 32 + (swz % 64) / 2; }
__device__ __forceinline__ int perm32(int rho) { const int n = rho >> 4, i = rho & 15; return 8 * (i >> 2) + 4 * n + (i & 3); }

struct Unit { const char* A; const char* B; unsigned mode; unsigned hstepA; unsigned kstepA; int pm, pn; };
__device__ __forceinline__ unsigned voffA_of(unsigned mode, int R, int C) {
    if (mode == 0u) return (unsigned)(R * KD + C) * 2u;
    if (mode == 1u) return (unsigned)(R * 64 * KD + C) * 2u;
    if (mode == 2u) return (unsigned)((((R >> 5) * 64 + (C >> 5)) * 1024) + (R & 31) * 32 + (C & 31)) * 2u;
    return (unsigned)((((R & 63) * 4 * 64 + (C >> 5)) * 1024) + (R >> 6) * 32 + (C & 31)) * 2u;
}

template <class Epi, class Sched, bool TRANS, bool PERM_A, bool PERM_B>
__device__ __forceinline__ void gemm_phase(LAS unsigned char* lds, const Sched& S, const Epi& E) {
    const int tid = threadIdx.x, wid = __builtin_amdgcn_readfirstlane(tid >> 6), lane = tid & 63, wr = wid >> 2, wc = wid & 3, fr = lane & 15, fq = lane >> 4;
    int RaA[2], CA[2]; unsigned voffB[2];
#pragma unroll
    for (int i = 0; i < 2; ++i) { int R, C; stage_rc(tid * 16 + i * 8192, R, C);
        RaA[i] = PERM_A ? ((R & ~31) + perm32(R & 31)) : R; CA[i] = C; const int Rb = PERM_B ? ((R & ~31) + perm32(R & 31)) : R;
        voffB[i] = (unsigned)(Rb * KD + C) * 2u; }
    constexpr size_t kstep = (size_t)(BK * 2);
    constexpr size_t hstepB = (size_t)HALF * KD * 2;
    const unsigned ldsw = (unsigned)wid * 1024u;
    const int aoff = lds_byte(wr * 64 + fr, fq * 8), boff = lds_byte(wc * 32 + fr, fq * 8);
#define PG8_SA(b, h) (((b) * 2 + (h)) * HTB)
#define PG8_SB(b, h) ((4 + (b) * 2 + (h)) * HTB)
#define PG8_STAGE(bufoff, gbase, voff) do { _Pragma("unroll") for (int _i = 0; _i < 2; ++_i) \
        __builtin_amdgcn_global_load_lds((const unsigned*)((const char*)(gbase) + (voff)[_i]), (LAS unsigned*)(lds + (bufoff) + ldsw + _i * 8192), 16, 0, 0); } while (0)
#define PG8_LDA(dst, b, h) do { _Pragma("unroll") for (int m = 0; m < 4; ++m) _Pragma("unroll") for (int k = 0; k < 2; ++k) dst[m][k] = *(const LAS bf16x8*)(lds + PG8_SA(b, h) + aoff + m * 2048 + k * 1024); } while (0)
#define PG8_LDB(dst, b, h) do { _Pragma("unroll") for (int n = 0; n < 2; ++n) _Pragma("unroll") for (int k = 0; k < 2; ++k) dst[n][k] = *(const LAS bf16x8*)(lds + PG8_SB(b, h) + boff + n * 2048 + k * 1024); } while (0)
#define PG8_MMA(ai, bj, At, Bt) do { __builtin_amdgcn_s_setprio(1); _Pragma("unroll") for (int m = 0; m < 4; ++m) _Pragma("unroll") for (int n = 0; n < 2; ++n) _Pragma("unroll") for (int k = 0; k < 2; ++k) \
        acc[ai][bj][m][n] = TRANS ? __builtin_amdgcn_mfma_f32_16x16x32_bf16(Bt[n][k], At[m][k], acc[ai][bj][m][n], 0, 0, 0) \
                                  : __builtin_amdgcn_mfma_f32_16x16x32_bf16(At[m][k], Bt[n][k], acc[ai][bj][m][n], 0, 0, 0); __builtin_amdgcn_s_setprio(0); } while (0)
#define PG8_WAIT_V(n) asm volatile("s_waitcnt vmcnt(" #n ")" ::: "memory")
#define PG8_WAIT_L(n) asm volatile("s_waitcnt lgkmcnt(" #n ")" ::: "memory")
#define PG8_BAR __builtin_amdgcn_s_barrier()
#define PG8_SCHED __builtin_amdgcn_sched_barrier(0)
    Unit cur, nxt; int ui = 0;
    if (!S.next(0, cur)) return;
    f32x4 acc[2][2][4][2];
#pragma unroll
    for (int a = 0; a < 2; ++a)
#pragma unroll
        for (int b = 0; b < 2; ++b)
#pragma unroll
            for (int m = 0; m < 4; ++m)
#pragma unroll
                for (int n = 0; n < 2; ++n) acc[a][b][m][n] = (f32x4){0.f, 0.f, 0.f, 0.f};
    bf16x8 At[4][2], B0[2][2], B1[2][2];
    const char* cA = cur.A; const char* cB = cur.B;
    unsigned vA[2] = {voffA_of(cur.mode, RaA[0], CA[0]), voffA_of(cur.mode, RaA[1], CA[1])};
    size_t hA = cur.hstepA, kA = cur.kstepA;
    PG8_STAGE(PG8_SB(0, 0), cB, voffB); PG8_STAGE(PG8_SA(0, 0), cA, vA); PG8_STAGE(PG8_SB(0, 1), cB + hstepB, voffB); PG8_STAGE(PG8_SA(0, 1), cA + hA, vA);
    if (wr == 1) PG8_BAR;
    PG8_WAIT_V(4); PG8_BAR;
    PG8_STAGE(PG8_SB(1, 0), cB + kstep, voffB); PG8_STAGE(PG8_SA(1, 0), cA + kA, vA); PG8_STAGE(PG8_SB(1, 1), cB + hstepB + kstep, voffB);
    PG8_WAIT_V(6); PG8_BAR;
    for (;;) {
        const bool has_next = S.next(ui + 1, nxt);
        const char* nA = has_next ? nxt.A : cA; const char* nB = has_next ? nxt.B : cB;
        unsigned vN[2]; size_t hN, kN;
        if (has_next) { vN[0] = voffA_of(nxt.mode, RaA[0], CA[0]); vN[1] = voffA_of(nxt.mode, RaA[1], CA[1]); hN = nxt.hstepA; kN = nxt.kstepA; } else { vN[0] = vA[0]; vN[1] = vA[1]; hN = hA; kN = kA; }
        for (int t = 0; t < NT; t += 2) {
            const bool last = (t == NT - 2);
            const char* a1 = cA + (size_t)(t + 1) * kA;
            const char* a2 = last ? nA : cA + (size_t)(t + 2) * kA; const char* b2 = last ? nB : cB + (size_t)(t + 2) * kstep;
            const char* a3 = a2 + (last ? kN : kA); const char* b3 = b2 + kstep;
            unsigned v2[2] = {last ? vN[0] : vA[0], last ? vN[1] : vA[1]}; const size_t h2 = last ? hN : hA;
            PG8_LDB(B0, 0, 0); PG8_SCHED; PG8_LDA(At, 0, 0); PG8_STAGE(PG8_SA(1, 1), a1 + hA, vA);
            PG8_WAIT_L(8); PG8_BAR; PG8_WAIT_L(0); PG8_MMA(0, 0, At, B0); PG8_BAR; PG8_SCHED;
            PG8_LDB(B1, 0, 1); PG8_STAGE(PG8_SB(0, 0), b2, voffB);
            PG8_BAR; PG8_WAIT_L(0); PG8_MMA(0, 1, At, B1); PG8_BAR;
            PG8_LDA(At, 0, 1); PG8_STAGE(PG8_SA(0, 0), a2, v2);
            PG8_BAR; PG8_WAIT_L(0); PG8_MMA(1, 0, At, B0); PG8_BAR; PG8_SCHED;
            PG8_STAGE(PG8_SB(0, 1), b2 + hstepB, voffB);
            PG8_WAIT_V(6); PG8_BAR; PG8_MMA(1, 1, At, B1); PG8_BAR;
            PG8_LDB(B0, 1, 0); PG8_SCHED; PG8_LDA(At, 1, 0); PG8_STAGE(PG8_SA(0, 1), a2 + h2, v2);
            PG8_WAIT_L(8); PG8_BAR; PG8_WAIT_L(0); PG8_MMA(0, 0, At, B0); PG8_BAR; PG8_SCHED;
            PG8_LDB(B1, 1, 1); PG8_STAGE(PG8_SB(1, 0), b3, voffB);
            PG8_BAR; PG8_WAIT_L(0); PG8_MMA(0, 1, At, B1); PG8_BAR;
            PG8_LDA(At, 1, 1); PG8_STAGE(PG8_SA(1, 0), a3, v2);
            PG8_BAR; PG8_WAIT_L(0); PG8_MMA(1, 0, At, B0); PG8_BAR; PG8_SCHED;
            PG8_STAGE(PG8_SB(1, 1), b3 + hstepB, voffB);
            PG8_WAIT_V(6); PG8_BAR; PG8_MMA(1, 1, At, B1); PG8_BAR;
        }
        E(acc, cur, wr, wc, fr, fq);
        if (!has_next) break;
#pragma unroll
        for (int a = 0; a < 2; ++a)
#pragma unroll
            for (int b = 0; b < 2; ++b)
#pragma unroll
                for (int m = 0; m < 4; ++m)
#pragma unroll
                    for (int n = 0; n < 2; ++n) acc[a][b][m][n] = (f32x4){0.f, 0.f, 0.f, 0.f};
        cur = nxt; cA = nA; cB = nB; vA[0] = vN[0]; vA[1] = vN[1]; hA = hN; kA = kN; ++ui;
    }
    PG8_WAIT_V(0);
    if (wr == 0) PG8_BAR;
    PG8_BAR;
#undef PG8_SA
#undef PG8_SB
#undef PG8_STAGE
#undef PG8_LDA
#undef PG8_LDB
#undef PG8_MMA
#undef PG8_WAIT_V
#undef PG8_WAIT_L
#undef PG8_BAR
#undef PG8_SCHED
}
}

typedef f32x4 AccT[2][2][4][2];

struct SchedScan {
    int G, c; const char* h; const char* wts;
    __device__ __forceinline__ bool next(int i, pg8::Unit& u) const {
        const int L = i * G + c;
        if (L >= 64 * 49 + 2 * 37) return false;
        int pm, pn;
        if (L < 64 * 49) { pm = L & 63; pn = L >> 6; }
        else { const int r = L - 64 * 49; pm = 64 + (r & 1); int q = r >> 1; pn = (q < 24) ? 8 + q : 36 + (q - 24); }
        u.pm = pm; u.pn = pn; u.B = wts + (size_t)pn * 256 * 4096;
        if (pn >= 32 && pm < 64) {
            const int b = pm >> 5, pp = pm & 31;
            u.A = h + (size_t)(b * 8192 + 2 * pp) * 4096; u.mode = 1u; u.hstepA = 4096u; u.kstepA = 128u;
        } else { u.A = h + (size_t)pm * 256 * 4096; u.mode = 0u; u.hstepA = 128u * 4096u; u.kstepA = 128u; }
        return true;
    }
};
struct SchedStd {
    int G, c, nN; const char* A; const char* B; unsigned mode;
    __device__ __forceinline__ bool next(int i, pg8::Unit& u) const {
        const int L = i * G + c;
        if (L >= 64 * nN) return false;
        u.pm = L & 63; u.pn = L >> 6; u.B = B + (size_t)u.pn * 256 * 4096; u.mode = mode;
        if (mode == 0u) { u.A = A + (size_t)u.pm * 256 * 4096; u.hstepA = 128u * 4096u; u.kstepA = 128u; }
        else if (mode == 2u) { u.A = A + (size_t)u.pm * 8 * 64 * 2048; u.hstepA = 4u * 64u * 2048u; u.kstepA = 4096u; }
        else { const int bb = u.pm >> 5, pp = u.pm & 31;
            u.A = A + ((size_t)(bb * 256 + (pp >> 3)) * 64 * 1024 + (size_t)(4 * (pp & 7)) * 32) * 2; u.hstepA = 2u * 32u * 2u; u.kstepA = 4096u; }
        return true;
    }
};

struct EpiScan {
    unsigned char* ws; const float* lbl;
    __device__ __forceinline__ void operator()(const AccT& acc, const pg8::Unit& u, int wr, int wc, int fr, int fq) const {
        const int pn = u.pn;
        int kind, pl, W; size_t base;
        if (pn < 8) { kind = 0; pl = pn; W = 2048; base = WS_AQ; }
        else if (pn < 16) { kind = 0; pl = pn - 8; W = 2048; base = WS_AV; }
        else if (pn < 24) { kind = 1; pl = pn - 16; W = 2048; base = WS_ALF; }
        else if (pn < 32) { kind = 2; pl = pn - 24; W = 2048; base = WS_ALF + (size_t)NCHUNK * 2048 * 32 * 2; }
        else if (pn < 36) { kind = 3; pl = pn - 32; W = 1024; base = WS_BQ; }
        else if (pn < 40) { kind = 0; pl = pn - 36; W = 1024; base = WS_BK; }
        else if (pn < 48) { kind = 0; pl = pn - 40; W = 2048; base = WS_BV; }
        else { kind = 4; pl = 0; W = 32; base = WS_R; }
#pragma unroll
        for (int bj = 0; bj < 2; ++bj)
#pragma unroll
            for (int n = 0; n < 2; ++n) {
                const int ch = pl * 256 + bj * 128 + wc * 32 + n * 16 + fr;
                float lb = 0.f;
                if (kind == 1 || kind == 2) { const int li = (kind == 2 ? 2048 : 0) + ch; lb = sigmoidf_(lbl[li] - lbl[4096 + li]); }
#pragma unroll
                for (int ai = 0; ai < 2; ++ai)
#pragma unroll
                    for (int q = 0; q < 2; ++q) {
                        const int chunk = u.pm * 8 + ai * 4 + wr * 2 + q;
                        f32x4 v0 = acc[ai][bj][2 * q][n], v1 = acc[ai][bj][2 * q + 1][n];
                        if (kind == 4) {
                            if (wc == 0 && bj == 0) { float* dst = (float*)(ws + base) + ((size_t)chunk * 32 + (n * 16 + fr)) * 32 + 8 * fq; *(f32x4*)dst = v0; *(f32x4*)(dst + 4) = v1; }
                        } else {
                            u32x4 w;
                            if (kind == 1 || kind == 2) {
                                float t[8] = {v0[0], v0[1], v0[2], v0[3], v1[0], v1[1], v1[2], v1[3]};
#pragma unroll
                                for (int e = 0; e < 8; ++e) t[e] = __log2f(lb + (1.0f - lb) * sigmoidf_(t[e]));
                                w.x = pk_f16(t[0], t[1]); w.y = pk_f16(t[2], t[3]); w.z = pk_f16(t[4], t[5]); w.w = pk_f16(t[6], t[7]);
                            } else {
                                if (kind == 3) { v0 = v0 * 0.0625f; v1 = v1 * 0.0625f; }
                                w.x = pk_bf16(v0[0], v0[1]); w.y = pk_bf16(v0[2], v0[3]); w.z = pk_bf16(v1[0], v1[1]); w.w = pk_bf16(v1[2], v1[3]);
                            }
                            const int chs = (pn >= 32 && pn < 40) ? ((ch & ~255) | ((ch & 1) << 7) | ((ch & 255) >> 1)) : ch;
                            u16* dst = (u16*)(ws + base) + (((size_t)chunk * 4 + fq) * W + chs) * 8;
                            *(u32x4*)dst = w;
                        }
                    }
            }
    }
};

struct EpiGate {
    unsigned char* ws; u16* OA; u16* OB; const float* gain_a; const float* gain_b; const unsigned* pdone;
    __device__ __forceinline__ void operator()(const AccT& acc, const pg8::Unit& u, int wr, int wc, int fr, int fq) const {
        const int pn = u.pn;
        const int row0 = u.pm * 256 + wr * 64 + fr;
        if (pn < 8 || pn >= 24) {
            unsigned spins = 0;
            while (__hip_atomic_load(pdone + u.pm * 4, __ATOMIC_RELAXED, __HIP_MEMORY_SCOPE_AGENT) < 64u) { __builtin_amdgcn_s_sleep(8); if (++spins > (1u << 22)) break; }
            __builtin_amdgcn_fence(__ATOMIC_ACQUIRE, "agent");
        }
        if (pn >= 16) {
            u16* MG = (u16*)(ws + (pn < 24 ? WS_MGA : WS_MGB));
            const int col0 = ((pn - 16) & 7) * 256 + wc * 32 + 8 * fq;
#pragma unroll
            for (int ai = 0; ai < 2; ++ai)
#pragma unroll
                for (int m = 0; m < 4; ++m) { u16* rowp = MG + (size_t)(row0 + ai * 128 + m * 16) * 2048 + col0;
#pragma unroll
                    for (int bj = 0; bj < 2; ++bj) { const f32x4 v0 = acc[ai][bj][m][0], v1 = acc[ai][bj][m][1]; u32x4 w;
                        w.x = pk_bf16(sigmoidf_(v0[0]), sigmoidf_(v0[1])); w.y = pk_bf16(sigmoidf_(v0[2]), sigmoidf_(v0[3]));
                        w.z = pk_bf16(sigmoidf_(v1[0]), sigmoidf_(v1[1])); w.w = pk_bf16(sigmoidf_(v1[2]), sigmoidf_(v1[3]));
                        *(u32x4*)(rowp + bj * 128) = w; } }
        } else {
            const bool isA = pn < 8; const int pl = isA ? pn : pn - 8;
            u16* O = isA ? OA : OB; const float* gain = isA ? gain_a : gain_b;
            const float* SS = (const float*)(ws + (isA ? WS_SSA : WS_SSB));
            const int col0 = pl * 256 + wc * 32 + 8 * fq;
            f32x4 g[2][2];
#pragma unroll
            for (int bj = 0; bj < 2; ++bj) { g[bj][0] = *(const f32x4*)(gain + col0 + bj * 128); g[bj][1] = *(const f32x4*)(gain + col0 + bj * 128 + 4); }
#pragma unroll
            for (int ai = 0; ai < 2; ++ai)
#pragma unroll
                for (int m = 0; m < 4; ++m) {
                    const int row = row0 + ai * 128 + m * 16;
                    float rstd[2];
                    if (isA) {
#pragma unroll
                        for (int bj = 0; bj < 2; ++bj) { const f32x4 s = *(const f32x4*)(SS + (size_t)row * 64 + (pl * 2 + bj) * 4); rstd[bj] = rsqrtf(((s[0] + s[1]) + (s[2] + s[3])) * (1.0f / 128.0f) + EPS); }
                    } else {
                        const float* sp = SS + (size_t)row * 64 + (pl >> 1) * 16; float t = 0.f;
#pragma unroll
                        for (int k = 0; k < 4; ++k) { const f32x4 s = *(const f32x4*)(sp + 4 * k); t += (s[0] + s[1]) + (s[2] + s[3]); }
                        rstd[0] = rstd[1] = rsqrtf(t * (1.0f / 512.0f) + EPS);
                    }
                    size_t tb;
                    if (isA) tb = ((size_t)(row >> 5) * 64) * 1024 + (size_t)(row & 31) * 32;
                    else { const int bb = row >> 13, t = row & 8191, ps = (t & 63) * 128 + (t >> 6); tb = ((size_t)(bb * 256 + (ps >> 5)) * 64) * 1024 + (size_t)(ps & 31) * 32; }
                    u16* rowp = O + tb + (size_t)(col0 >> 5) * 1024 + (col0 & 31);
#pragma unroll
                    for (int bj = 0; bj < 2; ++bj) {
                        const u32x4 ov = *(const u32x4*)(rowp + bj * 4 * 1024);
                        const f32x4 a0 = acc[ai][bj][m][0], a1 = acc[ai][bj][m][1];
                        float o[8] = {bf_lo(ov.x), bf_hi(ov.x), bf_lo(ov.y), bf_hi(ov.y), bf_lo(ov.z), bf_hi(ov.z), bf_lo(ov.w), bf_hi(ov.w)};
                        float gt[8] = {a0[0], a0[1], a0[2], a0[3], a1[0], a1[1], a1[2], a1[3]};
                        float gg[8] = {g[bj][0][0], g[bj][0][1], g[bj][0][2], g[bj][0][3], g[bj][1][0], g[bj][1][1], g[bj][1][2], g[bj][1][3]};
#pragma unroll
                        for (int e = 0; e < 8; ++e) o[e] = (o[e] * rstd[bj] * gg[e]) * (gt[e] * sigmoidf_(gt[e]));
                        u32x4 w; w.x = pk_bf16(o[0], o[1]); w.y = pk_bf16(o[2], o[3]); w.z = pk_bf16(o[4], o[5]); w.w = pk_bf16(o[6], o[7]);
                        *(u32x4*)(rowp + bj * 4 * 1024) = w;
                    }
                }
        }
    }
};
constexpr int NAG_SCAN = 8;
constexpr int NH_SHARED = 7;
struct SchedHelp {
    int id; int n_first; const char* A; const char* B;
    __device__ __forceinline__ bool next(int i, pg8::Unit& u) const {
        int pm, tile;
        if (i < n_first) { const int L = i * 128 + id; pm = L & 63; tile = 16 + (L >> 6); }
        else { int L;
            if (id < 128) { if (i - n_first >= NH_SHARED) return false; L = (i - n_first) * 128 + id; }
            else { L = 128 * NH_SHARED + i * 64 + (id - 128); if (L >= 1024) return false; }
            const int r = L >> 6, q = L & 63, ti = q >> 2, bb = q & 1, side = (q >> 1) & 1;
            pm = bb * 32 + (side ? 16 + r : 15 - r); tile = ti < 8 ? ti : 24 + (ti - 8); }
        u.pm = pm; u.pn = tile; u.A = A + (size_t)pm * 256 * 4096; u.B = B + (size_t)tile * 256 * 4096; u.mode = 0u; u.hstepA = 128u * 4096u; u.kstepA = 128u;
        return true;
    }
};
struct SchedTiles {
    int G, c, tile0, nT; const char* A; const char* B;
    __device__ __forceinline__ bool next(int i, pg8::Unit& u) const {
        const int L = i * G + c;
        if (L >= 64 * nT) return false;
        u.pm = L & 63; u.pn = tile0 + (L >> 6); u.A = A + (size_t)u.pm * 256 * 4096; u.B = B + (size_t)u.pn * 256 * 4096; u.mode = 0u; u.hstepA = 128u * 4096u; u.kstepA = 128u;
        return true;
    }
};

template <int SECOND> struct EpiY {
    unsigned char* ws;
    __device__ __forceinline__ void operator()(const AccT& acc, const pg8::Unit& u, int wr, int wc, int fr, int fq) const {
        const u16* MG = (const u16*)(ws + (SECOND ? WS_MGB : WS_MGA)); u16* Y = (u16*)(ws + WS_Y);
        const int row0 = u.pm * 256 + wr * 64 + fr, col0 = u.pn * 256 + wc * 32 + 8 * fq;
#pragma unroll
        for (int ai = 0; ai < 2; ++ai)
#pragma unroll
            for (int m = 0; m < 4; ++m) { const int row = row0 + ai * 128 + m * 16;
#pragma unroll
                for (int bj = 0; bj < 2; ++bj) {
                    const u32x4 mv = *(const u32x4*)(MG + (size_t)row * 2048 + col0 + bj * 128);
                    const f32x4 a0 = acc[ai][bj][m][0], a1 = acc[ai][bj][m][1];
                    float o[8] = {a0[0] * bf_lo(mv.x), a0[1] * bf_hi(mv.x), a0[2] * bf_lo(mv.y), a0[3] * bf_hi(mv.y), a1[0] * bf_lo(mv.z), a1[1] * bf_hi(mv.z), a1[2] * bf_lo(mv.w), a1[3] * bf_hi(mv.w)};
                    u16* yp = Y + (size_t)row * 2048 + col0 + bj * 128;
                    if (SECOND) { const u32x4 yv = *(const u32x4*)yp;
                        o[0] += bf_lo(yv.x); o[1] += bf_hi(yv.x); o[2] += bf_lo(yv.y); o[3] += bf_hi(yv.y); o[4] += bf_lo(yv.z); o[5] += bf_hi(yv.z); o[6] += bf_lo(yv.w); o[7] += bf_hi(yv.w); }
                    u32x4 w; w.x = pk_bf16(o[0], o[1]); w.y = pk_bf16(o[2], o[3]); w.z = pk_bf16(o[4], o[5]); w.w = pk_bf16(o[6], o[7]);
                    *(u32x4*)yp = w;
                } }
    }
};

struct SchedY {
    int G, c; const char* OA; const char* OB; const char* WP;
    __device__ __forceinline__ bool next(int i, pg8::Unit& u) const {
        const int L = (i >> 1) * G + c;
        if (L >= 512) return false;
        const int pm = L & 63, pn = L >> 6; u.pm = pm; u.kstepA = 4096u;
        if ((i & 1) == 0) { u.pn = pn | 0x100; u.mode = 2u; u.A = OA + (size_t)pm * 8 * 64 * 2048; u.hstepA = 4u * 64u * 2048u; u.B = WP + (size_t)pn * 256 * 4096; }
        else { u.pn = pn; u.mode = 3u; const int bb = pm >> 5, pp = pm & 31;
            u.A = OB + ((size_t)(bb * 256 + (pp >> 3)) * 64 * 1024 + (size_t)(4 * (pp & 7)) * 32) * 2; u.hstepA = 2u * 32u * 2u; u.B = WP + (size_t)2048 * 4096 + (size_t)pn * 256 * 4096; }
        return true;
    }
};
struct EpiY2 {
    unsigned char* ws;
    __device__ __forceinline__ void operator()(const AccT& acc, const pg8::Unit& u, int wr, int wc, int fr, int fq) const {
        pg8::Unit v = u; v.pn = u.pn & 0xff;
        if (u.pn & 0x100) { EpiY<0> e{ws}; e(acc, v, wr, wc, fr, fq); } else { EpiY<1> e{ws}; e(acc, v, wr, wc, fr, fq); }
    }
};

struct EpiOut {
    const float* x; float* out; const float* mod; float* sso;
    __device__ __forceinline__ void operator()(const AccT& acc, const pg8::Unit& u, int wr, int wc, int fr, int fq) const {
        const int row0 = u.pm * 256 + wr * 64 + fr, col0 = u.pn * 256 + wc * 32 + 4 * fq;
        const float* gate = mod + (size_t)(u.pm >> 5) * 6144 + 4096;
        f32x4 gv[2][2];
#pragma unroll
        for (int bj = 0; bj < 2; ++bj)
#pragma unroll
            for (int n = 0; n < 2; ++n) gv[bj][n] = *(const f32x4*)(gate + col0 + bj * 128 + n * 16);
#pragma unroll
        for (int ai = 0; ai < 2; ++ai)
#pragma unroll
            for (int mh = 0; mh < 2; ++mh) {
                f32x4 xv[2][2][2];
#pragma unroll
                for (int mm = 0; mm < 2; ++mm) { const size_t off = (size_t)(row0 + ai * 128 + (2 * mh + mm) * 16) * 2048 + col0;
#pragma unroll
                    for (int bj = 0; bj < 2; ++bj)
#pragma unroll
                        for (int n = 0; n < 2; ++n) xv[mm][bj][n] = *(const f32x4*)(x + off + bj * 128 + n * 16); }
#pragma unroll
                for (int mm = 0; mm < 2; ++mm) { const int m = 2 * mh + mm; const int row = row0 + ai * 128 + m * 16; const size_t off = (size_t)row * 2048 + col0; float s = 0.f;
#pragma unroll
                    for (int bj = 0; bj < 2; ++bj)
#pragma unroll
                        for (int n = 0; n < 2; ++n) { const f32x4 o = xv[mm][bj][n] + gv[bj][n] * acc[ai][bj][m][n];
                            *(f32x4*)(out + off + bj * 128 + n * 16) = o; s += (o[0] * o[0] + o[1] * o[1]) + (o[2] * o[2] + o[3] * o[3]); }
                    s += __shfl_xor(s, 16); s += __shfl_xor(s, 32);
                    if (fq == 0) sso[(size_t)row * 32 + u.pn * 4 + wc] = s; }
            }
    }
};

__device__ __forceinline__ void transpose_item(const float* W, int N, int n0, int k0, u16* WTrow0, LAS float* scr, int lane) {
    float tv[32];
#pragma unroll
    for (int i = 0; i < 32; ++i) tv[i] = W[(size_t)(k0 + 2 * i + (lane >> 5)) * N + n0 + (lane & 31)];
#pragma unroll
    for (int i = 0; i < 32; ++i) scr[(2 * i + (lane >> 5)) * 33 + (lane & 31)] = tv[i];
    LDS_WAIT(); asm volatile("" ::: "memory");
    const int c = lane & 7;
#pragma unroll
    for (int j = 0; j < 4; ++j) { const int n = (lane >> 3) + 8 * j; const LAS float* s = scr + (8 * c) * 33 + n;
        u32x4 o; o.x = pk_bf16(s[0 * 33], s[1 * 33]); o.y = pk_bf16(s[2 * 33], s[3 * 33]); o.z = pk_bf16(s[4 * 33], s[5 * 33]); o.w = pk_bf16(s[6 * 33], s[7 * 33]);
        *(u32x4*)(WTrow0 + (size_t)n * 2048 + k0 + 8 * c) = o; }
    LDS_WAIT(); asm volatile("" ::: "memory");
}

__device__ __forceinline__ void phase0(const Params& p, LAS unsigned char* lds) {
    const int tid = threadIdx.x, wid = tid >> 6, lane = tid & 63;
    unsigned char* ws = p.ws;
    if (blockIdx.x < 192) {
        LAS float* sl = (LAS float*)lds;
        LAS float* red = (LAS float*)lds + 6144;
        for (int i = tid; i < 3 * 2048; i += 512) { const int v = i >> 11, d = i & 2047; const float cv = (v < 2) ? p.c[v * 2048 + d] : p.c_ctx[d]; sl[i] = cv * sigmoidf_(cv); }
        __syncthreads();
        const int cg4 = tid & 7, kl = tid >> 3;
        const int col = blockIdx.x * 32 + cg4 * 4;
        f32x4 a0 = {0, 0, 0, 0}, a1 = {0, 0, 0, 0}, a2 = {0, 0, 0, 0};
#pragma unroll 8
        for (int k = kl; k < 2048; k += 64) { const f32x4 w = *(const f32x4*)(p.w_ada + (size_t)k * 6144 + col); a0 += sl[k] * w; a1 += sl[2048 + k] * w; a2 += sl[4096 + k] * w; }
        LAS float* rp = red + tid * 12;
#pragma unroll
        for (int e = 0; e < 4; ++e) { rp[e] = a0[e]; rp[4 + e] = a1[e]; rp[8 + e] = a2[e]; }
        __syncthreads();
        if (tid < 96) { const int v = tid >> 5, cc = tid & 31, g4 = cc >> 2, e = cc & 3; float s = 0.f;
            for (int k = 0; k < 64; ++k) s += red[(k * 8 + g4) * 12 + v * 4 + e];
            ((float*)(ws + WS_MOD))[v * 6144 + blockIdx.x * 32 + cc] = s + p.b_ada[blockIdx.x * 32 + cc]; }
        __syncthreads();
    }
    LAS float* scr = (LAS float*)(lds + 65536 + wid * 8448);
    const int gw = blockIdx.x * 8 + wid, NGW = gridDim.x * 8;
    constexpr int I_IN = 32 * 641;
    u16* WTS = (u16*)(ws + WS_WTS); u16* WTG = (u16*)(ws + WS_WTG);
    for (int it = gw; it < I_IN; it += NGW) {
        const int kb = it / 641, cb = it - kb * 641, n0 = cb * 32;
        u16* dst;
        if (n0 < 8192) dst = WTS + (size_t)n0 * 2048;
        else if (n0 < 10240) dst = WTG + (size_t)(n0 - 8192) * 2048;
        else if (n0 < 14336) dst = WTS + (size_t)(8192 + n0 - 10240) * 2048;
        else if (n0 == 14336) dst = WTS + (size_t)12288 * 2048;
        else if (n0 < 16416) dst = WTG + (size_t)(2048 + n0 - 14368) * 2048;
        else dst = WTG + (size_t)(4096 + n0 - 16416) * 2048;
        transpose_item(p.w_in, N_IN, n0, kb * 64, dst, scr, lane);
    }
    { u32x4* z = (u32x4*)(WTS + (size_t)12320 * 2048); const int nz = 224 * 2048 * 2 / 16;
      for (int i = blockIdx.x * 512 + tid; i < nz; i += gridDim.x * 512) z[i] = (u32x4){0u, 0u, 0u, 0u}; }
}

__device__ __forceinline__ void phase_wtp(const Params& p, LAS unsigned char* lds, int part, int nparts) {
    const int tid = threadIdx.x, wid = tid >> 6, lane = tid & 63;
    LAS float* scr = (LAS float*)(lds + wid * 8448);
    const int gw = part * 8 + wid, NGW = nparts * 8;
    u16* WTP = (u16*)(p.ws + WS_WTP);
    for (int it = gw; it < 3 * 2048; it += NGW) {
        const int which = it >> 11, r = it & 2047;
        const float* W = which == 0 ? p.w_pa : (which == 1 ? p.w_pb : p.w_out);
        const int kb = r >> 6, cb = r & 63;
        transpose_item(W, 2048, cb * 32, kb * 64, WTP + (size_t)which * 2048 * 2048 + (size_t)(cb * 32) * 2048, scr, lane);
    }
    __syncthreads();
}

__device__ __forceinline__ void phase1(const Params& p) {
    const int tid = threadIdx.x, wid = tid >> 6, lane = tid & 63;
    const float* mod = (const float*)(p.ws + WS_MOD);
    u16* H = (u16*)(p.ws + WS_H);
    for (int i = blockIdx.x * 512 + tid; i < 64 * 256 * 4; i += gridDim.x * 512) ((unsigned*)(p.ws + WS_FLG))[i] = 0u;
    if (blockIdx.x == 0 && tid < 64) ((unsigned*)(p.ws + WS_PDONE))[tid * 4] = 0u;
    if (blockIdx.x == 0 && tid == 64) *(unsigned*)(p.ws + 256) = 0u;
    for (int m0 = 2 * (blockIdx.x * 8 + wid); m0 < M_ALL; m0 += 2 * gridDim.x * 8) {
        f32x4 xv[2][8]; float ss[2] = {0.f, 0.f};
#pragma unroll
        for (int rr = 0; rr < 2; ++rr) { const int m = m0 + rr;
            const float* src = (m < M_LAT) ? p.x + (size_t)m * D : p.ctx + (size_t)(m - M_LAT) * D;
            const f32x4* s4 = (const f32x4*)src + lane;
#pragma unroll
            for (int j = 0; j < 8; ++j) xv[rr][j] = s4[64 * j]; }
#pragma unroll
        for (int rr = 0; rr < 2; ++rr)
#pragma unroll
            for (int j = 0; j < 8; ++j) ss[rr] += (xv[rr][j][0] * xv[rr][j][0] + xv[rr][j][1] * xv[rr][j][1]) + (xv[rr][j][2] * xv[rr][j][2] + xv[rr][j][3] * xv[rr][j][3]);
#pragma unroll
        for (int rr = 0; rr < 2; ++rr) { const int m = m0 + rr;
            const int v = (m < M_LAT) ? (m >> 13) : 2;
            const float rstd = rsqrtf(wave_sum(ss[rr]) * (1.0f / D) + EPS);
            u32x2* o8 = (u32x2*)(H + (size_t)m * D) + lane;
#pragma unroll
            for (int j = 0; j < 8; ++j) { const int col = 4 * (lane + 64 * j);
                const f32x4 g = *(const f32x4*)(p.norm_g + col), sh = *(const f32x4*)(mod + v * 6144 + col), sc = *(const f32x4*)(mod + v * 6144 + 2048 + col);
                const f32x4 y = (xv[rr][j] * rstd * g) * (sc + 1.0f) + sh;
                o8[64 * j] = (u32x2){pk_bf16(y[0], y[1]), pk_bf16(y[2], y[3])}; } }
    }
}

__device__ __forceinline__ void phase2b(const Params& p, LAS unsigned char* lds) {
    const int tid = threadIdx.x;
    const float* R = (const float*)(p.ws + WS_R);
    u16* LFB = (u16*)(p.ws + WS_LFB);
    LAS float* rs = (LAS float*)lds;
    float w[2][2][16], bias[2][2];
#pragma unroll
    for (int d = 0; d < 2; ++d)
#pragma unroll
        for (int cc = 0; cc < 2; ++cc) { bias[d][cc] = p.gk_b[d * 1024 + cc * 512 + tid];
#pragma unroll
            for (int r = 0; r < 16; ++r) w[d][cc][r] = p.gk_w[(size_t)(d * 16 + r) * 1024 + cc * 512 + tid]; }
    int buf = 0;
    for (int chunk = blockIdx.x; chunk < NCHUNK; chunk += gridDim.x, buf ^= 1) {
        LAS float* rb = rs + buf * 1024;
        { const f32x2 v = *(const f32x2*)(R + (size_t)chunk * 1024 + 2 * tid); *(LAS f32x2*)(rb + 2 * tid) = v; }
        __syncthreads();
#pragma unroll
        for (int d = 0; d < 2; ++d)
        {
            float run[2] = {0.f, 0.f};
#pragma unroll 1
            for (int t8i = 0; t8i < 4; ++t8i) {
                const int t8 = d ? 3 - t8i : t8i;
                float z[2][8];
#pragma unroll
                for (int cc = 0; cc < 2; ++cc)
#pragma unroll
                    for (int e = 0; e < 8; ++e) z[cc][e] = bias[d][cc];
#pragma unroll
                for (int r = 0; r < 16; ++r) {
                    LAS float* ra = rb + (d * 16 + r) * 32 + t8 * 8; asm volatile("" : "+v"(ra));
                    const f32x4 r0 = *(const LAS f32x4*)ra, r1 = *(const LAS f32x4*)(ra + 4);
#pragma unroll
                    for (int cc = 0; cc < 2; ++cc) { const float ww = w[d][cc][r];
#pragma unroll
                        for (int e = 0; e < 4; ++e) { z[cc][e] = __builtin_fmaf(r0[e], ww, z[cc][e]); z[cc][4 + e] = __builtin_fmaf(r1[e], ww, z[cc][4 + e]); } }
                }
#pragma unroll
                for (int cc = 0; cc < 2; ++cc) {
                    float zz[8];
#pragma unroll
                    for (int e = 0; e < 8; ++e) zz[e] = z[cc][e];
#pragma unroll
                    for (int e = 0; e < 8; ++e) { const float a = fabsf(zz[e]); zz[e] = (fminf(zz[e], 0.f) - __logf(1.0f + __expf(-a))) * (0.0625f * 1.4426950408889634f); }
#pragma unroll
                    for (int e_ = 0; e_ < 8; ++e_) { const int e = d ? 7 - e_ : e_; run[cc] += zz[e]; zz[e] = run[cc]; }
                    u32x4 o; o.x = pk_f16(zz[0], zz[1]); o.y = pk_f16(zz[2], zz[3]); o.z = pk_f16(zz[4], zz[5]); o.w = pk_f16(zz[6], zz[7]);
                    const int ch = cc * 512 + tid, chs = (ch & ~255) | ((ch & 1) << 7) | ((ch & 255) >> 1);
                    *(u32x4*)(LFB + ((((size_t)d * NCHUNK + chunk) * 4 + t8) * 1024 + chs) * 8) = o;
                }
            }
        }
    }
    __syncthreads();
}

__device__ __forceinline__ bf16x8 pack8(const f32x16& x, int s) {
    u32x4 pk; pk.x = pk_bf16(x[8 * s + 0], x[8 * s + 1]); pk.y = pk_bf16(x[8 * s + 2], x[8 * s + 3]); pk.z = pk_bf16(x[8 * s + 4], x[8 * s + 5]); pk.w = pk_bf16(x[8 * s + 6], x[8 * s + 7]);
    return __builtin_bit_cast(bf16x8, pk);
}
__device__ __forceinline__ unsigned rot16(unsigned x) { return (x >> 16) | (x << 16); }
template <int NW> __device__ __forceinline__ void maybe_rev(unsigned (&w)[NW], bool rev) {
    unsigned r[NW];
#pragma unroll
    for (int k = 0; k < NW; ++k) r[k] = rot16(w[NW - 1 - k]);
#pragma unroll
    for (int k = 0; k < NW; ++k) w[k] = rev ? r[k] : w[k];
}
__device__ __forceinline__ void ld16(unsigned (&w)[8], const u16* p) { const u32x4 a = *(const u32x4*)p, b = *(const u32x4*)(p + 8); w[0] = a.x; w[1] = a.y; w[2] = a.z; w[3] = a.w; w[4] = b.x; w[5] = b.y; w[6] = b.z; w[7] = b.w; }
__device__ __forceinline__ void ld16q(unsigned (&w)[8], const u16* p, size_t qstride) { const u32x4 a = *(const u32x4*)p, b = *(const u32x4*)(p + qstride); w[0] = a.x; w[1] = a.y; w[2] = a.z; w[3] = a.w; w[4] = b.x; w[5] = b.y; w[6] = b.z; w[7] = b.w; }
__device__ __forceinline__ void ld32(unsigned (&w)[16], const u16* p) {
#pragma unroll
    for (int k = 0; k < 4; ++k) { const u32x4 a = *(const u32x4*)(p + 8 * k); w[4 * k] = a.x; w[4 * k + 1] = a.y; w[4 * k + 2] = a.z; w[4 * k + 3] = a.w; }
}

#define DSR128(dst, addr, off) asm volatile("ds_read_b128 %0, %1 offset:%2" : "=v"(dst) : "v"(addr), "i"(off))
#define SBAR() do { asm volatile("s_waitcnt lgkmcnt(0)" ::: "memory"); __builtin_amdgcn_s_barrier(); asm volatile("" ::: "memory"); } while (0)
__device__ __forceinline__ f32x2 h2_sel(unsigned w0, unsigned w1, int hi) { return (f32x2){h_sel(w0, hi), h_sel(w1, hi)}; }
__device__ __forceinline__ f32x2 bf2_sel(unsigned w0, unsigned w1, int hi) { return (f32x2){bf_sel(w0, hi), bf_sel(w1, hi)}; }
#define GLD128(dst, ptr) asm volatile("global_load_dwordx4 %0, %1, off" : "=v"(dst) : "v"(ptr) : "memory")
#define GLD128_SC1(dst, ptr, off) asm volatile("global_load_dwordx4 %0, %1, off offset:%2 sc1" : "=v"(dst) : "v"(ptr), "i"(off) : "memory")
__device__ __forceinline__ unsigned wsel(const u32x4 (&v)[2], int w) { return v[w >> 2][w & 3]; }
__device__ __forceinline__ float vmul(float a, float b) { float r; asm("v_mul_f32_e32 %0, %1, %2" : "=v"(r) : "v"(a), "v"(b)); return r; }
__device__ __forceinline__ float vmul_v(float a, float b) { float r; asm volatile("v_mul_f32_e32 %0, %1, %2" : "=v"(r) : "v"(a), "v"(b)); return r; }
#define VEXP(dst, src) asm volatile("v_exp_f32_e32 %0, %1" : "=v"(dst) : "v"(src))
#define VEXPN(dst, src) asm volatile("v_exp_f32_e64 %0, -%1" : "=v"(dst) : "v"(src))
__device__ __forceinline__ float vmul_t(float a, float b) { float r; asm("s_nop 1\n\tv_mul_f32_e32 %0, %1, %2" : "=v"(r) : "v"(a), "v"(b)); return r; }
template <int DK, bool IS_A, int DIRC>
__device__ __forceinline__ void producer_loop(const Params& p, LAS unsigned char* lds, int b, int hh, int quarter, int pair, int pw, int ptid, int lane) {
    constexpr int QSTR = DK * 2 + 16, RSTR = 80;
    constexpr int OFF_KS = 32 * QSTR, OFF_KST = 2 * 32 * QSTR, OFF_VT = OFF_KST + DK * RSTR, OFF_DD = OFF_VT + 128 * RSTR, OFF_PD = OFF_DD + DK * 4, BUFB = OFF_PD + 4 * 32 * RSTR;
    constexpr int dir = DIRC;
    constexpr int NS = IS_A ? 6 : 14;
    const int h = lane >> 5, l31 = lane & 31;
    unsigned char* ws = p.ws;
    const u16* Qg = (const u16*)(ws + (IS_A ? WS_AQ : WS_BQ));
    const u16* Kg = (const u16*)(ws + WS_BK);
    const u16* Vg = (const u16*)(ws + (IS_A ? WS_AV : WS_BV));
    const u16* LFg = IS_A ? (const u16*)(ws + WS_ALF) + (size_t)dir * NCHUNK * 2048 * 32 : (const u16*)(ws + WS_LFB) + (size_t)dir * NCHUNK * 1024 * 32;
    unsigned* flg = (unsigned*)(ws + WS_FLG) + pair * 1024;
    const u16* Ogc = (const u16*)p.out + (IS_A ? 0 : (size_t)M_LAT * 2048);
    (void)ptid; (void)Kg;
#define STEP_CHUNK(k, is_ctx_, lc_, cidx_) const bool is_ctx_ = (k) < 8; const int lc_ = is_ctx_ ? (dir ? 7 - (k) : (k)) : (dir ? 263 - (k) : (k) - 8); const int cidx_ = is_ctx_ ? 512 + b * 8 + lc_ : b * 256 + lc_;
#define PD_LOADS(kq_, PD4) do { \
        STEP_CHUNK(kq_, icf, lcf, cidxf); (void)icf; (void)cidxf; \
        const u16* src = Ogc + ((size_t)(b * 256 + lcf) * 64 + (IS_A ? hh * 4 : hh * 16 + quarter * 4) + pw) * 1024 + lane * 8; \
        GLD128_SC1(PD4[0], src, 0); GLD128_SC1(PD4[1], src, 1024); \
    } while (0)
#define PD_ISSUE(kk, PD4) do { const int kq2_ = ((kk) >= 136 && (kk) < 264) ? (kk) : 136; PD_LOADS(kq2_, PD4); } while (0)
#define PD_FIRST(kk, PD4) do { if ((kk) == 136) { \
        STEP_CHUNK(136, icg, lcg, cidxg); (void)icg; (void)cidxg; unsigned spins = 0; \
        while (__hip_atomic_load(flg + lcg * 4 + pw, __ATOMIC_RELAXED, __HIP_MEMORY_SCOPE_AGENT) == 0u) { __builtin_amdgcn_s_sleep(2); if (++spins > (1u << 22)) break; } \
        PD_LOADS(136, PD4); \
        asm volatile("s_waitcnt vmcnt(0)" : "+v"(PD4[0]), "+v"(PD4[1])); } } while (0)
#define PD_STORE(PD4) do { _Pragma("unroll") for (int j_ = 0; j_ < 2; ++j_) *(LAS u32x4*)(buf + OFF_PD + (pw * 32 + 16 * j_ + (lane >> 2)) * RSTR + (lane & 3) * 16) = PD4[j_]; } while (0)
#define BUF_PTRS(kk) LAS unsigned char* buf = lds + ((kk) & 1) * BUFB; LAS unsigned char* QS = buf; LAS unsigned char* KS = buf + OFF_KS; LAS unsigned char* KST = buf + OFF_KST; LAS unsigned char* VT = buf + OFF_VT; LAS float* DD = (LAS float*)(buf + OFF_DD);
#define WAITV(n, ...) asm volatile("s_waitcnt vmcnt(" #n ")" : __VA_ARGS__)
    if (IS_A) {
        const int c = 32 * pw + l31, th = h;
#define LOAD_A(LF, QW, VW, kk) do { const int kl_ = (kk) < 264 ? (kk) : 263; STEP_CHUNK(kl_, ic, lc, cidx); (void)lc; (void)ic; \
            const size_t eo = (((size_t)cidx * 4 + 2 * th) * 2048 + hh * 128 + c) * 8; \
            GLD128(LF[0], LFg + eo); GLD128(LF[1], LFg + eo + 2048 * 8); GLD128(QW[0], Qg + eo); GLD128(QW[1], Qg + eo + 2048 * 8); GLD128(VW[0], Vg + eo); GLD128(VW[1], Vg + eo + 2048 * 8); } while (0)
#define PROC_A(LF, QW, VW, kk, PC, PN) do { \
            BUF_PTRS(kk) \
            PD_FIRST(kk, PC); \
            PD_ISSUE((kk) + 1, PN); \
            asm volatile("s_waitcnt vmcnt(10)" : "+v"(LF[0]), "+v"(LF[1]), "+v"(QW[0]), "+v"(QW[1]), "+v"(VW[0]), "+v"(VW[1]));     \
            float E[16], kk_[16]; float run = 1.f; \
            _Pragma("unroll") for (int it_ = 0; it_ < 16; ++it_) { const int it = dir ? 15 - it_ : it_; const float f = __builtin_amdgcn_exp2f(h_sel(wsel(LF, it >> 1), it & 1)); run = vmul_t(run, f); E[it] = run; kk_[it] = 1.0f - f; } \
            const float other = __shfl_xor(run, 32); \
            const float pre = (dir ? (th == 0) : (th == 1)) ? other : 1.0f; \
            unsigned kst[8]; \
            _Pragma("unroll") for (int it = 0; it < 16; it += 2) { \
                float ks2[2]; \
                _Pragma("unroll") for (int e = 0; e < 2; ++e) { const int i2 = it + e; const float ev = vmul(E[i2], pre); const float qs = vmul(bf_sel(wsel(QW, i2 >> 1), i2 & 1), ev); ks2[e] = vmul_t(kk_[i2], __builtin_amdgcn_rcpf(fmaxf(ev, 1e-30f))); \
                    const int i = 16 * th + i2; \
                    *(LAS u16*)(QS + i * QSTR + c * 2) = (u16)(pk_bf16(qs, 0.f) & 0xffffu); \
                    *(LAS u16*)(KS + i * QSTR + c * 2) = (u16)(pk_bf16(ks2[e], 0.f) & 0xffffu); } \
                kst[it >> 1] = pk_bf16(ks2[0], ks2[1]); \
            } \
            if (dir ? (th == 0) : (th == 1)) DD[c] = vmul(dir ? E[0] : E[15], pre); \
            *(LAS u32x4*)(KST + c * RSTR + th * 32) = (u32x4){kst[0], kst[1], kst[2], kst[3]}; \
            *(LAS u32x4*)(KST + c * RSTR + th * 32 + 16) = (u32x4){kst[4], kst[5], kst[6], kst[7]}; \
            *(LAS u32x4*)(VT + c * RSTR + th * 32) = VW[0]; \
            *(LAS u32x4*)(VT + c * RSTR + th * 32 + 16) = VW[1]; \
            asm volatile("s_waitcnt vmcnt(8)" : "+v"(PC[0]), "+v"(PC[1]));     \
            PD_STORE(PC); \
        } while (0)
        static_assert(NS == 6 || !IS_A, "wait counts");
        u32x4 lf0[2], q0_[2], v0_[2], lf1[2], q1_[2], v1_[2]; u32x4 pe[2], po[2];
        LOAD_A(lf0, q0_, v0_, 0); PD_ISSUE(0, pe); LOAD_A(lf1, q1_, v1_, 1);
#pragma unroll 1
        for (int k = 0; k < 264; k += 2) {
            PROC_A(lf0, q0_, v0_, k, pe, po); LOAD_A(lf0, q0_, v0_, k + 2); SBAR();
            PROC_A(lf1, q1_, v1_, k + 1, po, pe); LOAD_A(lf1, q1_, v1_, k + 3); SBAR();
        }
        asm volatile("s_waitcnt vmcnt(0)" ::: "memory");
#undef LOAD_A
#undef PROC_A
    } else {
        const int cp = 32 * pw + l31, th = h;
        const int col = ptid & 127, thv = ptid >> 7;
#define LOAD_B(LF, QW, KW, VW, kk) do { const int kl_ = (kk) < 264 ? (kk) : 263; STEP_CHUNK(kl_, ic, lc, cidx); (void)lc; (void)ic; \
            const size_t eo = (((size_t)cidx * 4 + 2 * th) * 1024 + hh * 256 + cp) * 8; const size_t evv = (((size_t)cidx * 4 + 2 * thv) * 2048 + hh * 512 + quarter * 128 + col) * 8; \
            GLD128(LF[0][0], LFg + eo); GLD128(LF[0][1], LFg + eo + 1024 * 8); GLD128(LF[1][0], LFg + eo + 128 * 8); GLD128(LF[1][1], LFg + eo + 128 * 8 + 1024 * 8); \
            GLD128(KW[0][0], Kg + eo); GLD128(KW[0][1], Kg + eo + 1024 * 8); GLD128(KW[1][0], Kg + eo + 128 * 8); GLD128(KW[1][1], Kg + eo + 128 * 8 + 1024 * 8); \
            GLD128(QW[0][0], Qg + eo); GLD128(QW[0][1], Qg + eo + 1024 * 8); GLD128(QW[1][0], Qg + eo + 128 * 8); GLD128(QW[1][1], Qg + eo + 128 * 8 + 1024 * 8); \
            GLD128(VW[0], Vg + evv); GLD128(VW[1], Vg + evv + 2048 * 8); } while (0)
#define PROC_B(LF, QW, KW, VW, kk, PC, PN) do { \
            BUF_PTRS(kk) \
            PD_FIRST(kk, PC); \
            PD_ISSUE((kk) + 1, PN); \
            asm volatile("s_waitcnt vmcnt(18)" : "+v"(LF[0][0]), "+v"(LF[0][1]), "+v"(LF[1][0]), "+v"(LF[1][1]), "+v"(KW[0][0]), "+v"(KW[0][1]), "+v"(KW[1][0]), "+v"(KW[1][1]), \
                         "+v"(QW[0][0]), "+v"(QW[0][1]), "+v"(QW[1][0]), "+v"(QW[1][1]), "+v"(VW[0]), "+v"(VW[1]));     \
            const bool tail = dir ? (th == 0) : (th == 1); \
            unsigned kst0[8], kst1[8]; float dd0 = 0.f, dd1 = 0.f; \
            float en0, in0, en1, in1;     \
            { const float c0 = h_sel(wsel(LF[0], 0), 0), c1 = h_sel(wsel(LF[1], 0), 0); VEXP(en0, c0); VEXPN(in0, c0); VEXP(en1, c1); VEXPN(in1, c1); } \
            float kap = 0.f, kbp = 0.f; \
            _Pragma("unroll") for (int it = 0; it < 16; ++it) { \
                const float e0 = en0, i0 = in0, e1 = en1, i1 = in1; \
                if (it < 15) { const float c0 = h_sel(wsel(LF[0], (it + 1) >> 1), (it + 1) & 1), c1 = h_sel(wsel(LF[1], (it + 1) >> 1), (it + 1) & 1); VEXP(en0, c0); VEXPN(in0, c0); VEXP(en1, c1); VEXPN(in1, c1); } \
                if (it == (dir ? 0 : 15)) { dd0 = e0; dd1 = e1; } \
                const float qs0 = vmul_v(bf_sel(wsel(QW[0], it >> 1), it & 1), e0), qs1 = vmul_v(bf_sel(wsel(QW[1], it >> 1), it & 1), e1); \
                const float ka = vmul_v(bf_sel(wsel(KW[0], it >> 1), it & 1), i0), kb = vmul_v(bf_sel(wsel(KW[1], it >> 1), it & 1), i1); \
                const int i = 16 * th + it; \
                *(LAS unsigned*)(QS + i * QSTR + cp * 4) = pk_bf16(qs0, qs1); \
                *(LAS unsigned*)(KS + i * QSTR + cp * 4) = pk_bf16(ka, kb); \
                if (it & 1) { kst0[it >> 1] = pk_bf16(kap, ka); kst1[it >> 1] = pk_bf16(kbp, kb); } \
                kap = ka; kbp = kb; \
            } \
            if (tail) { *(LAS f32x2*)(DD + 2 * cp) = (f32x2){dd0, dd1}; } \
            *(LAS u32x4*)(KST + (2 * cp) * RSTR + th * 32) = (u32x4){kst0[0], kst0[1], kst0[2], kst0[3]}; \
            *(LAS u32x4*)(KST + (2 * cp) * RSTR + th * 32 + 16) = (u32x4){kst0[4], kst0[5], kst0[6], kst0[7]}; \
            *(LAS u32x4*)(KST + (2 * cp + 1) * RSTR + th * 32) = (u32x4){kst1[0], kst1[1], kst1[2], kst1[3]}; \
            *(LAS u32x4*)(KST + (2 * cp + 1) * RSTR + th * 32 + 16) = (u32x4){kst1[4], kst1[5], kst1[6], kst1[7]}; \
            *(LAS u32x4*)(VT + col * RSTR + thv * 32) = VW[0]; \
            *(LAS u32x4*)(VT + col * RSTR + thv * 32 + 16) = VW[1]; \
            asm volatile("s_waitcnt vmcnt(16)" : "+v"(PC[0]), "+v"(PC[1]));     \
            PD_STORE(PC); \
        } while (0)
        static_assert(NS == 14 || IS_A, "wait counts");
        u32x4 lf0[2][2], q0_[2][2], k0_[2][2], v0_[2], lf1[2][2], q1_[2][2], k1_[2][2], v1_[2]; u32x4 pe[2], po[2];
        LOAD_B(lf0, q0_, k0_, v0_, 0); PD_ISSUE(0, pe); LOAD_B(lf1, q1_, k1_, v1_, 1);
#pragma unroll 1
        for (int k = 0; k < 264; k += 2) {
            PROC_B(lf0, q0_, k0_, v0_, k, pe, po); LOAD_B(lf0, q0_, k0_, v0_, k + 2); SBAR();
            PROC_B(lf1, q1_, k1_, v1_, k + 1, po, pe); LOAD_B(lf1, q1_, k1_, v1_, k + 3); SBAR();
        }
        asm volatile("s_waitcnt vmcnt(0)" ::: "memory");
#undef LOAD_B
#undef PROC_B
    }
#undef WAITV
#undef PD_LOADS
#undef PD_FIRST
#undef PD_ISSUE
#undef PD_STORE
#undef BUF_PTRS
#undef STEP_CHUNK
}

template <int DK, bool IS_A>
__device__ __forceinline__ void scan_unit(const Params& p, LAS unsigned char* lds, int b, int hh, int quarter, int dir, int pair) {
    constexpr int NT = DK / 32;
    constexpr int QSTR = DK * 2 + 16;
    constexpr int RSTR = 80;
    constexpr int OFF_KS = 32 * QSTR, OFF_KST = 2 * 32 * QSTR, OFF_VT = OFF_KST + DK * RSTR, OFF_DD = OFF_VT + 128 * RSTR, OFF_PD = OFF_DD + DK * 4, BUFB = OFF_PD + 4 * 32 * RSTR;
    static_assert(2 * BUFB <= LDS_BYTES, "scan LDS");
    const int tid = threadIdx.x, wid = __builtin_amdgcn_readfirstlane(tid >> 6), lane = tid & 63;
    const int h = lane >> 5, l31 = lane & 31;
    unsigned char* ws = p.ws;
    const u16* Qg = (const u16*)(ws + (IS_A ? WS_AQ : WS_BQ));
    const u16* Kg = (const u16*)(ws + WS_BK);
    const u16* Vg = (const u16*)(ws + (IS_A ? WS_AV : WS_BV));
    const u16* LFg = IS_A ? (const u16*)(ws + WS_ALF) + (size_t)dir * NCHUNK * 2048 * 32 : (const u16*)(ws + WS_LFB) + (size_t)dir * NCHUNK * 1024 * 32;
    unsigned* flg = (unsigned*)(ws + WS_FLG) + pair * 1024;
    const u16* Ogc = (const u16*)p.out + (IS_A ? 0 : (size_t)M_LAT * 2048);
#define STEP_CHUNK(k, is_ctx_, lc_, cidx_) const bool is_ctx_ = (k) < 8; const int lc_ = is_ctx_ ? (dir ? 7 - (k) : (k)) : (dir ? 263 - (k) : (k) - 8); const int cidx_ = is_ctx_ ? 512 + b * 8 + lc_ : b * 256 + lc_;
    if (wid >= 4) {
        const int pw = wid - 4, ptid = tid - 256;
        if (dir) producer_loop<DK, IS_A, 1>(p, lds, b, hh, quarter, pair, pw, ptid, lane);
        else producer_loop<DK, IS_A, 0>(p, lds, b, hh, quarter, pair, pw, ptid, lane);
        SBAR();
    } else {
        const int w = wid;
        u16* Og = (u16*)p.out + (IS_A ? 0 : (size_t)M_LAT * 2048);
        float* SSg = (float*)(ws + (IS_A ? WS_SSA : WS_SSB));
        unsigned* pdone = (unsigned*)(ws + WS_PDONE); (void)pdone; constexpr int PANEL_LAG = 4;
        const int ocol0 = IS_A ? hh * 128 + 32 * w : hh * 512 + quarter * 128 + 32 * w;
        const int sspart = IS_A ? hh * 4 + w : hh * 16 + quarter * 4 + w;
        const int prow = (l31 & 3) + 8 * ((l31 >> 2) & 1) + 4 * ((l31 >> 3) & 1) + 16 * (l31 >> 4);
        f32x16 S[NT];
#pragma unroll
        for (int t = 0; t < NT; ++t)
#pragma unroll
            for (int r = 0; r < 16; ++r) S[t][r] = 0.f;
        unsigned mk[2][4];
#pragma unroll
        for (int s2 = 0; s2 < 2; ++s2)
#pragma unroll
            for (int q = 0; q < 4; ++q) { const int r0 = 8 * s2 + 2 * q; const int j0 = (r0 & 3) + 8 * (r0 >> 2) + 4 * h, j1 = j0 + 1;
                const bool k0 = dir ? (j0 >= l31) : (j0 <= l31), k1 = dir ? (j1 >= l31) : (j1 <= l31);
                mk[s2][q] = (k0 ? 0xffffu : 0u) | (k1 ? 0xffff0000u : 0u); }
        SBAR();
#pragma unroll 1
        for (int k = 0; k < 264; ++k) {
            STEP_CHUNK(k, is_ctx, lc, cidx); (void)cidx;
            LAS unsigned char* buf = lds + (k & 1) * BUFB;
            LAS unsigned char* QS = buf; LAS unsigned char* KS = buf + OFF_KS; LAS unsigned char* KST = buf + OFF_KST; LAS unsigned char* VT = buf + OFF_VT; LAS float* DD = (LAS float*)(buf + OFF_DD);
            const bool fin = k >= 136;
            int row = 0;
            if (!is_ctx) { if (IS_A) row = b * SEQ + 32 * lc + l31; else { const int pp = 32 * lc + l31; row = b * SEQ + (pp & 127) * 64 + (pp >> 7); } }
            u16* otile = Og + ((size_t)(b * 256 + lc) * 64 + (IS_A ? hh * 4 : hh * 16 + quarter * 4) + w) * 1024;
            LAS unsigned char* orow = buf + OFF_PD + (w * 32 + l31) * RSTR + 8 * h;
            bf16x8 vk[2];
            f32x16 OT;
#pragma unroll
            for (int r = 0; r < 16; ++r) OT[r] = 0.f;
            if (!is_ctx) {
                f32x16 PT;
#pragma unroll
                for (int r = 0; r < 16; ++r) PT[r] = 0.f;
                {
                    LAS unsigned char* qa = QS + l31 * QSTR + 16 * h;
                    u32x4 fq[2][2], fk[2][2];
                    DSR128(fq[0][0], qa, 0); DSR128(fk[0][0], qa, OFF_KS); DSR128(fq[0][1], qa, 32); DSR128(fk[0][1], qa, OFF_KS + 32);
#define FSTEP(pp) if constexpr (NT > (pp)) { constexpr int s_ = (pp) & 1; \
                        if constexpr ((pp) + 1 < NT) { DSR128(fq[s_ ^ 1][0], qa, 64 * ((pp) + 1)); DSR128(fk[s_ ^ 1][0], qa, OFF_KS + 64 * ((pp) + 1)); \
                            DSR128(fq[s_ ^ 1][1], qa, 64 * ((pp) + 1) + 32); DSR128(fk[s_ ^ 1][1], qa, OFF_KS + 64 * ((pp) + 1) + 32); \
                            asm volatile("s_waitcnt lgkmcnt(4)" : "+v"(fq[s_][0]), "+v"(fk[s_][0]), "+v"(fq[s_][1]), "+v"(fk[s_][1])); } \
                        else asm volatile("s_waitcnt lgkmcnt(0)" : "+v"(fq[s_][0]), "+v"(fk[s_][0]), "+v"(fq[s_][1]), "+v"(fk[s_][1])); \
                        PT = __builtin_amdgcn_mfma_f32_32x32x16_bf16(__builtin_bit_cast(bf16x8, fk[s_][0]), __builtin_bit_cast(bf16x8, fq[s_][0]), PT, 0, 0, 0); \
                        OT = __builtin_amdgcn_mfma_f32_32x32x16_bf16(pack8(S[pp], 0), __builtin_bit_cast(bf16x8, fq[s_][0]), OT, 0, 0, 0); \
                        PT = __builtin_amdgcn_mfma_f32_32x32x16_bf16(__builtin_bit_cast(bf16x8, fk[s_][1]), __builtin_bit_cast(bf16x8, fq[s_][1]), PT, 0, 0, 0); \
                        OT = __builtin_amdgcn_mfma_f32_32x32x16_bf16(pack8(S[pp], 1), __builtin_bit_cast(bf16x8, fq[s_][1]), OT, 0, 0, 0); \
                        __builtin_amdgcn_sched_barrier(0); }
                    FSTEP(0) FSTEP(1) FSTEP(2) FSTEP(3) FSTEP(4) FSTEP(5) FSTEP(6) FSTEP(7)
#undef FSTEP
                }
#pragma unroll
                for (int s2 = 0; s2 < 2; ++s2) {
                    const u32x2 lo = *(const LAS u32x2*)(VT + (32 * w + l31) * RSTR + (16 * s2 + 4 * h) * 2);
                    const u32x2 hi = *(const LAS u32x2*)(VT + (32 * w + l31) * RSTR + (16 * s2 + 8 + 4 * h) * 2);
                    vk[s2] = __builtin_bit_cast(bf16x8, (u32x4){lo.x, lo.y, hi.x, hi.y});
                    u32x4 pw4 = __builtin_bit_cast(u32x4, pack8(PT, s2));
                    pw4.x &= mk[s2][0]; pw4.y &= mk[s2][1]; pw4.z &= mk[s2][2]; pw4.w &= mk[s2][3];
                    OT = __builtin_amdgcn_mfma_f32_32x32x16_bf16(vk[s2], __builtin_bit_cast(bf16x8, pw4), OT, 0, 0, 0);
                }
                float ss = 0.f;
#pragma unroll
                for (int g = 0; g < 4; ++g) {
                    float o0 = OT[4 * g], o1 = OT[4 * g + 1], o2 = OT[4 * g + 2], o3 = OT[4 * g + 3];
                    if (fin) {
                        const u32x2 pvv = *(const LAS u32x2*)(orow + 16 * g); const unsigned lo = pvv.x, hi = pvv.y;
                        o0 += bf_lo(lo); o1 += bf_hi(lo); o2 += bf_lo(hi); o3 += bf_hi(hi);
                        ss += (o0 * o0 + o1 * o1) + (o2 * o2 + o3 * o3);
                    }
                    *(LAS u32x2*)(orow + 16 * g) = (u32x2){pk_bf16(o0, o1), pk_bf16(o2, o3)};
                }
                asm volatile("s_waitcnt lgkmcnt(0)" ::: "memory");
#pragma unroll
                for (int j = 0; j < 2; ++j) {
                    const u32x4 tv = *(const LAS u32x4*)(buf + OFF_PD + (w * 32 + 16 * j + (lane >> 2)) * RSTR + (lane & 3) * 16);
                    u16* dst = otile + j * 512 + lane * 8;
                    if (fin && !IS_A) *(u32x4*)dst = tv;
                    else asm volatile("global_store_dwordx4 %0, %1, off sc1\n\ts_nop 1" :: "v"(dst), "v"(tv) : "memory");
                }
                if (fin) { ss += __shfl_xor(ss, 32);
                    if (h == 0) { float* sp = SSg + (size_t)row * 64 + sspart; if (IS_A) asm volatile("global_store_dword %0, %1, off sc1" :: "v"(sp), "v"(ss) : "memory"); else *sp = ss; } }
            }
            {
                bf16x8 vf[2];
#pragma unroll
                for (int s2 = 0; s2 < 2; ++s2) vf[s2] = *(const LAS bf16x8*)(VT + (32 * w + l31) * RSTR + (16 * s2 + 8 * h) * 2);
                LAS unsigned char* ka = KST + prow * RSTR + 16 * h;
                LAS unsigned char* da = (LAS unsigned char*)(DD + 8 * h);
                u32x4 kf[2][2];
                DSR128(kf[0][0], ka, 0); DSR128(kf[0][1], ka, 32);
#define USTEP(t) if constexpr (NT > (t)) { constexpr int s_ = (t) & 1; \
                    if constexpr ((t) + 1 < NT) { DSR128(kf[s_ ^ 1][0], ka, 32 * RSTR * ((t) + 1)); DSR128(kf[s_ ^ 1][1], ka, 32 * RSTR * ((t) + 1) + 32); \
                        asm volatile("s_waitcnt lgkmcnt(2)" : "+v"(kf[s_][0]), "+v"(kf[s_][1])); } \
                    else asm volatile("s_waitcnt lgkmcnt(0)" : "+v"(kf[s_][0]), "+v"(kf[s_][1])); \
                    S[t] = __builtin_amdgcn_mfma_f32_32x32x16_bf16(__builtin_bit_cast(bf16x8, kf[s_][0]), vf[0], S[t], 0, 0, 0); \
                    S[t] = __builtin_amdgcn_mfma_f32_32x32x16_bf16(__builtin_bit_cast(bf16x8, kf[s_][1]), vf[1], S[t], 0, 0, 0); \
                    __builtin_amdgcn_sched_barrier(0); }
                USTEP(0) USTEP(1) USTEP(2) USTEP(3) USTEP(4) USTEP(5) USTEP(6) USTEP(7)
#undef USTEP
                f32x4 dd[2][4];
                asm volatile("s_nop 15\n\ts_nop 15" ::: "memory");
                DSR128(dd[0][0], da, 0); DSR128(dd[0][1], da, 16); DSR128(dd[0][2], da, 64); DSR128(dd[0][3], da, 80);
#define DSTEP(t) if constexpr (NT > (t)) { constexpr int s_ = (t) & 1; \
                    if constexpr ((t) + 1 < NT) { DSR128(dd[s_ ^ 1][0], da, 128 * ((t) + 1)); DSR128(dd[s_ ^ 1][1], da, 128 * ((t) + 1) + 16); DSR128(dd[s_ ^ 1][2], da, 128 * ((t) + 1) + 64); DSR128(dd[s_ ^ 1][3], da, 128 * ((t) + 1) + 80); \
                        asm volatile("s_waitcnt lgkmcnt(4)" : "+v"(dd[s_][0]), "+v"(dd[s_][1]), "+v"(dd[s_][2]), "+v"(dd[s_][3])); } \
                    else asm volatile("s_waitcnt lgkmcnt(0)" : "+v"(dd[s_][0]), "+v"(dd[s_][1]), "+v"(dd[s_][2]), "+v"(dd[s_][3])); \
                    _Pragma("unroll") for (int r = 0; r < 4; ++r) { S[t][r] = vmul_v(S[t][r], dd[s_][0][r]); S[t][4 + r] = vmul_v(S[t][4 + r], dd[s_][1][r]); S[t][8 + r] = vmul_v(S[t][8 + r], dd[s_][2][r]); S[t][12 + r] = vmul_v(S[t][12 + r], dd[s_][3][r]); } \
                    asm volatile("" : "+v"(S[t])); __builtin_amdgcn_sched_barrier(0); }
                DSTEP(0) DSTEP(1) DSTEP(2) DSTEP(3) DSTEP(4) DSTEP(5) DSTEP(6) DSTEP(7)
#undef DSTEP
            }
            constexpr int FLAG_LAG = 8;
            if (k >= 8 + FLAG_LAG && k < 135) {
                asm volatile("s_waitcnt vmcnt(24)" ::: "memory"); static_assert(FLAG_LAG * 3 == 24, "vmcnt literal");
                const int kp = k - FLAG_LAG; const int lcp = dir ? 263 - kp : kp - 8;
                if (lane == 0) __hip_atomic_store(flg + lcp * 4 + w, 1u, __ATOMIC_RELAXED, __HIP_MEMORY_SCOPE_AGENT);
            } else if (k == 135) {
                VM_WAIT();
                if (lane == 0) {
#pragma unroll
                    for (int q = 0; q <= FLAG_LAG; ++q) { const int kp = 135 - q; const int lcp = dir ? 263 - kp : kp - 8; __hip_atomic_store(flg + lcp * 4 + w, 1u, __ATOMIC_RELAXED, __HIP_MEMORY_SCOPE_AGENT); }
                }
            }
            if (IS_A && k >= 136 + PANEL_LAG) {
                const int kd = k - PANEL_LAG; const int lcd = dir ? 263 - kd : kd - 8;
                if ((lcd & 7) == (dir ? 0 : 7)) {
                    asm volatile("s_waitcnt vmcnt(12)" ::: "memory"); static_assert(PANEL_LAG * 3 == 12, "vmcnt literal");
                    if (lane == 0) __hip_atomic_fetch_add(pdone + (b * 32 + (lcd >> 3)) * 4, 1u, __ATOMIC_RELAXED, __HIP_MEMORY_SCOPE_AGENT);
                }
            }
            SBAR();
        }
        if (IS_A) { VM_WAIT(); if (lane == 0) __hip_atomic_fetch_add(pdone + (b * 32 + (dir ? 0 : 31)) * 4, 1u, __ATOMIC_RELAXED, __HIP_MEMORY_SCOPE_AGENT); }
    }
#undef STEP_CHUNK
}

__device__ __forceinline__ void phase7(const Params& p) {
    const int tid = threadIdx.x, wid = tid >> 6, lane = tid & 63;
    const float* sso = (const float*)(p.ws + WS_SSO);
    for (int m0 = 2 * (blockIdx.x * 8 + wid); m0 < M_LAT; m0 += 2 * gridDim.x * 8) {
        f32x4 ov[2][8]; float sv[2];
#pragma unroll
        for (int rr = 0; rr < 2; ++rr) { const int m = m0 + rr; sv[rr] = (lane < 32) ? sso[(size_t)m * 32 + lane] : 0.f;
            const f32x4* o4 = (const f32x4*)(p.out + (size_t)m * D) + lane;
#pragma unroll
            for (int j = 0; j < 8; ++j) ov[rr][j] = o4[64 * j]; }
#pragma unroll
        for (int rr = 0; rr < 2; ++rr) { const int m = m0 + rr;
            const float rstd = rsqrtf(wave_sum(sv[rr]) * (1.0f / D) + EPS);
            f32x4* o4 = (f32x4*)(p.out + (size_t)m * D) + lane;
#pragma unroll
            for (int j = 0; j < 8; ++j) { const f32x4 g = *(const f32x4*)(p.final_g + 4 * (lane + 64 * j)); o4[64 * j] = ov[rr][j] * rstd * g; } }
    }
}


#define XB_TMO      128
#define XB_XCNT(j)  (256  + 64 * (j))
#define XB_XSUB(j)  (1280 + 64 * (j))
#define XB_XGEN(j)  (2304 + 64 * (j))
#define XB_TOP      3328
#define XB_TOPGEN   3392
#define XCD_BAR_WORDS 3456
#define XB_SPIN_CAP (1u << 18)
__device__ __forceinline__ unsigned xb_ld(unsigned* p)              { return __hip_atomic_load(p, __ATOMIC_RELAXED, __HIP_MEMORY_SCOPE_AGENT); }
__device__ __forceinline__ unsigned xb_add(unsigned* p, unsigned v) { return __hip_atomic_fetch_add(p, v, __ATOMIC_RELAXED, __HIP_MEMORY_SCOPE_AGENT); }
__device__ __forceinline__ unsigned xb_xcc_id() { return (unsigned)__builtin_amdgcn_s_getreg((3 << 11) | 20) & 0xFu; }
#define XB_SPIN(cond, bar) do { unsigned _sp = 0; while (cond) { __builtin_amdgcn_s_sleep(1); \
    if ((++_sp & 255u) == 0u) { if (xb_ld(&(bar)[XB_TMO])) break; if (_sp > XB_SPIN_CAP) { atomicAdd(&(bar)[XB_TMO], 1u); break; } } } } while (0)
struct XcdBarrier { unsigned* bar; unsigned x; volatile LAS unsigned* st; };
__device__ __forceinline__ XcdBarrier xcd_barrier_post(unsigned* bar, volatile LAS unsigned* st) {
    XcdBarrier b; b.bar = bar; b.x = xb_xcc_id(); b.st = st;
    if (threadIdx.x == 0) (void)xb_add(&bar[XB_XCNT(b.x)], 1u);
    return b;
}
__device__ __forceinline__ void xcd_barrier_complete(unsigned* bar, unsigned x, unsigned& nloc, unsigned& nx) {
    const unsigned G = gridDim.x * gridDim.y * gridDim.z;
    unsigned sum, cnt, mine, sp = 0u;
    for (;;) {
        sum = 0u; cnt = 0u; mine = 0u;
#pragma unroll
        for (unsigned j = 0; j < 16; ++j) { const unsigned c = xb_ld(&bar[XB_XCNT(j)]); sum += c; cnt += (c > 0u) ? 1u : 0u; mine = (j == x) ? c : mine; }
        if (sum == G) break;
        __builtin_amdgcn_s_sleep(1);
        if ((++sp & 255u) == 0u) { if (xb_ld(&bar[XB_TMO])) break; if (sp > XB_SPIN_CAP) { atomicAdd(&bar[XB_TMO], 1u); break; } }
    }
    nloc = mine > 0u ? mine : 1u; nx = cnt > 0u ? cnt : 1u;
}
__device__ __forceinline__ void xcd_barrier(const XcdBarrier& b) {
    asm volatile("s_waitcnt vmcnt(0)" ::: "memory");
    __syncthreads();
    if (threadIdx.x == 0) {
        unsigned* bar = b.bar;
        __builtin_amdgcn_s_waitcnt(0);
        unsigned nloc = b.st[0], nx = b.st[1];
        if (nloc == 0u) { xcd_barrier_complete(bar, b.x, nloc, nx); b.st[0] = nloc; b.st[1] = nx; }
        const unsigned old = xb_add(&bar[XB_XSUB(b.x)], 1u);
        const unsigned gen = old / nloc;
        if (old + 1u == (gen + 1u) * nloc) {
            __builtin_amdgcn_fence(__ATOMIC_RELEASE, "agent");
            asm volatile("s_waitcnt vmcnt(0)" ::: "memory");
            const unsigned og = xb_add(&bar[XB_TOP], 1u);
            const unsigned tg = og / nx;
            if (og + 1u == (tg + 1u) * nx) xb_add(&bar[XB_TOPGEN], 1u);
            else XB_SPIN(xb_ld(&bar[XB_TOPGEN]) == tg, bar);
            __builtin_amdgcn_fence(__ATOMIC_ACQUIRE, "agent");
            xb_add(&bar[XB_XGEN(b.x)], 1u);
            asm volatile("s_waitcnt vmcnt(0)" ::: "memory");
        } else {
            XB_SPIN(xb_ld(&bar[XB_XGEN(b.x)]) == gen, bar);
            __builtin_amdgcn_fence(__ATOMIC_ACQUIRE, "agent");
            asm volatile("s_waitcnt vmcnt(0)" ::: "memory");
        }
    }
    __syncthreads();
}

__global__ void __launch_bounds__(512, 2) fwd_megakernel(Params p) {
    extern __shared__ __attribute__((aligned(16))) unsigned char lds_raw[];
    LAS unsigned char* lds = (LAS unsigned char*)lds_raw;
    volatile LAS unsigned* bst = (volatile LAS unsigned*)(lds + LDS_BYTES - 16);
    if (threadIdx.x < 4) bst[threadIdx.x] = 0u;
    __syncthreads();
    const XcdBarrier xbar = xcd_barrier_post((unsigned*)(p.ws + WS_BAR), bst);
    const int lo = p.ph_lo, hi = p.ph_hi;
    const int G = gridDim.x, c = blockIdx.x;
    unsigned char* ws = p.ws;
#ifdef ONLY_PHASE
#define IN(k) ((k) == ONLY_PHASE && lo <= (k) && (k) < hi)
#else
#define IN(k) (lo <= (k) && (k) < hi)
#endif
#define SEAM(k) do { if (IN(k) && IN((k) + 1)) xcd_barrier(xbar); } while (0)
#ifndef DUP_PHASE
#define DUP_PHASE -1
#endif
#define REP(k) for (int rep_ = 0; rep_ < ((k) == DUP_PHASE ? 2 : 1); ++rep_)
    if (IN(0)) REP(0) phase0(p, lds);
    SEAM(0);
    if (IN(1)) REP(1) phase1(p);
    SEAM(1);
    if (IN(2)) REP(2) { SchedScan S{G, c, (const char*)(ws + WS_H), (const char*)(ws + WS_WTS)}; EpiScan E{ws, p.lb_logits};
        pg8::gemm_phase<EpiScan, SchedScan, false, true, false>(lds, S, E); }
    SEAM(2);
    if (IN(3)) REP(3) phase2b(p, lds);
    SEAM(3);
    if (IN(4)) {
        EpiGate E{ws, (u16*)p.out, (u16*)p.out + (size_t)M_LAT * 2048, p.onorm_a, p.onorm_b, (const unsigned*)(ws + WS_PDONE)};
        if (c < 64) {
            scan_unit<128, true>(p, lds, c >> 5, (c >> 1) & 15, 0, c & 1, c >> 1);
            unsigned* adone = (unsigned*)(ws + 256);
            __syncthreads();
            if (threadIdx.x == 0) __hip_atomic_fetch_add(adone, 1u, __ATOMIC_RELAXED, __HIP_MEMORY_SCOPE_AGENT);
            SchedHelp S{128 + c, 0, (const char*)(ws + WS_H), (const char*)(ws + WS_WTG)};
            pg8::gemm_phase<EpiGate, SchedHelp, true, false, true>(lds, S, E);
            if (threadIdx.x == 0) { unsigned spins = 0; while (__hip_atomic_load(adone, __ATOMIC_RELAXED, __HIP_MEMORY_SCOPE_AGENT) < 64u) { __builtin_amdgcn_s_sleep(8); if (++spins > (1u << 22)) break; } }
            __syncthreads();
            phase_wtp(p, lds, c, 64);
        } else if (c < 128) { const int u = c - 64; scan_unit<256, false>(p, lds, u >> 5, (u >> 3) & 3, (u >> 1) & 3, u & 1, 32 + (u >> 1)); }
        else { SchedHelp S{c - 128, 4, (const char*)(ws + WS_H), (const char*)(ws + WS_WTG)};
            pg8::gemm_phase<EpiGate, SchedHelp, true, false, true>(lds, S, E); }
    }
    SEAM(4);
    if (IN(5)) {
        SchedTiles S{G, c, NAG_SCAN, 16 - NAG_SCAN, (const char*)(ws + WS_H), (const char*)(ws + WS_WTG)};
        EpiGate E{ws, (u16*)p.out, (u16*)p.out + (size_t)M_LAT * 2048, p.onorm_a, p.onorm_b, (const unsigned*)(ws + WS_PDONE)};
        pg8::gemm_phase<EpiGate, SchedTiles, true, false, true>(lds, S, E); }
    SEAM(5);
    if (IN(6)) { SchedY S{G, c, (const char*)p.out, (const char*)p.out + (size_t)M_LAT * 2048 * 2, (const char*)(ws + WS_WTP)}; EpiY2 E{ws};
        pg8::gemm_phase<EpiY2, SchedY, true, false, true>(lds, S, E); }
    SEAM(6);
    if (IN(7)) REP(7) { SchedStd S{G, c, 8, (const char*)(ws + WS_Y), (const char*)(ws + WS_WTP) + (size_t)2 * 2048 * 4096, 0u};
        EpiOut E{p.x, p.out, (const float*)(ws + WS_MOD), (float*)(ws + WS_SSO)};
        pg8::gemm_phase<EpiOut, SchedStd, true, false, false>(lds, S, E); }
    SEAM(7);
    if (IN(8)) phase7(p);
#undef IN
#undef SEAM
}

#ifndef N_LAUNCHES
#define N_LAUNCHES 1
#endif
constexpr int N_PHASES = 9;

extern "C" void kernel_launch(void* const* d_in, const int* in_sizes, int n_in, void* d_out, int out_size, void* d_ws, size_t ws_size, hipStream_t stream) {
    static int grid = 0;
    if (grid == 0) {
        if (n_in != 17 || out_size != M_LAT * D || ws_size < WS_END) { fprintf(stderr, "kernel_launch: unexpected sizes (n_in %d out %d ws %zu need %zu)\n", n_in, out_size, ws_size, (size_t)WS_END); grid = -1; return; }
        int dev = 0, cus = 0, per_cu = 0;
        hipGetDevice(&dev);
        hipDeviceGetAttribute(&cus, hipDeviceAttributeMultiprocessorCount, dev);
        hipFuncSetAttribute((const void*)fwd_megakernel, hipFuncAttributeMaxDynamicSharedMemorySize, LDS_BYTES);
        hipOccupancyMaxActiveBlocksPerMultiprocessor(&per_cu, (const void*)fwd_megakernel, 512, LDS_BYTES);
        if (per_cu < 1) { fprintf(stderr, "kernel_launch: occupancy query reports %d blocks per CU\n", per_cu); grid = -1; return; }
        grid = cus;
    }
    if (grid < 0) return;
    Params p{};
    p.x = (const float*)d_in[0]; p.c = (const float*)d_in[1]; p.ctx = (const float*)d_in[2]; p.c_ctx = (const float*)d_in[3];
    p.w_ada = (const float*)d_in[4]; p.b_ada = (const float*)d_in[5]; p.norm_g = (const float*)d_in[6]; p.w_in = (const float*)d_in[7];
    p.lb_logits = (const float*)d_in[8]; p.gk_w = (const float*)d_in[9]; p.gk_b = (const float*)d_in[10]; p.onorm_a = (const float*)d_in[11];
    p.onorm_b = (const float*)d_in[12]; p.w_pa = (const float*)d_in[13]; p.w_pb = (const float*)d_in[14]; p.w_out = (const float*)d_in[15]; p.final_g = (const float*)d_in[16];
    p.out = (float*)d_out; p.ws = (unsigned char*)d_ws;
    (void)hipMemsetAsync((char*)d_ws + WS_BAR, 0, 16384, stream);
    const int per = (N_PHASES + N_LAUNCHES - 1) / N_LAUNCHES;
    for (int li = 0; li < N_LAUNCHES; ++li) {
        p.ph_lo = li * per; p.ph_hi = (li + 1) * per < N_PHASES ? (li + 1) * per : N_PHASES;
        if (p.ph_lo >= N_PHASES) break;
        void* args[] = {&p};
        hipError_t e = hipLaunchCooperativeKernel((const void*)fwd_megakernel, dim3(grid), dim3(512), args, LDS_BYTES, stream);
        if (e != hipSuccess) { fprintf(stderr, "cooperative launch failed: %s (grid %d)\n", hipGetErrorString(e), grid); break; }
    }
}
```

```cpp
#include <hip/hip_runtime.h>
#include <cstdio>
#include <cstdint>

#define LAS __attribute__((address_space(3)))
typedef unsigned short u16;
typedef short bf16x8 __attribute__((ext_vector_type(8)));
typedef float f32x2 __attribute__((ext_vector_type(2)));
typedef float f32x4 __attribute__((ext_vector_type(4)));
typedef float f32x16 __attribute__((ext_vector_type(16)));
typedef unsigned u32x2 __attribute__((ext_vector_type(2)));
typedef unsigned u32x4 __attribute__((ext_vector_type(4)));
typedef __bf16 bf16x2_t __attribute__((ext_vector_type(2)));
typedef _Float16 f16x2_t __attribute__((ext_vector_type(2)));

constexpr int D = 2048, NB = 2, SEQ = 8192, LCTX = 256;
constexpr int M_LAT = NB * SEQ;
constexpr int M_ALL = M_LAT + NB * LCTX;
constexpr int N_IN = 20512;
constexpr int NCHUNK = M_ALL / 32;
constexpr float EPS = 1e-6f;
constexpr int NSCAN_ROWS = 12544;
constexpr int NGATE_ROWS = 8192;

constexpr size_t WS_PDONE = 1024;
constexpr size_t WS_BAR = 4096;
constexpr size_t WS_MODCNT = WS_BAR + 16000;
constexpr size_t WS_FLG = WS_BAR + 16384;
constexpr size_t WS_MOD = WS_FLG + 64 * 256 * 4 * 4;
constexpr size_t WS_SSO = WS_MOD + 3 * 6144 * 4;
constexpr size_t WS_SSA = WS_SSO + (size_t)M_LAT * 32 * 4;
constexpr size_t WS_SSB = WS_SSA + (size_t)M_LAT * 64 * 4;
constexpr size_t WS_WTG = WS_SSB + (size_t)M_LAT * 64 * 4;
constexpr size_t WS_H   = WS_WTG + (size_t)NGATE_ROWS * D * 2;
constexpr size_t WS_WTS = WS_H + (size_t)M_ALL * D * 2;
constexpr size_t WS_LFB = WS_WTS;
constexpr size_t WS_R   = WS_LFB + (size_t)2 * NCHUNK * 1024 * 32 * 2;
constexpr size_t WS_AQ  = WS_R + (size_t)NCHUNK * 32 * 32 * 4;
constexpr size_t WS_AV  = WS_AQ + (size_t)NCHUNK * 2048 * 32 * 2;
constexpr size_t WS_ALF = WS_AV + (size_t)NCHUNK * 2048 * 32 * 2;
constexpr size_t WS_BQ  = WS_ALF + (size_t)2 * NCHUNK * 2048 * 32 * 2;
constexpr size_t WS_BK  = WS_BQ + (size_t)NCHUNK * 1024 * 32 * 2;
constexpr size_t WS_BV  = WS_BK + (size_t)NCHUNK * 1024 * 32 * 2;
constexpr size_t WS_MGA = WS_BV + (size_t)NCHUNK * 2048 * 32 * 2;
constexpr size_t WS_END = WS_MGA + (size_t)M_LAT * 2048 * 2;
constexpr size_t WS_MGB = WS_AQ;
constexpr size_t WS_Y   = WS_ALF;
constexpr size_t WS_WTP = WS_ALF + (size_t)M_LAT * 2048 * 2;
static_assert(WS_WTS + (size_t)NSCAN_ROWS * D * 2 <= WS_R, "LFB overlay");
static_assert(WS_MGB + (size_t)M_LAT * 2048 * 2 <= WS_AV, "MGB overlay");
static_assert(WS_WTP + (size_t)3 * D * D * 2 <= WS_BQ, "WTP overlay");
static_assert(WS_END <= (size_t)672137216, "workspace");

constexpr int LDS_BYTES = 155648;

struct Params {
    const float *x, *c, *ctx, *c_ctx, *w_ada, *b_ada, *norm_g, *w_in, *lb_logits, *gk_w, *gk_b, *onorm_a, *onorm_b, *w_pa, *w_pb, *w_out, *final_g;
    float* out; unsigned char* ws;
    int ph_lo, ph_hi;
};

__device__ __forceinline__ unsigned pk_bf16(float lo, float hi) { f32x2 v = {lo, hi}; return __builtin_bit_cast(unsigned, __builtin_convertvector(v, bf16x2_t)); }
__device__ __forceinline__ unsigned pk_f16(float lo, float hi) { f32x2 v = {lo, hi}; return __builtin_bit_cast(unsigned, __builtin_convertvector(v, f16x2_t)); }
__device__ __forceinline__ float bf_lo(unsigned w) { return __uint_as_float(w << 16); }
__device__ __forceinline__ float bf_hi(unsigned w) { return __uint_as_float(w & 0xffff0000u); }
__device__ __forceinline__ float bf_sel(unsigned w, int hi) { return hi ? bf_hi(w) : bf_lo(w); }
__device__ __forceinline__ float h_sel(unsigned w, int hi) { return (float)__builtin_bit_cast(_Float16, (u16)(hi ? (w >> 16) : (w & 0xffffu))); }
__device__ __forceinline__ float sigmoidf_(float v) { return __builtin_amdgcn_rcpf(1.0f + __builtin_amdgcn_exp2f(v * -1.4426950408889634f)); }
__device__ __forceinline__ float wave_sum(float v) {
#pragma unroll
    for (int o = 1; o < 64; o <<= 1) v += __shfl_xor(v, o);
    return v;
}
#define LDS_WAIT() asm volatile("s_waitcnt lgkmcnt(0)" ::: "memory")
#define VM_WAIT() asm volatile("s_waitcnt vmcnt(0)" ::: "memory")

namespace pg8 {
constexpr int BM = 256, BK = 64, HALF = 128, HTB = HALF * BK * 2, STAGE_BYTES = 8 * HTB, KD = 2048, NT = KD / BK;
__device__ __forceinline__ int lds_byte(int r, int c) { const int st = (r >> 4) * 2 + (c >> 5), rr = r & 15, cc = c & 31, ob = rr * 64 + cc * 2; return st * 1024 + (ob ^ (((ob >> 9) & 1) << 5)); }
__device__ __forceinline__ void stage_rc(int b, int& R, int& C) { const int st = b / 1024, sb = b % 1024, swz = sb ^ (((sb >> 9) & 1) << 5); R = (st >> 1) * 16 + swz / 64; C = (st & 1) * 32 + (swz % 64) / 2; }
__device__ __forceinline__ int perm32(int rho) { const int n = rho >> 4, i = rho & 15; return 8 * (i >> 2) + 4 * n + (i & 3); }

struct Unit { const char* A; const char* B; unsigned mode; unsigned hstepA; unsigned kstepA; int pm, pn; };
template <unsigned MODES>
__device__ __forceinline__ unsigned voffA_of(unsigned mode, int R, int C) {
    if ((MODES & 1u) && (mode == 0u || MODES == 1u)) return (unsigned)(R * KD + C) * 2u;
    if ((MODES & 2u) && (mode == 1u || (MODES & ~3u) == 0u)) return (unsigned)(R * 64 * KD + C) * 2u;
    if ((MODES & 4u) && (mode == 2u || (MODES & ~7u) == 0u)) return (unsigned)((((R >> 5) * 64 + (C >> 5)) * 1024) + (R & 31) * 32 + (C & 31)) * 2u;
    return (unsigned)((((R & 63) * 4 * 64 + (C >> 5)) * 1024) + (R >> 6) * 32 + (C & 31)) * 2u;
}

template <class Epi, class Sched, bool TRANS, bool PERM_A, bool PERM_B>
__device__ __forceinline__ void gemm_phase(LAS unsigned char* lds, const Sched& S, const Epi& E) {
    int tid = threadIdx.x; asm volatile("" : "+v"(tid));
    const int wid = __builtin_amdgcn_readfirstlane(tid >> 6), lane = tid & 63, wr = wid >> 2, wc = wid & 3, fr = lane & 15, fq = lane >> 4;
    int RaA[2], CA[2]; unsigned voffB[2];
#pragma unroll
    for (int i = 0; i < 2; ++i) { int R, C; stage_rc(tid * 16 + i * 8192, R, C);
        RaA[i] = PERM_A ? ((R & ~31) + perm32(R & 31)) : R; CA[i] = C; const int Rb = PERM_B ? ((R & ~31) + perm32(R & 31)) : R;
        voffB[i] = (unsigned)(Rb * KD + C) * 2u; }
    constexpr size_t kstep = (size_t)(BK * 2);
    constexpr size_t hstepB = (size_t)HALF * KD * 2;
    const unsigned ldsw = (unsigned)wid * 1024u;
    const int aoff = lds_byte(wr * 64 + fr, fq * 8), boff = lds_byte(wc * 32 + fr, fq * 8);
#define PG8_SA(b, h) (((b) * 2 + (h)) * HTB)
#define PG8_SB(b, h) ((4 + (b) * 2 + (h)) * HTB)
#define PG8_STAGE(bufoff, gbase, voff) do { _Pragma("unroll") for (int _i = 0; _i < 2; ++_i) \
        __builtin_amdgcn_global_load_lds((const unsigned*)((const char*)(gbase) + (voff)[_i]), (LAS unsigned*)(lds + (bufoff) + ldsw + _i * 8192), 16, 0, 0); } while (0)
#define PG8_LDA(dst, b, h) do { _Pragma("unroll") for (int m = 0; m < 4; ++m) _Pragma("unroll") for (int k = 0; k < 2; ++k) dst[m][k] = *(const LAS bf16x8*)(lds + PG8_SA(b, h) + aoff + m * 2048 + k * 1024); } while (0)
#define PG8_LDB(dst, b, h) do { _Pragma("unroll") for (int n = 0; n < 2; ++n) _Pragma("unroll") for (int k = 0; k < 2; ++k) dst[n][k] = *(const LAS bf16x8*)(lds + PG8_SB(b, h) + boff + n * 2048 + k * 1024); } while (0)
#define PG8_MMA(ai, bj, At, Bt) do { __builtin_amdgcn_s_setprio(1); _Pragma("unroll") for (int m = 0; m < 4; ++m) _Pragma("unroll") for (int n = 0; n < 2; ++n) _Pragma("unroll") for (int k = 0; k < 2; ++k) \
        acc[ai][bj][m][n] = TRANS ? __builtin_amdgcn_mfma_f32_16x16x32_bf16(Bt[n][k], At[m][k], acc[ai][bj][m][n], 0, 0, 0) \
                                  : __builtin_amdgcn_mfma_f32_16x16x32_bf16(At[m][k], Bt[n][k], acc[ai][bj][m][n], 0, 0, 0); __builtin_amdgcn_s_setprio(0); } while (0)
#define PG8_WAIT_V(n) asm volatile("s_waitcnt vmcnt(" #n ")" ::: "memory")
#define PG8_WAIT_L(n) asm volatile("s_waitcnt lgkmcnt(" #n ")" ::: "memory")
#define PG8_BAR __builtin_amdgcn_s_barrier()
#define PG8_SCHED __builtin_amdgcn_sched_barrier(0)
    Unit cur, nxt; int ui = 0;
    if (!S.next(0, cur)) return;
    f32x4 acc[2][2][4][2];
#pragma unroll
    for (int a = 0; a < 2; ++a)
#pragma unroll
        for (int b = 0; b < 2; ++b)
#pragma unroll
            for (int m = 0; m < 4; ++m)
#pragma unroll
                for (int n = 0; n < 2; ++n) acc[a][b][m][n] = (f32x4){0.f, 0.f, 0.f, 0.f};
    bf16x8 At[4][2], B0[2][2], B1[2][2];
    const char* cA = cur.A; const char* cB = cur.B;
    unsigned vA[2] = {voffA_of<Sched::MODES>(cur.mode, RaA[0], CA[0]), voffA_of<Sched::MODES>(cur.mode, RaA[1], CA[1])};
    size_t hA = cur.hstepA, kA = cur.kstepA;
    PG8_STAGE(PG8_SB(0, 0), cB, voffB); PG8_STAGE(PG8_SA(0, 0), cA, vA); PG8_STAGE(PG8_SB(0, 1), cB + hstepB, voffB); PG8_STAGE(PG8_SA(0, 1), cA + hA, vA);
    if (wr == 1) PG8_BAR;
    PG8_WAIT_V(4); PG8_BAR;
    PG8_STAGE(PG8_SB(1, 0), cB + kstep, voffB); PG8_STAGE(PG8_SA(1, 0), cA + kA, vA); PG8_STAGE(PG8_SB(1, 1), cB + hstepB + kstep, voffB);
    PG8_WAIT_V(6); PG8_BAR;
    for (;;) {
        const bool has_next = S.next(ui + 1, nxt);
        const char* nA = has_next ? nxt.A : cA; const char* nB = has_next ? nxt.B : cB;
        unsigned vN[2]; size_t hN, kN;
        if (has_next) { vN[0] = voffA_of<Sched::MODES>(nxt.mode, RaA[0], CA[0]); vN[1] = voffA_of<Sched::MODES>(nxt.mode, RaA[1], CA[1]); hN = nxt.hstepA; kN = nxt.kstepA; } else { vN[0] = vA[0]; vN[1] = vA[1]; hN = hA; kN = kA; }
        for (int t = 0; t < NT; t += 2) {
            const bool last = (t == NT - 2);
            const char* a1 = cA + (size_t)(t + 1) * kA;
            const char* a2 = last ? nA : cA + (size_t)(t + 2) * kA; const char* b2 = last ? nB : cB + (size_t)(t + 2) * kstep;
            const char* a3 = a2 + (last ? kN : kA); const char* b3 = b2 + kstep;
            unsigned v2[2] = {last ? vN[0] : vA[0], last ? vN[1] : vA[1]}; const size_t h2 = last ? hN : hA;
            PG8_LDB(B0, 0, 0); PG8_SCHED; PG8_LDA(At, 0, 0); PG8_STAGE(PG8_SA(1, 1), a1 + hA, vA);
            PG8_WAIT_L(8); PG8_BAR; PG8_WAIT_L(0); PG8_MMA(0, 0, At, B0); PG8_BAR; PG8_SCHED;
            PG8_LDB(B1, 0, 1); PG8_STAGE(PG8_SB(0, 0), b2, voffB);
            PG8_BAR; PG8_WAIT_L(0); PG8_MMA(0, 1, At, B1); PG8_BAR;
            PG8_LDA(At, 0, 1); PG8_STAGE(PG8_SA(0, 0), a2, v2);
            PG8_BAR; PG8_WAIT_L(0); PG8_MMA(1, 0, At, B0); PG8_BAR; PG8_SCHED;
            PG8_STAGE(PG8_SB(0, 1), b2 + hstepB, voffB);
            PG8_WAIT_V(6); PG8_BAR; PG8_MMA(1, 1, At, B1); PG8_BAR;
            PG8_LDB(B0, 1, 0); PG8_SCHED; PG8_LDA(At, 1, 0); PG8_STAGE(PG8_SA(0, 1), a2 + h2, v2);
            PG8_WAIT_L(8); PG8_BAR; PG8_WAIT_L(0); PG8_MMA(0, 0, At, B0); PG8_BAR; PG8_SCHED;
            PG8_LDB(B1, 1, 1); PG8_STAGE(PG8_SB(1, 0), b3, voffB);
            PG8_BAR; PG8_WAIT_L(0); PG8_MMA(0, 1, At, B1); PG8_BAR;
            PG8_LDA(At, 1, 1); PG8_STAGE(PG8_SA(1, 0), a3, v2);
            PG8_BAR; PG8_WAIT_L(0); PG8_MMA(1, 0, At, B0); PG8_BAR; PG8_SCHED;
            PG8_STAGE(PG8_SB(1, 1), b3 + hstepB, voffB);
            PG8_WAIT_V(6); PG8_BAR; PG8_MMA(1, 1, At, B1); PG8_BAR;
        }
        E(acc, cur, wr, wc, fr, fq);
        if (!has_next) break;
#pragma unroll
        for (int a = 0; a < 2; ++a)
#pragma unroll
            for (int b = 0; b < 2; ++b)
#pragma unroll
                for (int m = 0; m < 4; ++m)
#pragma unroll
                    for (int n = 0; n < 2; ++n) acc[a][b][m][n] = (f32x4){0.f, 0.f, 0.f, 0.f};
        cur = nxt; cA = nA; cB = nB; vA[0] = vN[0]; vA[1] = vN[1]; hA = hN; kA = kN; ++ui;
    }
    PG8_WAIT_V(0);
    if (wr == 0) PG8_BAR;
    PG8_BAR;
#undef PG8_SA
#undef PG8_SB
#undef PG8_STAGE
#undef PG8_LDA
#undef PG8_LDB
#undef PG8_MMA
#undef PG8_WAIT_V
#undef PG8_WAIT_L
#undef PG8_BAR
#undef PG8_SCHED
}
}

typedef f32x4 AccT[2][2][4][2];

struct SchedScan { static constexpr unsigned MODES = 3u;
    int G, c; const char* h; const char* wts;
    __device__ __forceinline__ bool next(int i, pg8::Unit& u) const {
        const int L = i * G + c;
        if (L >= 64 * 49 + 2 * 37) return false;
        int pm, pn;
        if (L < 64 * 49) { pm = L & 63; pn = L >> 6; }
        else { const int r = L - 64 * 49; pm = 64 + (r & 1); int q = r >> 1; pn = (q < 24) ? 8 + q : 36 + (q - 24); }
        u.pm = pm; u.pn = pn; u.B = wts + (size_t)pn * 256 * 4096;
        if (pn >= 32 && pm < 64) {
            const int b = pm >> 5, pp = pm & 31;
            u.A = h + (size_t)(b * 8192 + 2 * pp) * 4096; u.mode = 1u; u.hstepA = 4096u; u.kstepA = 128u;
        } else { u.A = h + (size_t)pm * 256 * 4096; u.mode = 0u; u.hstepA = 128u * 4096u; u.kstepA = 128u; }
        return true;
    }
};
struct SchedStd { static constexpr unsigned MODES = 1u;
    int G, c, nN; const char* A; const char* B; unsigned mode;
    __device__ __forceinline__ bool next(int i, pg8::Unit& u) const {
        const int L = i * G + c;
        if (L >= 64 * nN) return false;
        u.pm = L & 63; u.pn = L >> 6; u.B = B + (size_t)u.pn * 256 * 4096; u.mode = mode;
        if (mode == 0u) { u.A = A + (size_t)u.pm * 256 * 4096; u.hstepA = 128u * 4096u; u.kstepA = 128u; }
        else if (mode == 2u) { u.A = A + (size_t)u.pm * 8 * 64 * 2048; u.hstepA = 4u * 64u * 2048u; u.kstepA = 4096u; }
        else { const int bb = u.pm >> 5, pp = u.pm & 31;
            u.A = A + ((size_t)(bb * 256 + (pp >> 3)) * 64 * 1024 + (size_t)(4 * (pp & 7)) * 32) * 2; u.hstepA = 2u * 32u * 2u; u.kstepA = 4096u; }
        return true;
    }
};

struct EpiScan {
    unsigned char* ws; const float* lbl;
    __device__ __forceinline__ void operator()(const AccT& acc, const pg8::Unit& u, int wr, int wc, int fr, int fq) const {
        const int pn = u.pn;
        int kind, pl, W; size_t base;
        if (pn < 8) { kind = 0; pl = pn; W = 2048; base = WS_AQ; }
        else if (pn < 16) { kind = 0; pl = pn - 8; W = 2048; base = WS_AV; }
        else if (pn < 24) { kind = 1; pl = pn - 16; W = 2048; base = WS_ALF; }
        else if (pn < 32) { kind = 2; pl = pn - 24; W = 2048; base = WS_ALF + (size_t)NCHUNK * 2048 * 32 * 2; }
        else if (pn < 36) { kind = 3; pl = pn - 32; W = 1024; base = WS_BQ; }
        else if (pn < 40) { kind = 0; pl = pn - 36; W = 1024; base = WS_BK; }
        else if (pn < 48) { kind = 0; pl = pn - 40; W = 2048; base = WS_BV; }
        else { kind = 4; pl = 0; W = 32; base = WS_R; }
#pragma unroll
        for (int bj = 0; bj < 2; ++bj)
#pragma unroll
            for (int n = 0; n < 2; ++n) {
                const int ch = pl * 256 + bj * 128 + wc * 32 + n * 16 + fr;
                float lb = 0.f;
                if (kind == 1 || kind == 2) { const int li = (kind == 2 ? 2048 : 0) + ch; lb = sigmoidf_(lbl[li] - lbl[4096 + li]); }
#pragma unroll
                for (int ai = 0; ai < 2; ++ai)
#pragma unroll
                    for (int q = 0; q < 2; ++q) {
                        const int chunk = u.pm * 8 + ai * 4 + wr * 2 + q;
                        f32x4 v0 = acc[ai][bj][2 * q][n], v1 = acc[ai][bj][2 * q + 1][n];
                        if (kind == 4) {
                            if (wc == 0 && bj == 0) { float* dst = (float*)(ws + base) + ((size_t)chunk * 32 + (n * 16 + fr)) * 32 + 8 * fq; *(f32x4*)dst = v0; *(f32x4*)(dst + 4) = v1; }
                        } else {
                            u32x4 w;
                            if (kind == 1 || kind == 2) {
                                float t[8] = {v0[0], v0[1], v0[2], v0[3], v1[0], v1[1], v1[2], v1[3]};
#pragma unroll
                                for (int e = 0; e < 8; ++e) t[e] = __log2f(lb + (1.0f - lb) * sigmoidf_(t[e]));
                                w.x = pk_f16(t[0], t[1]); w.y = pk_f16(t[2], t[3]); w.z = pk_f16(t[4], t[5]); w.w = pk_f16(t[6], t[7]);
                            } else {
                                if (kind == 3) { v0 = v0 * 0.0625f; v1 = v1 * 0.0625f; }
                                w.x = pk_bf16(v0[0], v0[1]); w.y = pk_bf16(v0[2], v0[3]); w.z = pk_bf16(v1[0], v1[1]); w.w = pk_bf16(v1[2], v1[3]);
                            }
                            const int chs = (pn >= 32 && pn < 40) ? ((ch & ~255) | ((ch & 1) << 7) | ((ch & 255) >> 1)) : ch;
                            u16* dst = (u16*)(ws + base) + (((size_t)chunk * 4 + fq) * W + chs) * 8;
                            *(u32x4*)dst = w;
                        }
                    }
            }
    }
};

struct EpiGate {
    unsigned char* ws; u16* OA; u16* OB; const float* gain_a; const float* gain_b; const unsigned* pdone;
    __device__ __forceinline__ void operator()(const AccT& acc, const pg8::Unit& u, int wr, int wc, int fr, int fq) const {
        const int pn = u.pn;
        const int row0 = u.pm * 256 + wr * 64 + fr;
        if (pn < 16 || pn >= 24) {
            unsigned spins = 0;
            while (__hip_atomic_load(pdone + ((pn >= 8 && pn < 16 ? 64 : 0) + u.pm) * 4, __ATOMIC_RELAXED, __HIP_MEMORY_SCOPE_AGENT) < 64u) { __builtin_amdgcn_s_sleep(8); if (++spins > (1u << 22)) break; }
            __builtin_amdgcn_fence(__ATOMIC_ACQUIRE, "agent");
        }
        if (pn >= 16) {
            u16* MG = (u16*)(ws + (pn < 24 ? WS_MGA : WS_MGB));
            const int col0 = ((pn - 16) & 7) * 256 + wc * 32 + 8 * fq;
#pragma unroll
            for (int ai = 0; ai < 2; ++ai)
#pragma unroll
                for (int m = 0; m < 4; ++m) { u16* rowp = MG + (size_t)(row0 + ai * 128 + m * 16) * 2048 + col0;
#pragma unroll
                    for (int bj = 0; bj < 2; ++bj) { const f32x4 v0 = acc[ai][bj][m][0], v1 = acc[ai][bj][m][1]; u32x4 w;
                        w.x = pk_bf16(sigmoidf_(v0[0]), sigmoidf_(v0[1])); w.y = pk_bf16(sigmoidf_(v0[2]), sigmoidf_(v0[3]));
                        w.z = pk_bf16(sigmoidf_(v1[0]), sigmoidf_(v1[1])); w.w = pk_bf16(sigmoidf_(v1[2]), sigmoidf_(v1[3]));
                        *(u32x4*)(rowp + bj * 128) = w; } }
        } else {
            const bool isA = pn < 8; const int pl = isA ? pn : pn - 8;
            u16* O = isA ? OA : OB; const float* gain = isA ? gain_a : gain_b;
            const float* SS = (const float*)(ws + (isA ? WS_SSA : WS_SSB));
            const int col0 = pl * 256 + wc * 32 + 8 * fq;
            f32x4 g[2][2];
#pragma unroll
            for (int bj = 0; bj < 2; ++bj) { g[bj][0] = *(const f32x4*)(gain + col0 + bj * 128); g[bj][1] = *(const f32x4*)(gain + col0 + bj * 128 + 4); }
#pragma unroll
            for (int ai = 0; ai < 2; ++ai) {
                float rstd[4][2]; u16* rowp[4]; u32x4 ov[4][2];
#pragma unroll
                for (int m = 0; m < 4; ++m) {
                    const int row = row0 + ai * 128 + m * 16;
                    if (isA) {
#pragma unroll
                        for (int bj = 0; bj < 2; ++bj) {
                            float t = SS[((size_t)(row >> 5) * 64 + (pl * 2 + bj) * 4 + fq) * 32 + (row & 31)];
                            t += __shfl_xor(t, 16); t += __shfl_xor(t, 32); rstd[m][bj] = rsqrtf(t * (1.0f / 128.0f) + EPS); }
                    } else {
                        const int ps = (u.pm & 31) * 256 + (row & 255);
                        const float* sp = SS + ((size_t)((u.pm >> 5) * 256 + (ps >> 5)) * 64 + (pl >> 1) * 16 + 4 * fq) * 32 + (ps & 31); float t = 0.f;
#pragma unroll
                        for (int k = 0; k < 4; ++k) t += sp[32 * k];
                        t += __shfl_xor(t, 16); t += __shfl_xor(t, 32);
                        rstd[m][0] = rstd[m][1] = rsqrtf(t * (1.0f / 512.0f) + EPS);
                    }
                    size_t tb;
                    if (isA) tb = ((size_t)(row >> 5) * 64) * 1024 + (size_t)(row & 31) * 32;
                    else { const int bb = u.pm >> 5, ps = (u.pm & 31) * 256 + (row & 255); tb = ((size_t)(bb * 256 + (ps >> 5)) * 64) * 1024 + (size_t)(ps & 31) * 32; }
                    rowp[m] = O + tb + (size_t)(col0 >> 5) * 1024 + (col0 & 31);
                }
#pragma unroll
                for (int m = 0; m < 4; ++m)
#pragma unroll
                    for (int bj = 0; bj < 2; ++bj) ov[m][bj] = *(const u32x4*)(rowp[m] + bj * 4 * 1024);
#pragma unroll
                for (int m = 0; m < 4; ++m)
#pragma unroll
                    for (int bj = 0; bj < 2; ++bj) {
                        const u32x4 o4 = ov[m][bj];
                        const f32x4 a0 = acc[ai][bj][m][0], a1 = acc[ai][bj][m][1];
                        float o[8] = {bf_lo(o4.x), bf_hi(o4.x), bf_lo(o4.y), bf_hi(o4.y), bf_lo(o4.z), bf_hi(o4.z), bf_lo(o4.w), bf_hi(o4.w)};
                        float gt[8] = {a0[0], a0[1], a0[2], a0[3], a1[0], a1[1], a1[2], a1[3]};
                        float gg[8] = {g[bj][0][0], g[bj][0][1], g[bj][0][2], g[bj][0][3], g[bj][1][0], g[bj][1][1], g[bj][1][2], g[bj][1][3]};
#pragma unroll
                        for (int e = 0; e < 8; ++e) o[e] = (o[e] * rstd[m][bj] * gg[e]) * (gt[e] * sigmoidf_(gt[e]));
                        u32x4 w; w.x = pk_bf16(o[0], o[1]); w.y = pk_bf16(o[2], o[3]); w.z = pk_bf16(o[4], o[5]); w.w = pk_bf16(o[6], o[7]);
                        *(u32x4*)(rowp[m] + bj * 4 * 1024) = w;
                    }
            }
        }
    }
};
constexpr int NH_SHARED = 7;
constexpr int NMA_EARLY = 13 * 256 - (64 * 49 + 2 * 37);
struct SchedOne { static constexpr unsigned MODES = 1u;
    int L; const char* A; const char* B;
    __device__ __forceinline__ bool next(int i, pg8::Unit& u) const {
        if (i > 0) return false;
        u.pm = L & 63; u.pn = 16 + (L >> 6); u.A = A + (size_t)u.pm * 256 * 4096; u.B = B + (size_t)u.pn * 256 * 4096; u.mode = 0u; u.hstepA = 128u * 4096u; u.kstepA = 128u;
        return true;
    }
};
struct SchedHelp { static constexpr unsigned MODES = 1u;
    int id; int n_first; const char* A; const char* B;
    __device__ __forceinline__ bool next(int i, pg8::Unit& u) const {
        int pm, tile;
        if (i < n_first) { const int L = id < 128 ? NMA_EARLY + i * 128 + id : NMA_EARLY + 3 * 128 + (id - 128); pm = L & 63; tile = 16 + (L >> 6); }
        else { int L;
            if (id < 128) { if (i - n_first >= NH_SHARED) return false; L = (i - n_first) * 128 + id; }
            else { L = 128 * NH_SHARED + (i - n_first) * 64 + (id - 128); if (L >= 1024) return false; }
            const int r = L >> 6, q = L & 63, ti = (q >> 2) ^ (((i - n_first) & 1) << 3), bb = q & 1, side = (q >> 1) & 1;
            pm = bb * 32 + (side ? 16 + r : 15 - r); tile = ti < 8 ? ti : 24 + (ti - 8); }
        u.pm = pm; u.pn = tile; u.A = A + (size_t)pm * 256 * 4096; u.B = B + (size_t)tile * 256 * 4096; u.mode = 0u; u.hstepA = 128u * 4096u; u.kstepA = 128u;
        return true;
    }
};
struct SchedBG { static constexpr unsigned MODES = 2u;
    int G, c; const char* A; const char* B;
    __device__ __forceinline__ bool next(int i, pg8::Unit& u) const {
        const int L = i * G + c;
        if (L >= 512) return false;
        u.pm = L & 63; u.pn = 8 + (L >> 6); u.A = A + (size_t)((u.pm >> 5) * 8192 + 2 * (u.pm & 31)) * 4096; u.B = B + (size_t)u.pn * 256 * 4096; u.mode = 1u; u.hstepA = 4096u; u.kstepA = 128u;
        return true;
    }
};

template <int SECOND> struct EpiY {
    unsigned char* ws;
    __device__ __forceinline__ void operator()(const AccT& acc, const pg8::Unit& u, int wr, int wc, int fr, int fq) const {
        const u16* MG = (const u16*)(ws + (SECOND ? WS_MGB : WS_MGA)); u16* Y = (u16*)(ws + WS_Y);
        const int row0 = u.pm * 256 + wr * 64 + fr, col0 = u.pn * 256 + wc * 32 + 8 * fq;
#pragma unroll
        for (int ai = 0; ai < 2; ++ai) {
            u32x4 mv[4][2], yv[4][2];
#pragma unroll
            for (int m = 0; m < 4; ++m) { const size_t off = (size_t)(row0 + ai * 128 + m * 16) * 2048 + col0;
#pragma unroll
                for (int bj = 0; bj < 2; ++bj) { mv[m][bj] = *(const u32x4*)(MG + off + bj * 128); if (SECOND) yv[m][bj] = *(const u32x4*)(Y + off + bj * 128); } }
#pragma unroll
            for (int m = 0; m < 4; ++m) { const size_t off = (size_t)(row0 + ai * 128 + m * 16) * 2048 + col0;
#pragma unroll
                for (int bj = 0; bj < 2; ++bj) {
                    const u32x4 g4 = mv[m][bj];
                    const f32x4 a0 = acc[ai][bj][m][0], a1 = acc[ai][bj][m][1];
                    float o[8] = {a0[0] * bf_lo(g4.x), a0[1] * bf_hi(g4.x), a0[2] * bf_lo(g4.y), a0[3] * bf_hi(g4.y), a1[0] * bf_lo(g4.z), a1[1] * bf_hi(g4.z), a1[2] * bf_lo(g4.w), a1[3] * bf_hi(g4.w)};
                    if (SECOND) { const u32x4 y4 = yv[m][bj];
                        o[0] += bf_lo(y4.x); o[1] += bf_hi(y4.x); o[2] += bf_lo(y4.y); o[3] += bf_hi(y4.y); o[4] += bf_lo(y4.z); o[5] += bf_hi(y4.z); o[6] += bf_lo(y4.w); o[7] += bf_hi(y4.w); }
                    u32x4 w; w.x = pk_bf16(o[0], o[1]); w.y = pk_bf16(o[2], o[3]); w.z = pk_bf16(o[4], o[5]); w.w = pk_bf16(o[6], o[7]);
                    *(u32x4*)(Y + off + bj * 128) = w;
                } }
        }
    }
};

struct SchedY { static constexpr unsigned MODES = 12u;
    int G, c; const char* OA; const char* OB; const char* WP;
    __device__ __forceinline__ bool next(int i, pg8::Unit& u) const {
        const int L = (i >> 1) * G + c;
        if (L >= 512) return false;
        const int pm = L & 63, pn = L >> 6; u.pm = pm; u.kstepA = 4096u;
        if ((i & 1) == 0) { u.pn = pn | 0x100; u.mode = 2u; u.A = OA + (size_t)pm * 8 * 64 * 2048; u.hstepA = 4u * 64u * 2048u; u.B = WP + (size_t)pn * 256 * 4096; }
        else { u.pn = pn; u.mode = 3u; const int bb = pm >> 5, pp = pm & 31;
            u.A = OB + ((size_t)(bb * 256 + (pp >> 3)) * 64 * 1024 + (size_t)(4 * (pp & 7)) * 32) * 2; u.hstepA = 2u * 32u * 2u; u.B = WP + (size_t)2048 * 4096 + (size_t)pn * 256 * 4096; }
        return true;
    }
};
struct EpiY2 {
    unsigned char* ws;
    __device__ __forceinline__ void operator()(const AccT& acc, const pg8::Unit& u, int wr, int wc, int fr, int fq) const {
        pg8::Unit v = u; v.pn = u.pn & 0xff;
        if (u.pn & 0x100) { EpiY<0> e{ws}; e(acc, v, wr, wc, fr, fq); } else { EpiY<1> e{ws}; e(acc, v, wr, wc, fr, fq); }
    }
};

struct EpiOut {
    const float* x; u16* pre; const float* mod; float* sso;
    __device__ __forceinline__ void operator()(const AccT& acc, const pg8::Unit& u, int wr, int wc, int fr, int fq) const {
        const int row0 = u.pm * 256 + wr * 64 + fr, col0 = u.pn * 256 + wc * 32 + 8 * fq;
        const float* gate = mod + (size_t)(u.pm >> 5) * 6144 + 4096;
        f32x4 gv[2][2];
#pragma unroll
        for (int bj = 0; bj < 2; ++bj)
#pragma unroll
            for (int n = 0; n < 2; ++n) gv[bj][n] = *(const f32x4*)(gate + col0 + bj * 128 + n * 4);
#pragma unroll
        for (int ai = 0; ai < 2; ++ai)
#pragma unroll
            for (int mh = 0; mh < 2; ++mh) {
                f32x4 xv[2][2][2];
#pragma unroll
                for (int mm = 0; mm < 2; ++mm) { const size_t off = (size_t)(row0 + ai * 128 + (2 * mh + mm) * 16) * 2048 + col0;
#pragma unroll
                    for (int bj = 0; bj < 2; ++bj)
#pragma unroll
                        for (int n = 0; n < 2; ++n) xv[mm][bj][n] = *(const f32x4*)(x + off + bj * 128 + n * 4); }
#pragma unroll
                for (int mm = 0; mm < 2; ++mm) { const int m = 2 * mh + mm; const int row = row0 + ai * 128 + m * 16; const size_t off = (size_t)row * 2048 + col0;
#pragma unroll
                    for (int bj = 0; bj < 2; ++bj) {
                        const f32x4 o0 = xv[mm][bj][0] + gv[bj][0] * acc[ai][bj][m][0], o1 = xv[mm][bj][1] + gv[bj][1] * acc[ai][bj][m][1];
                        u32x4 w; w.x = pk_bf16(o0[0], o0[1]); w.y = pk_bf16(o0[2], o0[3]); w.z = pk_bf16(o1[0], o1[1]); w.w = pk_bf16(o1[2], o1[3]);
                        *(u32x4*)(pre + off + bj * 128) = w; } }
            }
    }
};

__device__ __forceinline__ void transpose_item(const float* W, int N, int n0, int k0, u16* WTrow0, LAS float* scr, int lane) {
    float tv[32];
#pragma unroll
    for (int i = 0; i < 32; ++i) tv[i] = W[(size_t)(k0 + 2 * i + (lane >> 5)) * N + n0 + (lane & 31)];
#pragma unroll
    for (int i = 0; i < 32; ++i) scr[(2 * i + (lane >> 5)) * 33 + (lane & 31)] = tv[i];
    LDS_WAIT(); asm volatile("" ::: "memory");
    const int c = lane & 7;
#pragma unroll
    for (int j = 0; j < 4; ++j) { const int n = (lane >> 3) + 8 * j; const LAS float* s = scr + (8 * c) * 33 + n;
        u32x4 o; o.x = pk_bf16(s[0 * 33], s[1 * 33]); o.y = pk_bf16(s[2 * 33], s[3 * 33]); o.z = pk_bf16(s[4 * 33], s[5 * 33]); o.w = pk_bf16(s[6 * 33], s[7 * 33]);
        *(u32x4*)(WTrow0 + (size_t)n * 2048 + k0 + 8 * c) = o; }
    LDS_WAIT(); asm volatile("" ::: "memory");
}

__device__ __forceinline__ void phase0(const Params& p, LAS unsigned char* lds) {
    const int tid = threadIdx.x, wid = tid >> 6, lane = tid & 63;
    unsigned char* ws = p.ws;
    if (blockIdx.x < 192) {
        LAS float* sl = (LAS float*)lds;
        LAS float* red = (LAS float*)lds + 6144;
        for (int i = tid; i < 3 * 2048; i += 512) { const int v = i >> 11, d = i & 2047; const float cv = (v < 2) ? p.c[v * 2048 + d] : p.c_ctx[d]; sl[i] = cv * sigmoidf_(cv); }
        __syncthreads();
        const int cg4 = tid & 7, kl = tid >> 3;
        const int col = blockIdx.x * 32 + cg4 * 4;
        f32x4 a0 = {0, 0, 0, 0}, a1 = {0, 0, 0, 0}, a2 = {0, 0, 0, 0};
#pragma unroll 8
        for (int k = kl; k < 2048; k += 64) { const f32x4 w = *(const f32x4*)(p.w_ada + (size_t)k * 6144 + col); a0 += sl[k] * w; a1 += sl[2048 + k] * w; a2 += sl[4096 + k] * w; }
        LAS float* rp = red + tid * 12;
#pragma unroll
        for (int e = 0; e < 4; ++e) { rp[e] = a0[e]; rp[4 + e] = a1[e]; rp[8 + e] = a2[e]; }
        __syncthreads();
        if (tid < 96) { const int v = tid >> 5, cc = tid & 31, g4 = cc >> 2, e = cc & 3; float s = 0.f;
            for (int k = 0; k < 64; ++k) s += red[(k * 8 + g4) * 12 + v * 4 + e];
            ((float*)(ws + WS_MOD))[v * 6144 + blockIdx.x * 32 + cc] = s + p.b_ada[blockIdx.x * 32 + cc]; }
        __syncthreads();
        if (tid == 0) { __builtin_amdgcn_fence(__ATOMIC_RELEASE, "agent"); __hip_atomic_fetch_add((unsigned*)(ws + WS_MODCNT), 1u, __ATOMIC_RELAXED, __HIP_MEMORY_SCOPE_AGENT); }
    }
    LAS float* scr = (LAS float*)(lds + 65536 + wid * 8448);
    const int gw = blockIdx.x * 8 + wid, NGW = gridDim.x * 8;
    constexpr int I_IN = 32 * 641;
    u16* WTS = (u16*)(ws + WS_WTS); u16* WTG = (u16*)(ws + WS_WTG);
    for (int it = gw; it < I_IN; it += NGW) {
        const int kb = it / 641, cb = it - kb * 641, n0 = cb * 32;
        u16* dst;
        if (n0 < 8192) dst = WTS + (size_t)n0 * 2048;
        else if (n0 < 10240) dst = WTG + (size_t)(n0 - 8192) * 2048;
        else if (n0 < 14336) dst = WTS + (size_t)(8192 + n0 - 10240) * 2048;
        else if (n0 == 14336) dst = WTS + (size_t)12288 * 2048;
        else if (n0 < 16416) dst = WTG + (size_t)(2048 + n0 - 14368) * 2048;
        else dst = WTG + (size_t)(4096 + n0 - 16416) * 2048;
        transpose_item(p.w_in, N_IN, n0, kb * 64, dst, scr, lane);
    }
    { u32x4* z = (u32x4*)(WTS + (size_t)12320 * 2048); const int nz = 224 * 2048 * 2 / 16;
      for (int i = blockIdx.x * 512 + tid; i < nz; i += gridDim.x * 512) z[i] = (u32x4){0u, 0u, 0u, 0u}; }
}

__device__ __forceinline__ void phase_wtp(const Params& p, LAS unsigned char* lds, int part, int nparts) {
    const int tid = threadIdx.x, wid = tid >> 6, lane = tid & 63;
    LAS float* scr = (LAS float*)(lds + wid * 8448);
    const int gw = part * 8 + wid, NGW = nparts * 8;
    u16* WTP = (u16*)(p.ws + WS_WTP);
    for (int it = gw; it < 3 * 2048; it += NGW) {
        const int which = it >> 11, r = it & 2047;
        const float* W = which == 0 ? p.w_pa : (which == 1 ? p.w_pb : p.w_out);
        const int kb = r >> 6, cb = r & 63;
        transpose_item(W, 2048, cb * 32, kb * 64, WTP + (size_t)which * 2048 * 2048 + (size_t)(cb * 32) * 2048, scr, lane);
    }
    __syncthreads();
}

__device__ __forceinline__ void phase1(const Params& p) {
    const int tid = threadIdx.x, wid = tid >> 6, lane = tid & 63;
    const float* mod = (const float*)(p.ws + WS_MOD);
    u16* H = (u16*)(p.ws + WS_H);
    for (int i = blockIdx.x * 512 + tid; i < 64 * 256 * 4; i += gridDim.x * 512) ((unsigned*)(p.ws + WS_FLG))[i] = 0u;
    if (blockIdx.x == 0 && tid < 128) ((unsigned*)(p.ws + WS_PDONE))[tid * 4] = 0u;
    if (blockIdx.x == 0 && tid == 64) *(unsigned*)(p.ws + 256) = 0u;
    if (tid == 0) { unsigned spins = 0; while (__hip_atomic_load((unsigned*)(p.ws + WS_MODCNT), __ATOMIC_RELAXED, __HIP_MEMORY_SCOPE_AGENT) < 192u) { __builtin_amdgcn_s_sleep(8); if (++spins > (1u << 22)) break; } }
    __syncthreads();
    __builtin_amdgcn_fence(__ATOMIC_ACQUIRE, "agent");
    f32x4 g[4][2];
#pragma unroll
    for (int j = 0; j < 4; ++j) { const int col = 8 * (lane + 64 * j); g[j][0] = *(const f32x4*)(p.norm_g + col); g[j][1] = *(const f32x4*)(p.norm_g + col + 4); }
    for (int m0 = 2 * (blockIdx.x * 8 + wid); m0 < M_ALL; m0 += 2 * gridDim.x * 8) {
        f32x4 xv[2][4][2]; float ss[2] = {0.f, 0.f};
#pragma unroll
        for (int rr = 0; rr < 2; ++rr) { const int m = m0 + rr;
            const float* src = (m < M_LAT) ? p.x + (size_t)m * D : p.ctx + (size_t)(m - M_LAT) * D;
#pragma unroll
            for (int j = 0; j < 4; ++j) { const f32x4* s4 = (const f32x4*)(src + 8 * (lane + 64 * j)); xv[rr][j][0] = s4[0]; xv[rr][j][1] = s4[1]; } }
        const int v = (m0 < M_LAT) ? (m0 >> 13) : 2;
        f32x4 sc[4][2], sh[4][2];
#pragma unroll
        for (int j = 0; j < 4; ++j) { const int col = 8 * (lane + 64 * j);
#pragma unroll
            for (int e = 0; e < 2; ++e) { sh[j][e] = *(const f32x4*)(mod + v * 6144 + col + 4 * e); sc[j][e] = *(const f32x4*)(mod + v * 6144 + 2048 + col + 4 * e) + 1.0f; } }
#pragma unroll
        for (int rr = 0; rr < 2; ++rr)
#pragma unroll
            for (int j = 0; j < 4; ++j)
#pragma unroll
                for (int e = 0; e < 2; ++e) { const f32x4 t = xv[rr][j][e]; ss[rr] += (t[0] * t[0] + t[1] * t[1]) + (t[2] * t[2] + t[3] * t[3]); }
#pragma unroll
        for (int rr = 0; rr < 2; ++rr) { const int m = m0 + rr;
            const float rstd = rsqrtf(wave_sum(ss[rr]) * (1.0f / D) + EPS);
#pragma unroll
            for (int j = 0; j < 4; ++j) {
                const f32x4 y0 = (xv[rr][j][0] * rstd * g[j][0]) * sc[j][0] + sh[j][0], y1 = (xv[rr][j][1] * rstd * g[j][1]) * sc[j][1] + sh[j][1];
                *(u32x4*)(H + (size_t)m * D + 8 * (lane + 64 * j)) = (u32x4){pk_bf16(y0[0], y0[1]), pk_bf16(y0[2], y0[3]), pk_bf16(y1[0], y1[1]), pk_bf16(y1[2], y1[3])}; } }
    }
}

template <int DIRC>
__device__ __forceinline__ void phase2b_dir(const Params& p, LAS float* wl, int hh, int h, int l31) {
    constexpr int d = DIRC;
    const float* R = (const float*)(p.ws + WS_R);
    u16* LFB = (u16*)(p.ws + WS_LFB);
#pragma unroll 1
    for (int item = blockIdx.x; item < 2 * NCHUNK; item += gridDim.x) {
        const int chunk = item >> 1, j0 = 4 * (item & 1);
        float areg[8];
#pragma unroll
        for (int kk = 0; kk < 8; ++kk) areg[kk] = R[(size_t)chunk * 1024 + (d * 16 + 2 * kk + h) * 32 + l31];
#pragma unroll 2
        for (int j = j0; j < j0 + 4; ++j) {
            const int c = hh * 256 + 32 * j + l31;
            const float bias = wl[32 * 1024 + d * 1024 + c];
            float wv[8];
#pragma unroll
            for (int kk = 0; kk < 8; ++kk) wv[kk] = wl[(d * 16 + 2 * kk + h) * 1024 + c];
            f32x16 z;
#pragma unroll
            for (int r = 0; r < 16; ++r) z[r] = bias;
#pragma unroll
            for (int kk = 0; kk < 8; ++kk) z = __builtin_amdgcn_mfma_f32_32x32x2f32(areg[kk], wv[kk], z, 0, 0, 0);
            float lf[16];
#pragma unroll
            for (int r = 0; r < 16; ++r) { const float v = z[r] * 1.4426950408889634f;
                lf[r] = (fminf(v, 0.f) - __builtin_amdgcn_logf(1.0f + __builtin_amdgcn_exp2f(-fabsf(v)))) * 0.0625f; }
            float own[4];
#pragma unroll
            for (int g = 0; g < 4; ++g) {
                if (d == 0) { lf[4 * g + 1] += lf[4 * g]; lf[4 * g + 2] += lf[4 * g + 1]; lf[4 * g + 3] += lf[4 * g + 2]; own[g] = lf[4 * g + 3]; }
                else { lf[4 * g + 2] += lf[4 * g + 3]; lf[4 * g + 1] += lf[4 * g + 2]; lf[4 * g] += lf[4 * g + 1]; own[g] = lf[4 * g]; }
            }
            float oth[4];
#pragma unroll
            for (int g = 0; g < 4; ++g) oth[g] = __shfl_xor(own[g], 32);
            float base = 0.f;
#pragma unroll
            for (int g_ = 0; g_ < 4; ++g_) { constexpr int dd = d; const int g = dd ? 3 - g_ : g_;
                const float off = base + ((d == 0) ? (h ? oth[g] : 0.f) : (h ? 0.f : oth[g]));
#pragma unroll
                for (int e = 0; e < 4; ++e) lf[4 * g + e] += off;
                base += own[g] + oth[g]; }
            const int chs = (c & ~255) | ((c & 1) << 7) | ((c & 255) >> 1);
#pragma unroll
            for (int g = 0; g < 4; ++g) {
                u32x2 o; o.x = pk_f16(lf[4 * g], lf[4 * g + 1]); o.y = pk_f16(lf[4 * g + 2], lf[4 * g + 3]);
                *(u32x2*)(LFB + ((((size_t)d * NCHUNK + chunk) * 4 + g) * 1024 + chs) * 8 + 4 * h) = o;
            }
        }
    }
}
__device__ __forceinline__ void phase2b(const Params& p, LAS unsigned char* lds) {
    const int tid = threadIdx.x, wid = __builtin_amdgcn_readfirstlane(tid >> 6), lane = tid & 63, h = lane >> 5, l31 = lane & 31;
    LAS float* wl = (LAS float*)lds;
#pragma unroll 4
    for (int i = tid; i < 32 * 1024 / 4; i += 512) *(LAS f32x4*)(wl + 4 * i) = *(const f32x4*)(p.gk_w + 4 * i);
    *(LAS f32x4*)(wl + 32 * 1024 + 4 * tid) = *(const f32x4*)(p.gk_b + 4 * tid);
    __syncthreads();
    if (wid & 1) phase2b_dir<1>(p, wl, wid >> 1, h, l31); else phase2b_dir<0>(p, wl, wid >> 1, h, l31);
    __syncthreads();
}

__device__ __forceinline__ bf16x8 pack8(const f32x16& x, int s) {
    u32x4 pk; pk.x = pk_bf16(x[8 * s + 0], x[8 * s + 1]); pk.y = pk_bf16(x[8 * s + 2], x[8 * s + 3]); pk.z = pk_bf16(x[8 * s + 4], x[8 * s + 5]); pk.w = pk_bf16(x[8 * s + 6], x[8 * s + 7]);
    return __builtin_bit_cast(bf16x8, pk);
}
__device__ __forceinline__ unsigned rot16(unsigned x) { return (x >> 16) | (x << 16); }
template <int NW> __device__ __forceinline__ void maybe_rev(unsigned (&w)[NW], bool rev) {
    unsigned r[NW];
#pragma unroll
    for (int k = 0; k < NW; ++k) r[k] = rot16(w[NW - 1 - k]);
#pragma unroll
    for (int k = 0; k < NW; ++k) w[k] = rev ? r[k] : w[k];
}
__device__ __forceinline__ void ld16(unsigned (&w)[8], const u16* p) { const u32x4 a = *(const u32x4*)p, b = *(const u32x4*)(p + 8); w[0] = a.x; w[1] = a.y; w[2] = a.z; w[3] = a.w; w[4] = b.x; w[5] = b.y; w[6] = b.z; w[7] = b.w; }
__device__ __forceinline__ void ld16q(unsigned (&w)[8], const u16* p, size_t qstride) { const u32x4 a = *(const u32x4*)p, b = *(const u32x4*)(p + qstride); w[0] = a.x; w[1] = a.y; w[2] = a.z; w[3] = a.w; w[4] = b.x; w[5] = b.y; w[6] = b.z; w[7] = b.w; }
__device__ __forceinline__ void ld32(unsigned (&w)[16], const u16* p) {
#pragma unroll
    for (int k = 0; k < 4; ++k) { const u32x4 a = *(const u32x4*)(p + 8 * k); w[4 * k] = a.x; w[4 * k + 1] = a.y; w[4 * k + 2] = a.z; w[4 * k + 3] = a.w; }
}

#define DSR128(dst, addr, off) asm volatile("ds_read_b128 %0, %1 offset:%2" : "=v"(dst) : "v"(addr), "i"(off))
#define SBAR() do { asm volatile("s_waitcnt lgkmcnt(0)" ::: "memory"); __builtin_amdgcn_s_barrier(); asm volatile("" ::: "memory"); } while (0)
__device__ __forceinline__ f32x2 h2_sel(unsigned w0, unsigned w1, int hi) { return (f32x2){h_sel(w0, hi), h_sel(w1, hi)}; }
__device__ __forceinline__ f32x2 bf2_sel(unsigned w0, unsigned w1, int hi) { return (f32x2){bf_sel(w0, hi), bf_sel(w1, hi)}; }
#define GLD128(dst, ptr) asm volatile("global_load_dwordx4 %0, %1, off" : "=v"(dst) : "v"(ptr) : "memory")
#define GLD128_SC1(dst, ptr, off) asm volatile("global_load_dwordx4 %0, %1, off offset:%2 sc1" : "=v"(dst) : "v"(ptr), "i"(off) : "memory")
__device__ __forceinline__ unsigned wsel(const u32x4 (&v)[2], int w) { return v[w >> 2][w & 3]; }
__device__ __forceinline__ float vmul(float a, float b) { float r; asm("v_mul_f32_e32 %0, %1, %2" : "=v"(r) : "v"(a), "v"(b)); return r; }
__device__ __forceinline__ float vmul_v(float a, float b) { float r; asm volatile("v_mul_f32_e32 %0, %1, %2" : "=v"(r) : "v"(a), "v"(b)); return r; }
#define VEXP(dst, src) asm volatile("v_exp_f32_e32 %0, %1" : "=v"(dst) : "v"(src))
#define VEXPN(dst, src) asm volatile("v_exp_f32_e64 %0, -%1" : "=v"(dst) : "v"(src))
__device__ __forceinline__ float vmul_t(float a, float b) { float r; asm("s_nop 1\n\tv_mul_f32_e32 %0, %1, %2" : "=v"(r) : "v"(a), "v"(b)); return r; }
template <int DK, bool IS_A, int DIRC>
__device__ __forceinline__ void producer_loop(const Params& p, LAS unsigned char* lds, int b, int hh, int quarter, int pair, int pw, int ptid, int lane) {
    constexpr int QSTR = DK * 2 + 16, RSTR = 80;
    constexpr int OFF_KS = 32 * QSTR, OFF_KST = 2 * 32 * QSTR, OFF_VT = OFF_KST + DK * RSTR, OFF_DD = OFF_VT + 128 * RSTR, OFF_PD = OFF_DD + DK * 4, BUFB = OFF_PD + 4 * 32 * RSTR;
    constexpr int dir = DIRC;
    constexpr int NS = IS_A ? 6 : 14;
    const int h = lane >> 5, l31 = lane & 31;
    unsigned char* ws = p.ws;
    const u16* Qg = (const u16*)(ws + (IS_A ? WS_AQ : WS_BQ));
    const u16* Kg = (const u16*)(ws + WS_BK);
    const u16* Vg = (const u16*)(ws + (IS_A ? WS_AV : WS_BV));
    const u16* LFg = IS_A ? (const u16*)(ws + WS_ALF) + (size_t)dir * NCHUNK * 2048 * 32 : (const u16*)(ws + WS_LFB) + (size_t)dir * NCHUNK * 1024 * 32;
    unsigned* flg = (unsigned*)(ws + WS_FLG) + pair * 1024;
    const u16* Ogc = (const u16*)p.out + (IS_A ? 0 : (size_t)M_LAT * 2048);
    (void)ptid; (void)Kg;
#define STEP_CHUNK(k, is_ctx_, lc_, cidx_) const bool is_ctx_ = (k) < 8; const int lc_ = is_ctx_ ? (dir ? 7 - (k) : (k)) : (dir ? 263 - (k) : (k) - 8); const int cidx_ = is_ctx_ ? 512 + b * 8 + lc_ : b * 256 + lc_;
#define PD_LOADS(kq_, PD4) do { \
        STEP_CHUNK(kq_, icf, lcf, cidxf); (void)icf; (void)cidxf; \
        const u16* src = Ogc + ((size_t)(b * 256 + lcf) * 64 + (IS_A ? hh * 4 : hh * 16 + quarter * 4) + pw) * 1024 + lane * 8; \
        GLD128_SC1(PD4[0], src, 0); GLD128_SC1(PD4[1], src, 1024); \
    } while (0)
#define PD_ISSUE(kk, PD4) do { const int kq2_ = ((kk) >= 136 && (kk) < 264) ? (kk) : 136; PD_LOADS(kq2_, PD4); } while (0)
#define PD_FIRST(kk, PD4) do { if ((kk) == 136) { \
        STEP_CHUNK(136, icg, lcg, cidxg); (void)icg; (void)cidxg; unsigned spins = 0; \
        while (__hip_atomic_load(flg + lcg * 4 + pw, __ATOMIC_RELAXED, __HIP_MEMORY_SCOPE_AGENT) == 0u) { __builtin_amdgcn_s_sleep(2); if (++spins > (1u << 22)) break; } \
        PD_LOADS(136, PD4); \
        asm volatile("s_waitcnt vmcnt(0)" : "+v"(PD4[0]), "+v"(PD4[1])); } } while (0)
#define PD_STORE(PD4) do { _Pragma("unroll") for (int j_ = 0; j_ < 2; ++j_) *(LAS u32x4*)(buf + OFF_PD + (pw * 32 + 16 * j_ + (lane >> 2)) * RSTR + (lane & 3) * 16) = PD4[j_]; } while (0)
#define BUF_PTRS(kk) LAS unsigned char* buf = lds + ((kk) & 1) * BUFB; LAS unsigned char* QS = buf; LAS unsigned char* KS = buf + OFF_KS; LAS unsigned char* KST = buf + OFF_KST; LAS unsigned char* VT = buf + OFF_VT; LAS float* DD = (LAS float*)(buf + OFF_DD);
#define WAITV(n, ...) asm volatile("s_waitcnt vmcnt(" #n ")" : __VA_ARGS__)
    if (IS_A) {
        const int c = 32 * pw + l31, th = h;
#define LOAD_A(LF, QW, VW, kk) do { const int kl_ = (kk) < 264 ? (kk) : 263; STEP_CHUNK(kl_, ic, lc, cidx); (void)lc; (void)ic; \
            const size_t eo = (((size_t)cidx * 4 + 2 * th) * 2048 + hh * 128 + c) * 8; \
            GLD128(LF[0], LFg + eo); GLD128(LF[1], LFg + eo + 2048 * 8); GLD128(QW[0], Qg + eo); GLD128(QW[1], Qg + eo + 2048 * 8); GLD128(VW[0], Vg + eo); GLD128(VW[1], Vg + eo + 2048 * 8); } while (0)
#define PROC_A(LF, QW, VW, kk, PC, PN) do { \
            BUF_PTRS(kk) \
            PD_FIRST(kk, PC); \
            PD_ISSUE((kk) + 1, PN); \
            asm volatile("s_waitcnt vmcnt(10)" : "+v"(LF[0]), "+v"(LF[1]), "+v"(QW[0]), "+v"(QW[1]), "+v"(VW[0]), "+v"(VW[1]));     \
            float E[16], kk_[16]; float run = 1.f; \
            _Pragma("unroll") for (int it_ = 0; it_ < 16; ++it_) { const int it = dir ? 15 - it_ : it_; const float f = __builtin_amdgcn_exp2f(h_sel(wsel(LF, it >> 1), it & 1)); run = vmul_t(run, f); E[it] = run; kk_[it] = 1.0f - f; } \
            const float other = __shfl_xor(run, 32); \
            const float pre = (dir ? (th == 0) : (th == 1)) ? other : 1.0f; \
            unsigned kst[8]; \
            _Pragma("unroll") for (int it = 0; it < 16; it += 2) { \
                float ks2[2]; \
                _Pragma("unroll") for (int e = 0; e < 2; ++e) { const int i2 = it + e; const float ev = vmul(E[i2], pre); const float qs = vmul(bf_sel(wsel(QW, i2 >> 1), i2 & 1), ev); ks2[e] = vmul_t(kk_[i2], __builtin_amdgcn_rcpf(fmaxf(ev, 1e-30f))); \
                    const int i = 16 * th + i2; \
                    *(LAS u16*)(QS + i * QSTR + c * 2) = (u16)(pk_bf16(qs, 0.f) & 0xffffu); \
                    *(LAS u16*)(KS + i * QSTR + c * 2) = (u16)(pk_bf16(ks2[e], 0.f) & 0xffffu); } \
                kst[it >> 1] = pk_bf16(ks2[0], ks2[1]); \
            } \
            if (dir ? (th == 0) : (th == 1)) DD[c] = vmul(dir ? E[0] : E[15], pre); \
            *(LAS u32x4*)(KST + c * RSTR + th * 32) = (u32x4){kst[0], kst[1], kst[2], kst[3]}; \
            *(LAS u32x4*)(KST + c * RSTR + th * 32 + 16) = (u32x4){kst[4], kst[5], kst[6], kst[7]}; \
            *(LAS u32x4*)(VT + c * RSTR + th * 32) = VW[0]; \
            *(LAS u32x4*)(VT + c * RSTR + th * 32 + 16) = VW[1]; \
            asm volatile("s_waitcnt vmcnt(8)" : "+v"(PC[0]), "+v"(PC[1]));     \
            PD_STORE(PC); \
        } while (0)
        static_assert(NS == 6 || !IS_A, "wait counts");
        u32x4 lf0[2], q0_[2], v0_[2], lf1[2], q1_[2], v1_[2]; u32x4 pe[2], po[2];
        LOAD_A(lf0, q0_, v0_, 0); PD_ISSUE(0, pe); LOAD_A(lf1, q1_, v1_, 1);
#pragma unroll 1
        for (int k = 0; k < 264; k += 2) {
            PROC_A(lf0, q0_, v0_, k, pe, po); LOAD_A(lf0, q0_, v0_, k + 2); SBAR();
            PROC_A(lf1, q1_, v1_, k + 1, po, pe); LOAD_A(lf1, q1_, v1_, k + 3); SBAR();
        }
        asm volatile("s_waitcnt vmcnt(0)" ::: "memory");
#undef LOAD_A
#undef PROC_A
    } else {
        const int cp = 32 * pw + l31, th = h;
        const int col = ptid & 127, thv = ptid >> 7;
#define EO_B(kk, eo_, evv_) const int kl_##eo_ = (kk) < 264 ? (kk) : 263; STEP_CHUNK(kl_##eo_, ic_##eo_, lc_##eo_, cidx_##eo_); (void)lc_##eo_; (void)ic_##eo_; \
            const size_t eo_ = (((size_t)cidx_##eo_ * 4 + 2 * th) * 1024 + hh * 256 + cp) * 8; const size_t evv_ = (((size_t)cidx_##eo_ * 4 + 2 * thv) * 2048 + hh * 512 + quarter * 128 + col) * 8; (void)evv_;
#define LDQ_B(LF, QW, KW, eo_, j, n) do { \
            if ((n) == 0) GLD128(LF[0][j], LFg + eo_ + (j) * 1024 * 8); else if ((n) == 1) GLD128(LF[1][j], LFg + eo_ + 128 * 8 + (j) * 1024 * 8); \
            else if ((n) == 2) GLD128(KW[0][j], Kg + eo_ + (j) * 1024 * 8); else if ((n) == 3) GLD128(KW[1][j], Kg + eo_ + 128 * 8 + (j) * 1024 * 8); \
            else if ((n) == 4) GLD128(QW[0][j], Qg + eo_ + (j) * 1024 * 8); else GLD128(QW[1][j], Qg + eo_ + 128 * 8 + (j) * 1024 * 8); } while (0)
#define LDV_B(VW, evv_) do { GLD128(VW[0], Vg + evv_); GLD128(VW[1], Vg + evv_ + 2048 * 8); } while (0)
#define PROC_B(LF, QW, KW, VW, LFY, QWY, KWY, kk, PC, PN) do { \
            BUF_PTRS(kk) \
            PD_FIRST(kk, PC); \
            PD_ISSUE((kk) + 1, PN); \
            asm volatile("s_waitcnt vmcnt(8)" : "+v"(LF[0][0]), "+v"(LF[0][1]), "+v"(LF[1][0]), "+v"(LF[1][1]), "+v"(KW[0][0]), "+v"(KW[0][1]), "+v"(KW[1][0]), "+v"(KW[1][1]), \
                         "+v"(QW[0][0]), "+v"(QW[0][1]), "+v"(QW[1][0]), "+v"(QW[1][1]), "+v"(VW[0]), "+v"(VW[1]), "+v"(PC[0]), "+v"(PC[1])); \
            PD_STORE(PC); \
            *(LAS u32x4*)(VT + col * RSTR + thv * 32) = VW[0]; \
            *(LAS u32x4*)(VT + col * RSTR + thv * 32 + 16) = VW[1]; \
            EO_B((kk) + 1, eo1, evv1) EO_B((kk) + 2, eo2, evv2) \
            LDV_B(VW, evv2); \
            const bool tail = dir ? (th == 0) : (th == 1); \
            unsigned kst0[8], kst1[8]; float dd0 = 0.f, dd1 = 0.f; \
            float en0, in0, en1, in1;     \
            { const float c0 = h_sel(wsel(LF[0], 0), 0), c1 = h_sel(wsel(LF[1], 0), 0); VEXP(en0, c0); VEXPN(in0, c0); VEXP(en1, c1); VEXPN(in1, c1); } \
            float kap = 0.f, kbp = 0.f; \
            _Pragma("unroll") for (int it = 0; it < 16; ++it) { \
                const float e0 = en0, i0 = in0, e1 = en1, i1 = in1; \
                if (it < 15) { const float c0 = h_sel(wsel(LF[0], (it + 1) >> 1), (it + 1) & 1), c1 = h_sel(wsel(LF[1], (it + 1) >> 1), (it + 1) & 1); VEXP(en0, c0); VEXPN(in0, c0); VEXP(en1, c1); VEXPN(in1, c1); } \
                if (it == (dir ? 0 : 15)) { dd0 = e0; dd1 = e1; } \
                const float qs0 = vmul_v(bf_sel(wsel(QW[0], it >> 1), it & 1), e0), qs1 = vmul_v(bf_sel(wsel(QW[1], it >> 1), it & 1), e1); \
                const float ka = vmul_v(bf_sel(wsel(KW[0], it >> 1), it & 1), i0), kb = vmul_v(bf_sel(wsel(KW[1], it >> 1), it & 1), i1); \
                const int i = 16 * th + it; \
                *(LAS unsigned*)(QS + i * QSTR + cp * 4) = pk_bf16(qs0, qs1); \
                *(LAS unsigned*)(KS + i * QSTR + cp * 4) = pk_bf16(ka, kb); \
                if (it & 1) { kst0[it >> 1] = pk_bf16(kap, ka); kst1[it >> 1] = pk_bf16(kbp, kb); } \
                kap = ka; kbp = kb; \
                if (it < 6) LDQ_B(LFY, QWY, KWY, eo1, 1, it); \
                else if (it >= 8 && it < 14) LDQ_B(LF, QW, KW, eo2, 0, it - 8); \
            } \
            if (tail) { *(LAS f32x2*)(DD + 2 * cp) = (f32x2){dd0, dd1}; } \
            *(LAS u32x4*)(KST + (2 * cp) * RSTR + th * 32) = (u32x4){kst0[0], kst0[1], kst0[2], kst0[3]}; \
            *(LAS u32x4*)(KST + (2 * cp) * RSTR + th * 32 + 16) = (u32x4){kst0[4], kst0[5], kst0[6], kst0[7]}; \
            *(LAS u32x4*)(KST + (2 * cp + 1) * RSTR + th * 32) = (u32x4){kst1[0], kst1[1], kst1[2], kst1[3]}; \
            *(LAS u32x4*)(KST + (2 * cp + 1) * RSTR + th * 32 + 16) = (u32x4){kst1[4], kst1[5], kst1[6], kst1[7]}; \
        } while (0)
        static_assert(NS == 14 || IS_A, "wait counts");
        u32x4 lf0[2][2], q0_[2][2], k0_[2][2], v0_[2], lf1[2][2], q1_[2][2], k1_[2][2], v1_[2]; u32x4 pe[2], po[2];
        {
            EO_B(0, eoa, evva) EO_B(1, eob, evvb)
            LDV_B(v0_, evva);
#pragma unroll
            for (int n = 0; n < 6; ++n) LDQ_B(lf0, q0_, k0_, eoa, 0, n);
            PD_ISSUE(0, pe);
            LDV_B(v1_, evvb);
#pragma unroll
            for (int n = 0; n < 6; ++n) LDQ_B(lf0, q0_, k0_, eoa, 1, n);
#pragma unroll
            for (int n = 0; n < 6; ++n) LDQ_B(lf1, q1_, k1_, eob, 0, n);
        }
#pragma unroll 1
        for (int k = 0; k < 264; k += 2) {
            PROC_B(lf0, q0_, k0_, v0_, lf1, q1_, k1_, k, pe, po); SBAR();
            PROC_B(lf1, q1_, k1_, v1_, lf0, q0_, k0_, k + 1, po, pe); SBAR();
        }
        asm volatile("s_waitcnt vmcnt(0)" ::: "memory");
#undef EO_B
#undef LDQ_B
#undef LDV_B
#undef PROC_B
    }
#undef WAITV
#undef PD_LOADS
#undef PD_FIRST
#undef PD_ISSUE
#undef PD_STORE
#undef BUF_PTRS
#undef STEP_CHUNK
}

template <int DK, bool IS_A>
__device__ __forceinline__ void scan_unit(const Params& p, LAS unsigned char* lds, int b, int hh, int quarter, int dir, int pair) {
    constexpr int NT = DK / 32;
    constexpr int QSTR = DK * 2 + 16;
    constexpr int RSTR = 80;
    constexpr int OFF_KS = 32 * QSTR, OFF_KST = 2 * 32 * QSTR, OFF_VT = OFF_KST + DK * RSTR, OFF_DD = OFF_VT + 128 * RSTR, OFF_PD = OFF_DD + DK * 4, BUFB = OFF_PD + 4 * 32 * RSTR;
    static_assert(2 * BUFB <= LDS_BYTES, "scan LDS");
    const int tid = threadIdx.x, wid = __builtin_amdgcn_readfirstlane(tid >> 6), lane = tid & 63;
    const int h = lane >> 5, l31 = lane & 31;
    unsigned char* ws = p.ws;
    const u16* Qg = (const u16*)(ws + (IS_A ? WS_AQ : WS_BQ));
    const u16* Kg = (const u16*)(ws + WS_BK);
    const u16* Vg = (const u16*)(ws + (IS_A ? WS_AV : WS_BV));
    const u16* LFg = IS_A ? (const u16*)(ws + WS_ALF) + (size_t)dir * NCHUNK * 2048 * 32 : (const u16*)(ws + WS_LFB) + (size_t)dir * NCHUNK * 1024 * 32;
    unsigned* flg = (unsigned*)(ws + WS_FLG) + pair * 1024;
    const u16* Ogc = (const u16*)p.out + (IS_A ? 0 : (size_t)M_LAT * 2048);
#define STEP_CHUNK(k, is_ctx_, lc_, cidx_) const bool is_ctx_ = (k) < 8; const int lc_ = is_ctx_ ? (dir ? 7 - (k) : (k)) : (dir ? 263 - (k) : (k) - 8); const int cidx_ = is_ctx_ ? 512 + b * 8 + lc_ : b * 256 + lc_;
    if (wid >= 4) {
        const int pw = wid - 4, ptid = tid - 256;
        if (dir) producer_loop<DK, IS_A, 1>(p, lds, b, hh, quarter, pair, pw, ptid, lane);
        else producer_loop<DK, IS_A, 0>(p, lds, b, hh, quarter, pair, pw, ptid, lane);
        SBAR();
    } else {
        const int w = wid;
        u16* Og = (u16*)p.out + (IS_A ? 0 : (size_t)M_LAT * 2048);
        float* SSg = (float*)(ws + (IS_A ? WS_SSA : WS_SSB));
        unsigned* pdone = (unsigned*)(ws + WS_PDONE); (void)pdone; constexpr int PANEL_LAG = 4;
        const int ocol0 = IS_A ? hh * 128 + 32 * w : hh * 512 + quarter * 128 + 32 * w;
        const int sspart = IS_A ? hh * 4 + w : hh * 16 + quarter * 4 + w;
        const int prow = (l31 & 3) + 8 * ((l31 >> 2) & 1) + 4 * ((l31 >> 3) & 1) + 16 * (l31 >> 4);
        f32x16 S[NT];
#pragma unroll
        for (int t = 0; t < NT; ++t)
#pragma unroll
            for (int r = 0; r < 16; ++r) S[t][r] = 0.f;
        unsigned mk[2][4];
#pragma unroll
        for (int s2 = 0; s2 < 2; ++s2)
#pragma unroll
            for (int q = 0; q < 4; ++q) { const int r0 = 8 * s2 + 2 * q; const int j0 = (r0 & 3) + 8 * (r0 >> 2) + 4 * h, j1 = j0 + 1;
                const bool k0 = dir ? (j0 >= l31) : (j0 <= l31), k1 = dir ? (j1 >= l31) : (j1 <= l31);
                mk[s2][q] = (k0 ? 0xffffu : 0u) | (k1 ? 0xffff0000u : 0u); }
        SBAR();
#pragma unroll 1
        for (int k = 0; k < 264; ++k) {
            STEP_CHUNK(k, is_ctx, lc, cidx); (void)cidx;
            LAS unsigned char* buf = lds + (k & 1) * BUFB;
            LAS unsigned char* QS = buf; LAS unsigned char* KS = buf + OFF_KS; LAS unsigned char* KST = buf + OFF_KST; LAS unsigned char* VT = buf + OFF_VT; LAS float* DD = (LAS float*)(buf + OFF_DD);
            const bool fin = k >= 136;
            int row = 0;
            if (!is_ctx) { if (IS_A) row = b * SEQ + 32 * lc + l31; else { const int pp = 32 * lc + l31; row = b * SEQ + (pp & 127) * 64 + (pp >> 7); } }
            u16* otile = Og + ((size_t)(b * 256 + lc) * 64 + (IS_A ? hh * 4 : hh * 16 + quarter * 4) + w) * 1024;
            LAS unsigned char* orow = buf + OFF_PD + (w * 32 + l31) * RSTR + 8 * h;
            bf16x8 vk[2];
            f32x16 OT;
#pragma unroll
            for (int r = 0; r < 16; ++r) OT[r] = 0.f;
            if (!is_ctx) {
                f32x16 PT;
#pragma unroll
                for (int r = 0; r < 16; ++r) PT[r] = 0.f;
                {
                    LAS unsigned char* qa = QS + l31 * QSTR + 16 * h;
                    u32x4 fq[2][2], fk[2][2];
                    DSR128(fq[0][0], qa, 0); DSR128(fk[0][0], qa, OFF_KS); DSR128(fq[0][1], qa, 32); DSR128(fk[0][1], qa, OFF_KS + 32);
#define FSTEP(pp) if constexpr (NT > (pp)) { constexpr int s_ = (pp) & 1; \
                        if constexpr ((pp) + 1 < NT) { DSR128(fq[s_ ^ 1][0], qa, 64 * ((pp) + 1)); DSR128(fk[s_ ^ 1][0], qa, OFF_KS + 64 * ((pp) + 1)); \
                            DSR128(fq[s_ ^ 1][1], qa, 64 * ((pp) + 1) + 32); DSR128(fk[s_ ^ 1][1], qa, OFF_KS + 64 * ((pp) + 1) + 32); \
                            asm volatile("s_waitcnt lgkmcnt(4)" : "+v"(fq[s_][0]), "+v"(fk[s_][0]), "+v"(fq[s_][1]), "+v"(fk[s_][1])); } \
                        else asm volatile("s_waitcnt lgkmcnt(0)" : "+v"(fq[s_][0]), "+v"(fk[s_][0]), "+v"(fq[s_][1]), "+v"(fk[s_][1])); \
                        PT = __builtin_amdgcn_mfma_f32_32x32x16_bf16(__builtin_bit_cast(bf16x8, fk[s_][0]), __builtin_bit_cast(bf16x8, fq[s_][0]), PT, 0, 0, 0); \
                        OT = __builtin_amdgcn_mfma_f32_32x32x16_bf16(pack8(S[pp], 0), __builtin_bit_cast(bf16x8, fq[s_][0]), OT, 0, 0, 0); \
                        PT = __builtin_amdgcn_mfma_f32_32x32x16_bf16(__builtin_bit_cast(bf16x8, fk[s_][1]), __builtin_bit_cast(bf16x8, fq[s_][1]), PT, 0, 0, 0); \
                        OT = __builtin_amdgcn_mfma_f32_32x32x16_bf16(pack8(S[pp], 1), __builtin_bit_cast(bf16x8, fq[s_][1]), OT, 0, 0, 0); \
                        __builtin_amdgcn_sched_barrier(0); }
                    FSTEP(0) FSTEP(1) FSTEP(2) FSTEP(3) FSTEP(4) FSTEP(5) FSTEP(6) FSTEP(7)
#undef FSTEP
                }
#pragma unroll
                for (int s2 = 0; s2 < 2; ++s2) {
                    const u32x2 lo = *(const LAS u32x2*)(VT + (32 * w + l31) * RSTR + (16 * s2 + 4 * h) * 2);
                    const u32x2 hi = *(const LAS u32x2*)(VT + (32 * w + l31) * RSTR + (16 * s2 + 8 + 4 * h) * 2);
                    vk[s2] = __builtin_bit_cast(bf16x8, (u32x4){lo.x, lo.y, hi.x, hi.y});
                    u32x4 pw4 = __builtin_bit_cast(u32x4, pack8(PT, s2));
                    pw4.x &= mk[s2][0]; pw4.y &= mk[s2][1]; pw4.z &= mk[s2][2]; pw4.w &= mk[s2][3];
                    OT = __builtin_amdgcn_mfma_f32_32x32x16_bf16(vk[s2], __builtin_bit_cast(bf16x8, pw4), OT, 0, 0, 0);
                }
                float ss = 0.f;
#pragma unroll
                for (int g = 0; g < 4; ++g) {
                    float o0 = OT[4 * g], o1 = OT[4 * g + 1], o2 = OT[4 * g + 2], o3 = OT[4 * g + 3];
                    if (fin) {
                        const u32x2 pvv = *(const LAS u32x2*)(orow + 16 * g); const unsigned lo = pvv.x, hi = pvv.y;
                        o0 += bf_lo(lo); o1 += bf_hi(lo); o2 += bf_lo(hi); o3 += bf_hi(hi);
                        ss += (o0 * o0 + o1 * o1) + (o2 * o2 + o3 * o3);
                    }
                    *(LAS u32x2*)(orow + 16 * g) = (u32x2){pk_bf16(o0, o1), pk_bf16(o2, o3)};
                }
                asm volatile("s_waitcnt lgkmcnt(0)" ::: "memory");
#pragma unroll
                for (int j = 0; j < 2; ++j) {
                    const u32x4 tv = *(const LAS u32x4*)(buf + OFF_PD + (w * 32 + 16 * j + (lane >> 2)) * RSTR + (lane & 3) * 16);
                    u16* dst = otile + j * 512 + lane * 8;
                    asm volatile("global_store_dwordx4 %0, %1, off sc1\n\ts_nop 1" :: "v"(dst), "v"(tv) : "memory");
                }
                if (fin) { ss += __shfl_xor(ss, 32);
                    if (h == 0) { float* sp = SSg + ((size_t)(b * 256 + lc) * 64 + sspart) * 32 + l31; (void)row;
                        asm volatile("global_store_dword %0, %1, off sc1" :: "v"(sp), "v"(ss) : "memory"); } }
            }
            {
                bf16x8 vf[2];
#pragma unroll
                for (int s2 = 0; s2 < 2; ++s2) vf[s2] = *(const LAS bf16x8*)(VT + (32 * w + l31) * RSTR + (16 * s2 + 8 * h) * 2);
                LAS unsigned char* ka = KST + prow * RSTR + 16 * h;
                LAS unsigned char* da = (LAS unsigned char*)(DD + 8 * h);
                u32x4 kf[2][2];
                DSR128(kf[0][0], ka, 0); DSR128(kf[0][1], ka, 32);
#define USTEP(t) if constexpr (NT > (t)) { constexpr int s_ = (t) & 1; \
                    if constexpr ((t) + 1 < NT) { DSR128(kf[s_ ^ 1][0], ka, 32 * RSTR * ((t) + 1)); DSR128(kf[s_ ^ 1][1], ka, 32 * RSTR * ((t) + 1) + 32); \
                        asm volatile("s_waitcnt lgkmcnt(2)" : "+v"(kf[s_][0]), "+v"(kf[s_][1])); } \
                    else asm volatile("s_waitcnt lgkmcnt(0)" : "+v"(kf[s_][0]), "+v"(kf[s_][1])); \
                    S[t] = __builtin_amdgcn_mfma_f32_32x32x16_bf16(__builtin_bit_cast(bf16x8, kf[s_][0]), vf[0], S[t], 0, 0, 0); \
                    S[t] = __builtin_amdgcn_mfma_f32_32x32x16_bf16(__builtin_bit_cast(bf16x8, kf[s_][1]), vf[1], S[t], 0, 0, 0); \
                    __builtin_amdgcn_sched_barrier(0); }
                USTEP(0) USTEP(1) USTEP(2) USTEP(3) USTEP(4) USTEP(5) USTEP(6) USTEP(7)
#undef USTEP
                f32x4 dd[2][4];
                asm volatile("s_nop 15\n\ts_nop 15" ::: "memory");
                DSR128(dd[0][0], da, 0); DSR128(dd[0][1], da, 16); DSR128(dd[0][2], da, 64); DSR128(dd[0][3], da, 80);
#define DSTEP(t) if constexpr (NT > (t)) { constexpr int s_ = (t) & 1; \
                    if constexpr ((t) + 1 < NT) { DSR128(dd[s_ ^ 1][0], da, 128 * ((t) + 1)); DSR128(dd[s_ ^ 1][1], da, 128 * ((t) + 1) + 16); DSR128(dd[s_ ^ 1][2], da, 128 * ((t) + 1) + 64); DSR128(dd[s_ ^ 1][3], da, 128 * ((t) + 1) + 80); \
                        asm volatile("s_waitcnt lgkmcnt(4)" : "+v"(dd[s_][0]), "+v"(dd[s_][1]), "+v"(dd[s_][2]), "+v"(dd[s_][3])); } \
                    else asm volatile("s_waitcnt lgkmcnt(0)" : "+v"(dd[s_][0]), "+v"(dd[s_][1]), "+v"(dd[s_][2]), "+v"(dd[s_][3])); \
                    _Pragma("unroll") for (int r = 0; r < 4; ++r) { S[t][r] = vmul_v(S[t][r], dd[s_][0][r]); S[t][4 + r] = vmul_v(S[t][4 + r], dd[s_][1][r]); S[t][8 + r] = vmul_v(S[t][8 + r], dd[s_][2][r]); S[t][12 + r] = vmul_v(S[t][12 + r], dd[s_][3][r]); } \
                    asm volatile("" : "+v"(S[t])); __builtin_amdgcn_sched_barrier(0); }
                DSTEP(0) DSTEP(1) DSTEP(2) DSTEP(3) DSTEP(4) DSTEP(5) DSTEP(6) DSTEP(7)
#undef DSTEP
            }
            constexpr int FLAG_LAG = 8;
            if (k >= 8 + FLAG_LAG && k < 135) {
                asm volatile("s_waitcnt vmcnt(24)" ::: "memory"); static_assert(FLAG_LAG * 3 == 24, "vmcnt literal");
                const int kp = k - FLAG_LAG; const int lcp = dir ? 263 - kp : kp - 8;
                if (lane == 0) __hip_atomic_store(flg + lcp * 4 + w, 1u, __ATOMIC_RELAXED, __HIP_MEMORY_SCOPE_AGENT);
            } else if (k == 135) {
                VM_WAIT();
                if (lane == 0) {
#pragma unroll
                    for (int q = 0; q <= FLAG_LAG; ++q) { const int kp = 135 - q; const int lcp = dir ? 263 - kp : kp - 8; __hip_atomic_store(flg + lcp * 4 + w, 1u, __ATOMIC_RELAXED, __HIP_MEMORY_SCOPE_AGENT); }
                }
            }
            if (k >= 136 + PANEL_LAG) {
                const int kd = k - PANEL_LAG; const int lcd = dir ? 263 - kd : kd - 8;
                if ((lcd & 7) == (dir ? 0 : 7)) {
                    asm volatile("s_waitcnt vmcnt(12)" ::: "memory"); static_assert(PANEL_LAG * 3 == 12, "vmcnt literal");
                    if (lane == 0) __hip_atomic_fetch_add(pdone + ((IS_A ? 0 : 64) + b * 32 + (lcd >> 3)) * 4, 1u, __ATOMIC_RELAXED, __HIP_MEMORY_SCOPE_AGENT);
                }
            }
            SBAR();
        }
        { VM_WAIT(); if (lane == 0) __hip_atomic_fetch_add(pdone + ((IS_A ? 0 : 64) + b * 32 + (dir ? 0 : 31)) * 4, 1u, __ATOMIC_RELAXED, __HIP_MEMORY_SCOPE_AGENT); }
    }
#undef STEP_CHUNK
}

__device__ __forceinline__ void phase7(const Params& p) {
    const int tid = threadIdx.x, wid = tid >> 6, lane = tid & 63;
    const float* sso = (const float*)(p.ws + WS_SSO);
    const u16* pre = (const u16*)(p.ws + WS_MGA);
    const int xq = blockIdx.x >> 3, xc = blockIdx.x & 7;
    f32x4 fg[8];
#pragma unroll
    for (int j = 0; j < 8; ++j) fg[j] = *(const f32x4*)(p.final_g + 4 * (lane + 64 * j));
    for (int it = 0; it < 4; ++it) {
        const int lr = it * 512 + xq * 16 + wid * 2, m0 = (xc + 8 * (lr >> 8)) * 256 + (lr & 255);
        u32x2 pv[2][8]; float sv[2];
#pragma unroll
        for (int rr = 0; rr < 2; ++rr) { const int m = m0 + rr; sv[rr] = 0.f;
            const u32x2* p2 = (const u32x2*)(pre + (size_t)m * D) + lane;
#pragma unroll
            for (int j = 0; j < 8; ++j) pv[rr][j] = p2[64 * j]; }
#pragma unroll
        for (int rr = 0; rr < 2; ++rr) { const int m = m0 + rr;
#pragma unroll
            for (int j = 0; j < 8; ++j) { const u32x2 w = pv[rr][j]; const float a = bf_lo(w.x), b2 = bf_hi(w.x), c2 = bf_lo(w.y), d2 = bf_hi(w.y); sv[rr] += (a * a + b2 * b2) + (c2 * c2 + d2 * d2); }
            const float rstd = rsqrtf(wave_sum(sv[rr]) * (1.0f / D) + EPS);
#pragma unroll
            for (int j = 0; j < 8; ++j) { const u32x2 w = pv[rr][j];
                const f32x4 a0 = {bf_lo(w.x), bf_hi(w.x), bf_lo(w.y), bf_hi(w.y)};
                *(f32x4*)(p.out + (size_t)m * D + 4 * (lane + 64 * j)) = a0 * rstd * fg[j]; } }
    }
}


#define XB_TMO      128
#define XB_XCNT(j)  (256  + 64 * (j))
#define XB_XSUB(j)  (1280 + 64 * (j))
#define XB_XGEN(j)  (2304 + 64 * (j))
#define XB_TOP      3328
#define XB_TOPGEN   3392
#define XCD_BAR_WORDS 3456
#define XB_SPIN_CAP (1u << 18)
__device__ __forceinline__ unsigned xb_ld(unsigned* p)              { return __hip_atomic_load(p, __ATOMIC_RELAXED, __HIP_MEMORY_SCOPE_AGENT); }
__device__ __forceinline__ unsigned xb_add(unsigned* p, unsigned v) { return __hip_atomic_fetch_add(p, v, __ATOMIC_RELAXED, __HIP_MEMORY_SCOPE_AGENT); }
__device__ __forceinline__ unsigned xb_xcc_id() { return (unsigned)__builtin_amdgcn_s_getreg((3 << 11) | 20) & 0xFu; }
#define XB_SPIN(cond, bar) do { unsigned _sp = 0; while (cond) { __builtin_amdgcn_s_sleep(1); \
    if ((++_sp & 255u) == 0u) { if (xb_ld(&(bar)[XB_TMO])) break; if (_sp > XB_SPIN_CAP) { atomicAdd(&(bar)[XB_TMO], 1u); break; } } } } while (0)
struct XcdBarrier { unsigned* bar; unsigned x; volatile LAS unsigned* st; };
__device__ __forceinline__ XcdBarrier xcd_barrier_post(unsigned* bar, volatile LAS unsigned* st) {
    XcdBarrier b; b.bar = bar; b.x = xb_xcc_id(); b.st = st;
    if (threadIdx.x == 0) (void)xb_add(&bar[XB_XCNT(b.x)], 1u);
    return b;
}
__device__ __forceinline__ void xcd_barrier_complete(unsigned* bar, unsigned x, unsigned& nloc, unsigned& nx) {
    const unsigned G = gridDim.x * gridDim.y * gridDim.z;
    unsigned sum, cnt, mine, sp = 0u;
    for (;;) {
        sum = 0u; cnt = 0u; mine = 0u;
#pragma unroll
        for (unsigned j = 0; j < 16; ++j) { const unsigned c = xb_ld(&bar[XB_XCNT(j)]); sum += c; cnt += (c > 0u) ? 1u : 0u; mine = (j == x) ? c : mine; }
        if (sum == G) break;
        __builtin_amdgcn_s_sleep(1);
        if ((++sp & 255u) == 0u) { if (xb_ld(&bar[XB_TMO])) break; if (sp > XB_SPIN_CAP) { atomicAdd(&bar[XB_TMO], 1u); break; } }
    }
    nloc = mine > 0u ? mine : 1u; nx = cnt > 0u ? cnt : 1u;
}
__device__ __forceinline__ void xcd_barrier(const XcdBarrier& b) {
    asm volatile("s_waitcnt vmcnt(0)" ::: "memory");
    __syncthreads();
    if (threadIdx.x == 0) {
        unsigned* bar = b.bar;
        __builtin_amdgcn_s_waitcnt(0);
        unsigned nloc = b.st[0], nx = b.st[1];
        if (nloc == 0u) { xcd_barrier_complete(bar, b.x, nloc, nx); b.st[0] = nloc; b.st[1] = nx; }
        const unsigned old = xb_add(&bar[XB_XSUB(b.x)], 1u);
        const unsigned gen = old / nloc;
        if (old + 1u == (gen + 1u) * nloc) {
            __builtin_amdgcn_fence(__ATOMIC_RELEASE, "agent");
            asm volatile("s_waitcnt vmcnt(0)" ::: "memory");
            const unsigned og = xb_add(&bar[XB_TOP], 1u);
            const unsigned tg = og / nx;
            if (og + 1u == (tg + 1u) * nx) xb_add(&bar[XB_TOPGEN], 1u);
            else XB_SPIN(xb_ld(&bar[XB_TOPGEN]) == tg, bar);
            __builtin_amdgcn_fence(__ATOMIC_ACQUIRE, "agent");
            xb_add(&bar[XB_XGEN(b.x)], 1u);
            asm volatile("s_waitcnt vmcnt(0)" ::: "memory");
        } else {
            XB_SPIN(xb_ld(&bar[XB_XGEN(b.x)]) == gen, bar);
            __builtin_amdgcn_fence(__ATOMIC_ACQUIRE, "agent");
            asm volatile("s_waitcnt vmcnt(0)" ::: "memory");
        }
    }
    __syncthreads();
}

__global__ void __launch_bounds__(512, 2) fwd_megakernel(Params p) {
    extern __shared__ __attribute__((aligned(16))) unsigned char lds_raw[];
    LAS unsigned char* lds = (LAS unsigned char*)lds_raw;
    volatile LAS unsigned* bst = (volatile LAS unsigned*)(lds + LDS_BYTES - 16);
    if (threadIdx.x < 4) bst[threadIdx.x] = 0u;
    __syncthreads();
    const XcdBarrier xbar = xcd_barrier_post((unsigned*)(p.ws + WS_BAR), bst);
    const int lo = p.ph_lo, hi = p.ph_hi;
    const int G = gridDim.x, c = blockIdx.x;
    unsigned char* ws = p.ws;
#ifdef ONLY_PHASE
#define IN(k) ((k) == ONLY_PHASE && lo <= (k) && (k) < hi)
#else
#define IN(k) (lo <= (k) && (k) < hi)
#endif
#define SEAM(k) do { if (IN(k) && IN((k) + 1)) xcd_barrier(xbar); } while (0)
#ifndef DUP_PHASE
#define DUP_PHASE -1
#endif
#define REP(k) for (int rep_ = 0; rep_ < ((k) == DUP_PHASE ? 2 : 1); ++rep_)
    if (IN(0)) REP(0) phase0(p, lds);
    if (IN(1)) REP(1) phase1(p);
    SEAM(1);
    if (IN(2)) REP(2) { SchedScan S{G, c, (const char*)(ws + WS_H), (const char*)(ws + WS_WTS)}; EpiScan E{ws, p.lb_logits};
        pg8::gemm_phase<EpiScan, SchedScan, false, true, false>(lds, S, E);
        if (c >= 256 - NMA_EARLY) {
            SchedOne S1{c - (256 - NMA_EARLY), (const char*)(ws + WS_H), (const char*)(ws + WS_WTG)};
            EpiGate E1{ws, (u16*)p.out, (u16*)p.out + (size_t)M_LAT * 2048, p.onorm_a, p.onorm_b, (const unsigned*)(ws + WS_PDONE)};
            pg8::gemm_phase<EpiGate, SchedOne, true, false, true>(lds, S1, E1); } }
    SEAM(2);
    if (IN(3)) REP(3) phase2b(p, lds);
    SEAM(3);
    if (IN(4)) {
        EpiGate E{ws, (u16*)p.out, (u16*)p.out + (size_t)M_LAT * 2048, p.onorm_a, p.onorm_b, (const unsigned*)(ws + WS_PDONE)};
        if (c < 64) {
            scan_unit<128, true>(p, lds, c >> 5, (c >> 1) & 15, 0, c & 1, c >> 1);
            unsigned* adone = (unsigned*)(ws + 256);
            __syncthreads();
            if (threadIdx.x == 0) __hip_atomic_fetch_add(adone, 1u, __ATOMIC_RELAXED, __HIP_MEMORY_SCOPE_AGENT);
            constexpr int NMA_A = 512 - NMA_EARLY - 3 * 128;
            SchedHelp S{128 + c, c < NMA_A ? 1 : 0, (const char*)(ws + WS_H), (const char*)(ws + WS_WTG)};
            pg8::gemm_phase<EpiGate, SchedHelp, true, false, true>(lds, S, E);
            if (threadIdx.x == 0) { unsigned spins = 0; while (__hip_atomic_load(adone, __ATOMIC_RELAXED, __HIP_MEMORY_SCOPE_AGENT) < 64u) { __builtin_amdgcn_s_sleep(8); if (++spins > (1u << 22)) break; } }
            __syncthreads();
            if (c >= NMA_A) phase_wtp(p, lds, c - NMA_A, 64 - NMA_A);
        } else if (c < 128) { const int u = c - 64; scan_unit<256, false>(p, lds, u >> 5, (u >> 1) & 3, (u >> 3) & 3, u & 1, 32 + (u >> 1)); __syncthreads(); }
        else { SchedHelp S{c - 128, 3, (const char*)(ws + WS_H), (const char*)(ws + WS_WTG)};
            pg8::gemm_phase<EpiGate, SchedHelp, true, false, true>(lds, S, E); }
    }
    if (IN(5)) {
        SchedBG S{G, c, (const char*)(ws + WS_H), (const char*)(ws + WS_WTG)};
        EpiGate E{ws, (u16*)p.out, (u16*)p.out + (size_t)M_LAT * 2048, p.onorm_a, p.onorm_b, (const unsigned*)(ws + WS_PDONE)};
        pg8::gemm_phase<EpiGate, SchedBG, true, false, true>(lds, S, E); }
    SEAM(5);
    if (IN(6)) { SchedY S{G, c, (const char*)p.out, (const char*)p.out + (size_t)M_LAT * 2048 * 2, (const char*)(ws + WS_WTP)}; EpiY2 E{ws};
        pg8::gemm_phase<EpiY2, SchedY, true, false, true>(lds, S, E); }
    SEAM(6);
    if (IN(7)) REP(7) { SchedStd S{G, c, 8, (const char*)(ws + WS_Y), (const char*)(ws + WS_WTP) + (size_t)2 * 2048 * 4096, 0u};
        EpiOut E{p.x, (u16*)(ws + WS_MGA), (const float*)(ws + WS_MOD), (float*)(ws + WS_SSO)};
        pg8::gemm_phase<EpiOut, SchedStd, true, false, true>(lds, S, E); }
    SEAM(7);
    if (IN(8)) phase7(p);
#undef IN
#undef SEAM
}

#ifndef N_LAUNCHES
#define N_LAUNCHES 1
#endif
constexpr int N_PHASES = 9;

extern "C" void kernel_launch(void* const* d_in, const int* in_sizes, int n_in, void* d_out, int out_size, void* d_ws, size_t ws_size, hipStream_t stream) {
    static int grid = 0;
    if (grid == 0) {
        if (n_in != 17 || out_size != M_LAT * D || ws_size < WS_END) { fprintf(stderr, "kernel_launch: unexpected sizes (n_in %d out %d ws %zu need %zu)\n", n_in, out_size, ws_size, (size_t)WS_END); grid = -1; return; }
        int dev = 0, cus = 0, per_cu = 0;
        hipGetDevice(&dev);
        hipDeviceGetAttribute(&cus, hipDeviceAttributeMultiprocessorCount, dev);
        hipFuncSetAttribute((const void*)fwd_megakernel, hipFuncAttributeMaxDynamicSharedMemorySize, LDS_BYTES);
        hipOccupancyMaxActiveBlocksPerMultiprocessor(&per_cu, (const void*)fwd_megakernel, 512, LDS_BYTES);
        if (per_cu < 1) { fprintf(stderr, "kernel_launch: occupancy query reports %d blocks per CU\n", per_cu); grid = -1; return; }
        grid = cus;
    }
    if (grid < 0) return;
    Params p{};
    p.x = (const float*)d_in[0]; p.c = (const float*)d_in[1]; p.ctx = (const float*)d_in[2]; p.c_ctx = (const float*)d_in[3];
    p.w_ada = (const float*)d_in[4]; p.b_ada = (const float*)d_in[5]; p.norm_g = (const float*)d_in[6]; p.w_in = (const float*)d_in[7];
    p.lb_logits = (const float*)d_in[8]; p.gk_w = (const float*)d_in[9]; p.gk_b = (const float*)d_in[10]; p.onorm_a = (const float*)d_in[11];
    p.onorm_b = (const float*)d_in[12]; p.w_pa = (const float*)d_in[13]; p.w_pb = (const float*)d_in[14]; p.w_out = (const float*)d_in[15]; p.final_g = (const float*)d_in[16];
    p.out = (float*)d_out; p.ws = (unsigned char*)d_ws;
    (void)hipMemsetAsync((char*)d_ws + WS_BAR, 0, 16384, stream);
    const int per = (N_PHASES + N_LAUNCHES - 1) / N_LAUNCHES;
    for (int li = 0; li < N_LAUNCHES; ++li) {
        p.ph_lo = li * per; p.ph_hi = (li + 1) * per < N_PHASES ? (li + 1) * per : N_PHASES;
        if (p.ph_lo >= N_PHASES) break;
        void* args[] = {&p};
        hipError_t e = hipLaunchCooperativeKernel((const void*)fwd_megakernel, dim3(grid), dim3(512), args, LDS_BYTES, stream);
        if (e != hipSuccess) { fprintf(stderr, "cooperative launch failed: %s (grid %d)\n", hipGetErrorString(e), grid); break; }
    }
}
```
